# Optimizing an MI355X kernel written in HIP

```python
import math
import jax, jax.numpy as jnp
from jax import lax
import numpy as np

D_MODEL = 1024
BATCH = 4
SEQ = 8192
DEPTH = 1

N_META = 16
HEAD_DIM = 64
N_Q_HEADS = 16
N_KV_HEADS = 4
GQA_GROUP = N_Q_HEADS // N_KV_HEADS
WINDOW = 128
SSM_WIDTH = D_MODEL
SSM_GROUP_CH = 16
SSM_GROUPS = SSM_WIDTH // SSM_GROUP_CH
SSM_STATE = 64
D_FF = -(-8 * D_MODEL // (3 * 256)) * 256
Q_W = N_Q_HEADS * HEAD_DIM
KV_W = N_KV_HEADS * HEAD_DIM
IN_COLS = Q_W + 2 * KV_W + SSM_WIDTH + 2 * D_MODEL
EPS = 1e-6
DT_MIN = 1e-3
DT_MAX = 1e-1

kernel_name = "hybrid_swa_sink_s5_gated_block"


def rmsnorm(x, g):
    xf = x.astype(jnp.float32)
    xf = xf * lax.rsqrt(jnp.mean(xf * xf, axis=-1, keepdims=True) + EPS)
    return (xf * g.astype(jnp.float32)).astype(x.dtype)


def softmax_with_sink(s, sink):
    sink = sink.astype(jnp.float32)[:, :, None, None]
    m = jnp.maximum(jnp.max(s, axis=-1, keepdims=True), sink)
    e = jnp.exp(s - m)
    return e / (jnp.sum(e, axis=-1, keepdims=True) + jnp.exp(sink - m))


def sliding_window_attention(q, k, v, sinks):
    b, L = q.shape[0], q.shape[1]
    n_blk = (L - N_META) // WINDOW
    scale = HEAD_DIM ** -0.5
    sink = sinks.reshape(N_KV_HEADS, GQA_GROUP)
    qm = q[:, :N_META].reshape(b, N_META, N_KV_HEADS, GQA_GROUP, HEAD_DIM)
    km, vm = k[:, :N_META], v[:, :N_META]
    s_m = jnp.einsum('bqkrd,bskd->bkrqs', qm, km, preferred_element_type=jnp.float32) * scale
    causal = jnp.tril(jnp.ones((N_META, N_META), dtype=bool))
    s_m = jnp.where(causal, s_m, -jnp.inf)
    p_m = softmax_with_sink(s_m, sink).astype(v.dtype)
    o_m = jnp.einsum('bkrqs,bskd->bqkrd', p_m, vm).reshape(b, N_META, Q_W)
    qb = q[:, N_META:].reshape(b, n_blk, WINDOW, N_KV_HEADS, GQA_GROUP, HEAD_DIM)
    kb = k[:, N_META:].reshape(b, n_blk, WINDOW, N_KV_HEADS, HEAD_DIM)
    vb = v[:, N_META:].reshape(b, n_blk, WINDOW, N_KV_HEADS, HEAD_DIM)
    pad = ((0, 0), (1, 0), (0, 0), (0, 0), (0, 0))
    k_prev = jnp.pad(kb[:, :-1], pad)
    v_prev = jnp.pad(vb[:, :-1], pad)
    meta_shape = (b, n_blk, N_META, N_KV_HEADS, HEAD_DIM)
    k_win = jnp.concatenate([jnp.broadcast_to(km[:, None], meta_shape), k_prev, kb], axis=2)
    v_win = jnp.concatenate([jnp.broadcast_to(vm[:, None], meta_shape), v_prev, vb], axis=2)
    s = jnp.einsum('bnqkrd,bnskd->bnkrqs', qb, k_win, preferred_element_type=jnp.float32) * scale
    qi = jnp.arange(WINDOW)[:, None]
    kj = jnp.arange(WINDOW)[None, :]
    blk = jnp.arange(n_blk)[:, None, None]
    meta_vis = jnp.ones((n_blk, WINDOW, N_META), dtype=bool)
    prev_vis = (kj > qi)[None] & (blk > 0)
    cur_vis = jnp.broadcast_to((kj <= qi)[None], (n_blk, WINDOW, WINDOW))
    mask = jnp.concatenate([meta_vis, prev_vis, cur_vis], axis=-1)
    s = jnp.where(mask[None, :, None, None], s, -jnp.inf)
    p = softmax_with_sink(s, sink).astype(v.dtype)
    o_r = jnp.einsum('bnkrqs,bnskd->bnqkrd', p, v_win).reshape(b, n_blk * WINDOW, Q_W)
    return jnp.concatenate([o_m, o_r], axis=1)


def s5_ssm(u, lam_re, lam_im, log_dt, b_re, b_im, c_re, c_im, d_skip):
    bsz, L = u.shape[0], u.shape[1]
    uf = u.astype(jnp.float32)
    ug = uf.reshape(bsz, L, SSM_GROUPS, SSM_GROUP_CH)
    dt = jnp.exp(log_dt.astype(jnp.float32))[:, None]
    lr, li = lam_re.astype(jnp.float32), lam_im.astype(jnp.float32)
    mag = jnp.exp(lr * dt)
    ar, ai = mag * jnp.cos(li * dt), mag * jnp.sin(li * dt)
    den = lr * lr + li * li
    nr, ni = ar - 1.0, ai
    fr, fi = (nr * lr + ni * li) / den, (ni * lr - nr * li) / den
    br, bi = b_re.astype(jnp.float32), b_im.astype(jnp.float32)
    bbar_re = fr[..., None] * br - fi[..., None] * bi
    bbar_im = fr[..., None] * bi + fi[..., None] * br
    xr = jnp.einsum('gpc,blgc->blgp', bbar_re, ug)
    xi = jnp.einsum('gpc,blgc->blgp', bbar_im, ug)
    a_re = jnp.broadcast_to(ar[None, None], (1, L, SSM_GROUPS, SSM_STATE))
    a_im = jnp.broadcast_to(ai[None, None], (1, L, SSM_GROUPS, SSM_STATE))

    def combine(e1, e2):
        a1r, a1i, b1r, b1i = e1
        a2r, a2i, b2r, b2i = e2
        return (a1r * a2r - a1i * a2i,
                a1r * a2i + a1i * a2r,
                a2r * b1r - a2i * b1i + b2r,
                a2r * b1i + a2i * b1r + b2i)

    _, _, sr, si = lax.associative_scan(combine, (a_re, a_im, xr, xi), axis=1)
    y = (jnp.einsum('gcp,blgp->blgc', c_re.astype(jnp.float32), sr)
         - jnp.einsum('gcp,blgp->blgc', c_im.astype(jnp.float32), si))
    y = y.reshape(bsz, L, SSM_WIDTH) + d_skip.astype(jnp.float32) * uf
    return y


def setup_inputs(seed: int = 0) -> dict:
    key = jax.random.key(seed)
    ks = jax.random.split(key, 24)
    f32 = jnp.float32
    nrm = lambda k, shape, s: jax.random.normal(k, shape, f32) * s
    gain = lambda k, shape: 1.0 + 0.02 * jax.random.normal(k, shape, f32)
    n_idx = jnp.arange(SSM_STATE, dtype=f32)
    return {
        "x": nrm(ks[0], (BATCH, SEQ, D_MODEL), 1.0),
        "meta_tokens": nrm(ks[1], (N_META, D_MODEL), 1.0),
        "norm_mix": gain(ks[2], (DEPTH, D_MODEL)),
        "w_in": nrm(ks[3], (DEPTH, D_MODEL, IN_COLS), D_MODEL ** -0.5),
        "q_norm": gain(ks[4], (DEPTH, HEAD_DIM)),
        "k_norm": gain(ks[5], (DEPTH, HEAD_DIM)),
        "attn_sinks": nrm(ks[6], (DEPTH, N_Q_HEADS), 0.5),
        "lam_re": -0.5 + nrm(ks[7], (DEPTH, SSM_GROUPS, SSM_STATE), 0.01),
        "lam_im": math.pi * n_idx + nrm(ks[8], (DEPTH, SSM_GROUPS, SSM_STATE), 0.01),
        "log_dt": jax.random.uniform(ks[9], (DEPTH, SSM_GROUPS), f32, math.log(DT_MIN), math.log(DT_MAX)),
        "ssm_b_re": nrm(ks[10], (DEPTH, SSM_GROUPS, SSM_STATE, SSM_GROUP_CH), (2 * SSM_GROUP_CH) ** -0.5),
        "ssm_b_im": nrm(ks[11], (DEPTH, SSM_GROUPS, SSM_STATE, SSM_GROUP_CH), (2 * SSM_GROUP_CH) ** -0.5),
        "ssm_c_re": nrm(ks[12], (DEPTH, SSM_GROUPS, SSM_GROUP_CH, SSM_STATE), (2 * SSM_STATE) ** -0.5),
        "ssm_c_im": nrm(ks[13], (DEPTH, SSM_GROUPS, SSM_GROUP_CH, SSM_STATE), (2 * SSM_STATE) ** -0.5),
        "ssm_d": nrm(ks[14], (DEPTH, SSM_WIDTH), 1.0),
        "w_glu": nrm(ks[15], (DEPTH, SSM_WIDTH, 2 * D_MODEL), SSM_WIDTH ** -0.5),
        "attn_branch_norm": gain(ks[16], (DEPTH, D_MODEL)),
        "ssm_branch_norm": gain(ks[17], (DEPTH, D_MODEL)),
        "w_out": nrm(ks[18], (DEPTH, D_MODEL, D_MODEL), D_MODEL ** -0.5),
        "norm_ffn": gain(ks[19], (DEPTH, D_MODEL)),
        "w_ffn_in": nrm(ks[20], (DEPTH, D_MODEL, 2 * D_FF), D_MODEL ** -0.5),
        "w_ffn_out": nrm(ks[21], (DEPTH, D_FF, D_MODEL), D_FF ** -0.5),
    }


def reference(x, meta_tokens, norm_mix, w_in, q_norm, k_norm, attn_sinks, lam_re, lam_im, log_dt,
              ssm_b_re, ssm_b_im, ssm_c_re, ssm_c_im, ssm_d, w_glu, attn_branch_norm, ssm_branch_norm,
              w_out, norm_ffn, w_ffn_in, w_ffn_out):
    b = x.shape[0]
    meta = jnp.broadcast_to(meta_tokens.astype(x.dtype)[None], (b, N_META, D_MODEL))
    h = jnp.concatenate([meta, x], axis=1)
    L = h.shape[1]
    offs = np.cumsum([Q_W, KV_W, KV_W, SSM_WIDTH, D_MODEL]).tolist()
    for i in range(DEPTH):
        xn = rmsnorm(h, norm_mix[i])
        proj = xn @ w_in[i]
        q, k, v, u, g_att, g_ssm = jnp.split(proj, offs, axis=-1)
        q = rmsnorm(q.reshape(b, L, N_Q_HEADS, HEAD_DIM), q_norm[i])
        k = rmsnorm(k.reshape(b, L, N_KV_HEADS, HEAD_DIM), k_norm[i])
        v = v.reshape(b, L, N_KV_HEADS, HEAD_DIM)
        attn = sliding_window_attention(q, k, v, attn_sinks[i])
        y = s5_ssm(u, lam_re[i], lam_im[i], log_dt[i], ssm_b_re[i], ssm_b_im[i],
                   ssm_c_re[i], ssm_c_im[i], ssm_d[i])
        z = jax.nn.gelu(y).astype(h.dtype)
        za, zb = jnp.split(z @ w_glu[i], 2, axis=-1)
        ssm = za * jax.nn.sigmoid(zb)
        merged = (jax.nn.sigmoid(g_att) * rmsnorm(attn, attn_branch_norm[i])
                  + jax.nn.sigmoid(g_ssm) * rmsnorm(ssm, ssm_branch_norm[i]))
        h = h + merged @ w_out[i]
        hn = rmsnorm(h, norm_ffn[i])
        gate, up = jnp.split(hn @ w_ffn_in[i], 2, axis=-1)
        h = h + (jax.nn.silu(gate) * up) @ w_ffn_out[i]
    return h[:, N_META:]
```

```cpp
#include <hip/hip_runtime.h>
#include <hip/hip_cooperative_groups.h>
#include <cstdio>
#include <cstdint>
namespace cg = cooperative_groups;
namespace pg8 {
#define PG8_LAS __attribute__((address_space(3)))
typedef unsigned short bf16_t;
typedef short bf16x8 __attribute__((ext_vector_type(8)));
typedef float f32x4 __attribute__((ext_vector_type(4)));
typedef unsigned u32x4 __attribute__((ext_vector_type(4)));
constexpr int BM = 256, BK = 64, HALF = 128, HTB = HALF * BK * 2  , STAGE_BYTES = 8 * HTB, NXCD = 8, WGM = 8;

__host__ __device__ __forceinline__ int lds_byte(int r, int c) { const int st = (r >> 4) * 2 + (c >> 5), rr = r & 15, cc = c & 31, ob = rr * 64 + cc * 2; return st * 1024 + (ob ^ (((ob >> 9) & 1) << 5)); }
__host__ __device__ __forceinline__ void stage_rc(int b, int& R, int& C) { const int st = b / 1024, sb = b % 1024, swz = sb ^ (((sb >> 9) & 1) << 5); R = (st >> 1) * 16 + swz / 64; C = (st & 1) * 32 + (swz % 64) / 2; }
__host__ __device__ __forceinline__ int perm32(int rho) { const int n = rho >> 4, i = rho & 15; return 8 * (i >> 2) + 4 * n + (i & 3); }

struct Unit { int pm, pn; };
struct Gemm { const bf16_t* A; const bf16_t* Bt; int M, N, K; };

struct StaticOrder {
    int nM, nN, nwg, G, c;
    __host__ __device__ void init(int M, int N, int G_, int c_) { nM = M / BM; nN = N / BM; nwg = nM * nN; G = G_; c = c_; }
    __host__ __device__ bool next(int i, Unit& u) const {
        const long L = (long)i * G + c; if (L >= nwg) return false;
        int wgid = (int)L; { const int q = nwg / NXCD, r = nwg % NXCD, xcd = wgid % NXCD, off = wgid / NXCD; wgid = (xcd < r ? xcd * (q + 1) : r * (q + 1) + (xcd - r) * q) + off; }
        const int nig = WGM * nN, gid = wgid / nig, fm = gid * WGM, gsz = (nM - fm) < WGM ? (nM - fm) : WGM;
        u.pm = fm + ((wgid % nig) % gsz); u.pn = (wgid % nig) / gsz; return true;
    }
    __device__ __forceinline__ void a_ready(const Unit&) const {}
    __device__ __forceinline__ void done(const Unit&) const {}
};

__device__ __forceinline__ unsigned cvt_pk_bf16(float lo, float hi) { unsigned r; asm volatile("v_cvt_pk_bf16_f32 %0, %1, %2" : "=v"(r) : "v"(lo), "v"(hi)); return r; }
typedef float f32x2 __attribute__((ext_vector_type(2)));
__device__ __forceinline__ f32x2 gelu_pk(f32x2 v) {
    const f32x2 av = __builtin_elementwise_abs(v), d = av * 0.2316418882f + 1.0f;
    f32x2 t; t.x = __builtin_amdgcn_rcpf(d.x); t.y = __builtin_amdgcn_rcpf(d.y);
    f32x2 q = t * 0.5307027145f + (-0.7265760135f); q = q * t + 0.7107068705f; q = q * t + (-0.142248368f); q = q * t + 0.127414796f; q = q * t;
    const f32x2 s = (v * v) * (-0.72134752044f);
    f32x2 e; e.x = __builtin_amdgcn_exp2f(s.x); e.y = __builtin_amdgcn_exp2f(s.y);
    const f32x2 m = v * (q * e), r = v - m;
    f32x2 o; o.x = v.x < 0.f ? m.x : r.x; o.y = v.y < 0.f ? m.y : r.y; return o;
}

template <int ACT  > struct EpiBf16 {
    static constexpr bool PERM = true, AFTER_DRAIN = false; static_assert(ACT == 0 || ACT == 1, "EpiBf16: ACT is 0 (none) or 1 (gelu_pk)");
    bf16_t* O; int ldc; const float* bias; int split_cols; size_t split_stride; float scale0;
    __device__ __forceinline__ void operator()(const f32x4 (&acc)[2][2][4][2], const Unit& u, int wr, int wc, int fr, int fq) const {
        const int row0 = u.pm * BM + wr * 64 + fr; int colt = u.pn * BM; bf16_t* base = O;
        float sc = 1.f; if (split_cols) { const int t = colt / split_cols; base += (size_t)t * split_stride; colt -= t * split_cols; if (t == 0) sc = scale0; }
        const int col0 = colt + wc * 32 + 8 * fq, bcol0 = u.pn * BM + wc * 32 + 8 * fq;
        f32x4 bv[2][2];
#pragma unroll
        for (int bj = 0; bj < 2; ++bj)
#pragma unroll
            for (int n = 0; n < 2; ++n) bv[bj][n] = bias ? *(const f32x4*)(bias + bcol0 + bj * HALF + 4 * n) : (f32x4){0.f, 0.f, 0.f, 0.f};
#pragma unroll
        for (int ai = 0; ai < 2; ++ai)
#pragma unroll
            for (int m = 0; m < 4; ++m) { bf16_t* rowp = base + (size_t)(row0 + ai * HALF + m * 16) * ldc + col0;
#pragma unroll
                for (int bj = 0; bj < 2; ++bj) { f32x4 v0 = acc[ai][bj][m][0] + bv[bj][0], v1 = acc[ai][bj][m][1] + bv[bj][1];
                    if (ACT == 1) { f32x2 a = gelu_pk((f32x2){v0[0], v0[1]}), b = gelu_pk((f32x2){v0[2], v0[3]}), c = gelu_pk((f32x2){v1[0], v1[1]}), d = gelu_pk((f32x2){v1[2], v1[3]});
                        v0 = (f32x4){a.x, a.y, b.x, b.y}; v1 = (f32x4){c.x, c.y, d.x, d.y}; }
                    v0 = v0 * sc; v1 = v1 * sc; u32x4 w; w.x = cvt_pk_bf16(v0[0], v0[1]); w.y = cvt_pk_bf16(v0[2], v0[3]); w.z = cvt_pk_bf16(v1[0], v1[1]); w.w = cvt_pk_bf16(v1[2], v1[3]);
                    *(u32x4*)(rowp + bj * HALF) = w; } }
    }
};
template <class Epi, class Sched, bool ALIGN_EPI = false, bool SP2 = false>
__device__ __forceinline__ void gemm_phase(PG8_LAS unsigned char* lds, const Gemm g, const Sched& S, const Epi& E) {
    const int tid = threadIdx.x, wid = __builtin_amdgcn_readfirstlane(tid >> 6), lane = tid & 63, wr = wid >> 2, wc = wid & 3, fr = lane & 15, fq = lane >> 4;
    const int K = g.K, nt = K / BK;
    unsigned voffA[2], voffB[2];
#pragma unroll
    for (int i = 0; i < 2; ++i) { int R, C; stage_rc(tid * 16 + i * 8192, R, C); const int Rb = Epi::PERM ? ((R & ~31) + perm32(R & 31)) : R;
        voffA[i] = (unsigned)(R * K + C) * 2u; voffB[i] = (unsigned)(Rb * K + C) * 2u; }
    const size_t kstep = (size_t)(BK * 2);
    const size_t hstep = (size_t)HALF * K * 2;
    const size_t tstep = 2 * hstep;
    const unsigned ldsw = (unsigned)wid * 1024u;
    const int aoff = lds_byte(wr * 64 + fr, fq * 8), boff = lds_byte(wc * 32 + fr, fq * 8);
#define PG8_SA(b, h) (((b) * 2 + (h)) * HTB)
#define PG8_SB(b, h) ((4 + (b) * 2 + (h)) * HTB)
#define PG8_STAGE(bufoff, gbase, voff) do { _Pragma("unroll") for (int _i = 0; _i < 2; ++_i) \
        __builtin_amdgcn_global_load_lds((const unsigned*)((const char*)(gbase) + (voff)[_i]), (PG8_LAS unsigned*)(lds + (bufoff) + ldsw + _i * 8192), 16, 0, 0); } while (0)
#define PG8_LDA(dst, b, h) do { _Pragma("unroll") for (int m = 0; m < 4; ++m) _Pragma("unroll") for (int k = 0; k < 2; ++k) dst[m][k] = *(const PG8_LAS bf16x8*)(lds + PG8_SA(b, h) + aoff + m * 2048 + k * 1024); } while (0)
#define PG8_LDB(dst, b, h) do { _Pragma("unroll") for (int n = 0; n < 2; ++n) _Pragma("unroll") for (int k = 0; k < 2; ++k) dst[n][k] = *(const PG8_LAS bf16x8*)(lds + PG8_SB(b, h) + boff + n * 2048 + k * 1024); } while (0)
#define PG8_MMA(ai, bj, At, Bt) do { __builtin_amdgcn_s_setprio(1); _Pragma("unroll") for (int m = 0; m < 4; ++m) _Pragma("unroll") for (int n = 0; n < 2; ++n) _Pragma("unroll") for (int k = 0; k < 2; ++k) \
        acc[ai][bj][m][n] = __builtin_amdgcn_mfma_f32_16x16x32_bf16(Bt[n][k], At[m][k], acc[ai][bj][m][n], 0, 0, 0); __builtin_amdgcn_s_setprio(0); } while (0)
#define PG8_WAIT_V(n) asm volatile("s_waitcnt vmcnt(" #n ")" ::: "memory")
#define PG8_WAIT_L(n) asm volatile("s_waitcnt lgkmcnt(" #n ")" ::: "memory")
#define PG8_BAR __builtin_amdgcn_s_barrier()
#define PG8_SCHED __builtin_amdgcn_sched_barrier(0)
    Unit cur, nxt; int ui = 0;
    if (!S.next(0, cur)) return;
    f32x4 acc[2][2][4][2];
#pragma unroll
    for (int a = 0; a < 2; ++a)
#pragma unroll
        for (int b = 0; b < 2; ++b)
#pragma unroll
            for (int m = 0; m < 4; ++m)
#pragma unroll
                for (int n = 0; n < 2; ++n) acc[a][b][m][n] = (f32x4){0.f, 0.f, 0.f, 0.f};
    bf16x8 At[4][2], B0[2][2], B1[2][2];
    const char* cA = (const char*)g.A + (size_t)cur.pm * tstep; const char* cB = (const char*)g.Bt + (size_t)cur.pn * tstep;
    S.a_ready(cur);
    if constexpr (SP2) {
        PG8_STAGE(PG8_SB(0, 0), cB, voffB); PG8_STAGE(PG8_SB(0, 1), cB + hstep, voffB); PG8_STAGE(PG8_SA(0, 0), cA, voffA); PG8_STAGE(PG8_SA(0, 1), cA + hstep, voffA);
        if (wr == 1) PG8_BAR;
        PG8_WAIT_V(2); PG8_BAR;
        PG8_STAGE(PG8_SB(1, 0), cB + kstep, voffB); PG8_STAGE(PG8_SA(1, 0), cA + kstep, voffA); PG8_STAGE(PG8_SB(1, 1), cB + hstep + kstep, voffB);
        PG8_WAIT_V(6); PG8_BAR;
    } else {
        PG8_STAGE(PG8_SB(0, 0), cB, voffB); PG8_STAGE(PG8_SA(0, 0), cA, voffA); PG8_STAGE(PG8_SB(0, 1), cB + hstep, voffB); PG8_STAGE(PG8_SA(0, 1), cA + hstep, voffA);
        if (wr == 1) PG8_BAR;
        PG8_WAIT_V(4); PG8_BAR;
        PG8_STAGE(PG8_SB(1, 0), cB + kstep, voffB); PG8_STAGE(PG8_SA(1, 0), cA + kstep, voffA); PG8_STAGE(PG8_SB(1, 1), cB + hstep + kstep, voffB);
        PG8_WAIT_V(6); PG8_BAR;
    }
    for (;;) {
        const bool has_next = S.next(ui + 1, nxt);
        const char* nA = has_next ? (const char*)g.A + (size_t)nxt.pm * tstep : cA; const char* nB = has_next ? (const char*)g.Bt + (size_t)nxt.pn * tstep : cB;
        for (int t = 0; t < nt; t += 2) {
            const bool last = (t == nt - 2);
            const char* a1 = cA + (size_t)(t + 1) * kstep;
            const char* a2 = last ? nA : cA + (size_t)(t + 2) * kstep; const char* b2 = last ? nB : cB + (size_t)(t + 2) * kstep;
            const char* a3 = a2 + kstep; const char* b3 = b2 + kstep;
            if (last && has_next) S.a_ready(nxt);
            if constexpr (SP2) {
            PG8_LDB(B0, 0, 0); PG8_LDB(B1, 0, 1); PG8_SCHED; PG8_LDA(At, 0, 0); PG8_STAGE(PG8_SA(1, 1), a1 + hstep, voffA);
            PG8_WAIT_V(8); PG8_WAIT_L(0); PG8_BAR; PG8_MMA(0, 0, At, B0); PG8_MMA(0, 1, At, B1); PG8_BAR; PG8_SCHED;
            PG8_LDA(At, 0, 1); PG8_STAGE(PG8_SB(0, 0), b2, voffB); PG8_STAGE(PG8_SB(0, 1), b2 + hstep, voffB); PG8_STAGE(PG8_SA(0, 0), a2, voffA);
            PG8_WAIT_V(8); PG8_WAIT_L(0); PG8_BAR; PG8_MMA(1, 0, At, B0); PG8_MMA(1, 1, At, B1); PG8_BAR; PG8_SCHED;
            PG8_LDB(B0, 1, 0); PG8_LDB(B1, 1, 1); PG8_SCHED; PG8_LDA(At, 1, 0); PG8_STAGE(PG8_SA(0, 1), a2 + hstep, voffA);
            PG8_WAIT_V(8); PG8_WAIT_L(0); PG8_BAR; PG8_MMA(0, 0, At, B0); PG8_MMA(0, 1, At, B1); PG8_BAR; PG8_SCHED;
            PG8_LDA(At, 1, 1); PG8_STAGE(PG8_SB(1, 0), b3, voffB); PG8_STAGE(PG8_SB(1, 1), b3 + hstep, voffB); PG8_STAGE(PG8_SA(1, 0), a3, voffA);
            PG8_WAIT_V(8); PG8_WAIT_L(0); PG8_BAR; PG8_MMA(1, 0, At, B0); PG8_MMA(1, 1, At, B1); PG8_BAR; PG8_SCHED;
            } else {
            PG8_LDB(B0, 0, 0); PG8_SCHED; PG8_LDA(At, 0, 0); PG8_STAGE(PG8_SA(1, 1), a1 + hstep, voffA);
            PG8_WAIT_L(8); PG8_BAR; PG8_WAIT_L(0); PG8_MMA(0, 0, At, B0); PG8_BAR; PG8_SCHED;
            PG8_LDB(B1, 0, 1); PG8_STAGE(PG8_SB(0, 0), b2, voffB);
            PG8_BAR; PG8_WAIT_L(0); PG8_MMA(0, 1, At, B1); PG8_BAR;
            PG8_LDA(At, 0, 1); PG8_STAGE(PG8_SA(0, 0), a2, voffA);
            PG8_BAR; PG8_WAIT_L(0); PG8_MMA(1, 0, At, B0); PG8_BAR; PG8_SCHED;
            PG8_STAGE(PG8_SB(0, 1), b2 + hstep, voffB);
            PG8_WAIT_V(6); PG8_BAR; PG8_MMA(1, 1, At, B1); PG8_BAR;
            PG8_LDB(B0, 1, 0); PG8_SCHED; PG8_LDA(At, 1, 0); PG8_STAGE(PG8_SA(0, 1), a2 + hstep, voffA);
            PG8_WAIT_L(8); PG8_BAR; PG8_WAIT_L(0); PG8_MMA(0, 0, At, B0); PG8_BAR; PG8_SCHED;
            PG8_LDB(B1, 1, 1); PG8_STAGE(PG8_SB(1, 0), b3, voffB);
            PG8_BAR; PG8_WAIT_L(0); PG8_MMA(0, 1, At, B1); PG8_BAR;
            PG8_LDA(At, 1, 1); PG8_STAGE(PG8_SA(1, 0), a3, voffA);
            PG8_BAR; PG8_WAIT_L(0); PG8_MMA(1, 0, At, B0); PG8_BAR; PG8_SCHED;
            PG8_STAGE(PG8_SB(1, 1), b3 + hstep, voffB);
            PG8_WAIT_V(6); PG8_BAR; PG8_MMA(1, 1, At, B1); PG8_BAR;
            }
        }
        if constexpr (ALIGN_EPI) { if (wr == 0) PG8_BAR; }
        if constexpr (!Epi::AFTER_DRAIN) { E(acc, cur, wr, wc, fr, fq); S.done(cur); }
        if (!has_next) break;
#pragma unroll
        for (int a = 0; a < 2; ++a)
#pragma unroll
            for (int b = 0; b < 2; ++b)
#pragma unroll
                for (int m = 0; m < 4; ++m)
#pragma unroll
                    for (int n = 0; n < 2; ++n) acc[a][b][m][n] = (f32x4){0.f, 0.f, 0.f, 0.f};
        cur = nxt; cA = nA; cB = nB; ++ui;
        if constexpr (ALIGN_EPI) { if (wr == 1) PG8_BAR; }
    }
    PG8_WAIT_V(0);
    if constexpr (!ALIGN_EPI) { if (wr == 0) PG8_BAR; }
    PG8_BAR;
    if constexpr (Epi::AFTER_DRAIN) { E.fused(acc, cur, wr, wc, fr, fq, lds, wid, lane); S.done(cur); }
#undef PG8_SA
#undef PG8_SB
#undef PG8_STAGE
#undef PG8_LDA
#undef PG8_LDB
#undef PG8_MMA
#undef PG8_WAIT_V
#undef PG8_WAIT_L
#undef PG8_BAR
#undef PG8_SCHED
}
}

#define LAS __attribute__((address_space(3)))
typedef unsigned short bf16;
typedef float f32x4 __attribute__((ext_vector_type(4)));
typedef float f32x2 __attribute__((ext_vector_type(2)));
typedef float f32x16 __attribute__((ext_vector_type(16)));
typedef short bf16x8 __attribute__((ext_vector_type(8)));
typedef short s16x4 __attribute__((ext_vector_type(4)));
typedef unsigned u32x4 __attribute__((ext_vector_type(4)));
typedef unsigned u32x2 __attribute__((ext_vector_type(2)));

constexpr int NB = 4, SEQ = 8192, DM = 1024, NTOK = NB * SEQ, MROWS = NTOK + 256, META_ROW = NTOK;
constexpr int INC = 4608, DFF = 2816, KVW = 256;
constexpr int NGRP = 64, NST = 64, CHUNK = 256, NCHUNK = SEQ / CHUNK;
constexpr float EPS = 1e-6f;
constexpr int NTHREADS = 512, NWAVES = 8;
constexpr int LDS_BYTES = 147456;

constexpr size_t MiB = 1u << 20;
constexpr size_t WS_RSTDX = 0;
constexpr size_t WS_ROWSS = 256 * 1024;
constexpr size_t WS_ROWSA = 384 * 1024;
constexpr size_t WS_ROWSB = 800 * 1024;
constexpr size_t WS_ATAB = 512 * 1024;
constexpr size_t WS_ATAB2 = 512 * 1024 + 32768;
constexpr size_t WS_SMETA = 512 * 1024 + 65536;
constexpr size_t WS_BB = 1 * MiB;
constexpr size_t WS_CM = 1 * MiB + 262144;
constexpr size_t WS_WG = 7 * MiB;
constexpr int NQKVU = 2560;
constexpr size_t WS_W1 = 2 * MiB, WS_W2 = 11 * MiB, WS_W3 = 15 * MiB, WS_W4 = 17 * MiB, WS_W5 = 28 * MiB;
constexpr size_t WS_E = 34 * MiB;
constexpr size_t ROWBUF = (size_t)MROWS * DM * 2;
constexpr size_t WS_XB = 44 * MiB;
constexpr size_t WS_Q = 110 * MiB;
constexpr size_t WS_K = 175 * MiB, WS_V = 192 * MiB;
constexpr size_t WS_U = 209 * MiB;
constexpr size_t WS_GA = 274 * MiB, WS_GS = 339 * MiB;
constexpr size_t WS_ATT = 404 * MiB;
constexpr size_t WS_ACT = 110 * MiB;
constexpr size_t WS_END = 470 * MiB;
static_assert(WS_XB + ROWBUF <= WS_Q && WS_Q + ROWBUF <= WS_K && WS_U + ROWBUF <= WS_GA && WS_GA + ROWBUF <= WS_GS && WS_GS + ROWBUF <= WS_ATT && WS_ATT + ROWBUF <= WS_END, "ws map");
static_assert(WS_K + (size_t)MROWS * KVW * 2 <= WS_V && WS_V + (size_t)MROWS * KVW * 2 <= WS_U, "ws map kv");
static_assert(WS_ACT + (size_t)NTOK * DFF * 2 <= WS_GS, "act overlay");

__device__ __forceinline__ unsigned cvt_pk(float lo, float hi) { unsigned r; asm volatile("v_cvt_pk_bf16_f32 %0, %1, %2" : "=v"(r) : "v"(lo), "v"(hi)); return r; }
__device__ __forceinline__ float bf_lo(unsigned w) { return __uint_as_float(w << 16); }
__device__ __forceinline__ float bf_hi(unsigned w) { return __uint_as_float(w & 0xffff0000u); }
__device__ __forceinline__ float fast_sigmoid(float v) { return __builtin_amdgcn_rcpf(1.0f + __builtin_amdgcn_exp2f(-1.4426950408889634f * v)); }
__device__ __forceinline__ float wave_sum(float v) {
#pragma unroll
    for (int o = 1; o < 64; o <<= 1) v += __shfl_xor(v, o);
    return v;
}
#define LDS_WAIT() asm volatile("s_waitcnt lgkmcnt(0)" ::: "memory")

struct EpiProj {
    static constexpr bool PERM = true, AFTER_DRAIN = false;
    bf16 *Q, *K, *V, *U; const float* rstd;
    __device__ __forceinline__ void operator()(const pg8::f32x4 (&acc)[2][2][4][2], const pg8::Unit& u, int wr, int wc, int fr, int fq) const {
        const int pn = u.pn; bf16* base; int ld, ct;
        if (pn < 4) { base = Q; ld = DM; ct = pn; } else if (pn == 4) { base = K; ld = KVW; ct = 0; } else if (pn == 5) { base = V; ld = KVW; ct = 0; } else { base = U; ld = DM; ct = pn - 6; }
        const int row0 = u.pm * 256 + wr * 64 + fr, col0 = ct * 256 + wc * 32 + 8 * fq;
        float rsv[8];
#pragma unroll
        for (int q = 0; q < 8; ++q) rsv[q] = rstd[row0 + (q >> 2) * 128 + (q & 3) * 16];
        asm volatile("" : "+v"(rsv[0]), "+v"(rsv[1]), "+v"(rsv[2]), "+v"(rsv[3]), "+v"(rsv[4]), "+v"(rsv[5]), "+v"(rsv[6]), "+v"(rsv[7]));
#pragma unroll
        for (int ai = 0; ai < 2; ++ai)
#pragma unroll
            for (int m = 0; m < 4; ++m) { const int row = row0 + ai * 128 + m * 16; const float rs = rsv[ai * 4 + m]; bf16* rowp = base + (size_t)row * ld + col0;
#pragma unroll
                for (int bj = 0; bj < 2; ++bj) { pg8::f32x4 v0 = acc[ai][bj][m][0] * rs, v1 = acc[ai][bj][m][1] * rs;
                    u32x4 w; w.x = cvt_pk(v0[0], v0[1]); w.y = cvt_pk(v0[2], v0[3]); w.z = cvt_pk(v1[0], v1[1]); w.w = cvt_pk(v1[2], v1[3]);
                    *(u32x4*)(rowp + bj * 128) = w; } }
    }
};
struct EpiMerge {
    static constexpr bool PERM = true, AFTER_DRAIN = false;
    const bf16* ATT; const bf16* SSM; bf16* MG; const float* rstd; const float* rowsa; const float* rowsb; const float* wa; const float* wsn;
    __device__ __forceinline__ void operator()(const pg8::f32x4 (&acc)[2][2][4][2], const pg8::Unit& u, int wr, int wc, int fr, int fq) const {
        const int row0 = u.pm * 256 + wr * 64 + fr, col0 = u.pn * 128 + wc * 32 + 8 * fq;
        const pg8::f32x4 wa0 = *(const pg8::f32x4*)(wa + col0), wa1 = *(const pg8::f32x4*)(wa + col0 + 4), ws0 = *(const pg8::f32x4*)(wsn + col0), ws1 = *(const pg8::f32x4*)(wsn + col0 + 4);
        float rsv[8], rav[8], rbv[8];
#pragma unroll
        for (int q = 0; q < 8; ++q) { const int row = row0 + (q >> 2) * 128 + (q & 3) * 16; rsv[q] = rstd[row]; rav[q] = rowsa[row]; rbv[q] = rowsb[row]; }
#pragma unroll
        for (int p = 0; p < 4; ++p) {
            u32x4 awv[2], swv[2];
#pragma unroll
            for (int m2 = 0; m2 < 2; ++m2) { const int q = p * 2 + m2; const size_t off = (size_t)(row0 + (q >> 2) * 128 + (q & 3) * 16) * DM + col0; awv[m2] = *(const u32x4*)(ATT + off); swv[m2] = *(const u32x4*)(SSM + off); }
            asm volatile("" : "+v"(awv[0]), "+v"(awv[1]), "+v"(swv[0]), "+v"(swv[1]));
#pragma unroll
            for (int m2 = 0; m2 < 2; ++m2) { const int q = p * 2 + m2, ai = q >> 2, m = q & 3; const int row = row0 + ai * 128 + m * 16; const size_t off = (size_t)row * DM + col0;
                const u32x4 aw = awv[m2], sw = swv[m2];
                const float rs = rsv[q], ra = __builtin_amdgcn_rsqf(rav[q] * (1.0f / DM) + EPS), rb = __builtin_amdgcn_rsqf(rbv[q] * (1.0f / DM) + EPS);
                const float av[8] = {bf_lo(aw.x), bf_hi(aw.x), bf_lo(aw.y), bf_hi(aw.y), bf_lo(aw.z), bf_hi(aw.z), bf_lo(aw.w), bf_hi(aw.w)};
                const float sv[8] = {bf_lo(sw.x), bf_hi(sw.x), bf_lo(sw.y), bf_hi(sw.y), bf_lo(sw.z), bf_hi(sw.z), bf_lo(sw.w), bf_hi(sw.w)};
                float o[8];
#pragma unroll
                for (int n = 0; n < 2; ++n)
#pragma unroll
                    for (int e = 0; e < 4; ++e) { const float wl = n ? wa1[e] : wa0[e], vl = n ? ws1[e] : ws0[e];
                        o[n * 4 + e] = fast_sigmoid(acc[ai][0][m][n][e] * rs) * av[n * 4 + e] * (ra * wl) + fast_sigmoid(acc[ai][1][m][n][e] * rs) * sv[n * 4 + e] * (rb * vl); }
                u32x4 w; w.x = cvt_pk(o[0], o[1]); w.y = cvt_pk(o[2], o[3]); w.z = cvt_pk(o[4], o[5]); w.w = cvt_pk(o[6], o[7]);
                *(u32x4*)(MG + off) = w; }
        }
    }
};
struct EpiGlu {
    static constexpr bool PERM = true, AFTER_DRAIN = false;
    bf16* O; int ldc; float* rowsb;
    __device__ __forceinline__ void operator()(const pg8::f32x4 (&acc)[2][2][4][2], const pg8::Unit& u, int wr, int wc, int fr, int fq) const {
        const int row0 = u.pm * 256 + wr * 64 + fr, col0 = u.pn * 128 + wc * 32 + 8 * fq;
#pragma unroll
        for (int ai = 0; ai < 2; ++ai)
#pragma unroll
            for (int m = 0; m < 4; ++m) { const int row = row0 + ai * 128 + m * 16; float o[8]; float ss = 0.f;
#pragma unroll
                for (int n = 0; n < 2; ++n)
#pragma unroll
                    for (int e = 0; e < 4; ++e) { const float v = acc[ai][0][m][n][e] * fast_sigmoid(acc[ai][1][m][n][e]); o[n * 4 + e] = v; ss += v * v; }
                u32x4 w; w.x = cvt_pk(o[0], o[1]); w.y = cvt_pk(o[2], o[3]); w.z = cvt_pk(o[4], o[5]); w.w = cvt_pk(o[6], o[7]);
                *(u32x4*)(O + (size_t)row * ldc + col0) = w;
                ss += __shfl_xor(ss, 16); ss += __shfl_xor(ss, 32);
                if (fq == 0) atomicAdd(rowsb + row, ss); }
    }
};
struct EpiSwiglu {
    static constexpr bool PERM = true, AFTER_DRAIN = false;
    bf16* O; int ldc; const float* rowss;
    __device__ __forceinline__ void operator()(const pg8::f32x4 (&acc)[2][2][4][2], const pg8::Unit& u, int wr, int wc, int fr, int fq) const {
        const int row0 = u.pm * 256 + wr * 64 + fr, col0 = u.pn * 128 + wc * 32 + 8 * fq;
        float rsv[8];
#pragma unroll
        for (int q = 0; q < 8; ++q) rsv[q] = rowss[row0 + (q >> 2) * 128 + (q & 3) * 16];
        asm volatile("" : "+v"(rsv[0]), "+v"(rsv[1]), "+v"(rsv[2]), "+v"(rsv[3]), "+v"(rsv[4]), "+v"(rsv[5]), "+v"(rsv[6]), "+v"(rsv[7]));
#pragma unroll
        for (int ai = 0; ai < 2; ++ai)
#pragma unroll
            for (int m = 0; m < 4; ++m) { const int row = row0 + ai * 128 + m * 16; const float rs = __builtin_amdgcn_rsqf(rsv[ai * 4 + m] * (1.0f / DM) + EPS); float o[8];
#pragma unroll
                for (int n = 0; n < 2; ++n)
#pragma unroll
                    for (int e = 0; e < 4; ++e) { const float g = acc[ai][0][m][n][e] * rs, up = acc[ai][1][m][n][e] * rs; o[n * 4 + e] = g * fast_sigmoid(g) * up; }
                u32x4 w; w.x = cvt_pk(o[0], o[1]); w.y = cvt_pk(o[2], o[3]); w.z = cvt_pk(o[4], o[5]); w.w = cvt_pk(o[6], o[7]);
                *(u32x4*)(O + (size_t)row * ldc + col0) = w; }
    }
};
struct EpiResid1 {
    static constexpr bool PERM = true, AFTER_DRAIN = false;
    const bf16* XBp; bf16* HB; bf16* HL; float* rowss;
    __device__ __forceinline__ void operator()(const pg8::f32x4 (&acc)[2][2][4][2], const pg8::Unit& u, int wr, int wc, int fr, int fq) const {
        const int row0 = u.pm * 256 + wr * 64 + fr, col0 = u.pn * 256 + wc * 32 + 8 * fq;
#pragma unroll
        for (int ai = 0; ai < 2; ++ai) {
            u32x4 xwv[4][2];
#pragma unroll
            for (int m = 0; m < 4; ++m)
#pragma unroll
                for (int bj = 0; bj < 2; ++bj) xwv[m][bj] = *(const u32x4*)(XBp + (size_t)(row0 + ai * 128 + m * 16) * DM + col0 + bj * 128);
            asm volatile("" : "+v"(xwv[0][0]), "+v"(xwv[0][1]), "+v"(xwv[1][0]), "+v"(xwv[1][1]), "+v"(xwv[2][0]), "+v"(xwv[2][1]), "+v"(xwv[3][0]), "+v"(xwv[3][1]));
#pragma unroll
            for (int m = 0; m < 4; ++m) { const int row = row0 + ai * 128 + m * 16; float ss = 0.f;
#pragma unroll
                for (int bj = 0; bj < 2; ++bj) { const size_t off = (size_t)row * DM + col0 + bj * 128;
                    const u32x4 xw = xwv[m][bj];
                    const pg8::f32x4 h0 = (pg8::f32x4){bf_lo(xw.x), bf_hi(xw.x), bf_lo(xw.y), bf_hi(xw.y)} + acc[ai][bj][m][0], h1 = (pg8::f32x4){bf_lo(xw.z), bf_hi(xw.z), bf_lo(xw.w), bf_hi(xw.w)} + acc[ai][bj][m][1];
                    ss += (h0[0] * h0[0] + h0[1] * h0[1]) + (h0[2] * h0[2] + h0[3] * h0[3]) + (h1[0] * h1[0] + h1[1] * h1[1]) + (h1[2] * h1[2] + h1[3] * h1[3]);
                    u32x4 w; w.x = cvt_pk(h0[0], h0[1]); w.y = cvt_pk(h0[2], h0[3]); w.z = cvt_pk(h1[0], h1[1]); w.w = cvt_pk(h1[2], h1[3]);
                    *(u32x4*)(HB + off) = w;
                    u32x4 l; l.x = cvt_pk(h0[0] - bf_lo(w.x), h0[1] - bf_hi(w.x)); l.y = cvt_pk(h0[2] - bf_lo(w.y), h0[3] - bf_hi(w.y)); l.z = cvt_pk(h1[0] - bf_lo(w.z), h1[1] - bf_hi(w.z)); l.w = cvt_pk(h1[2] - bf_lo(w.w), h1[3] - bf_hi(w.w));
                    *(u32x4*)(HL + off) = l; }
                ss += __shfl_xor(ss, 16); ss += __shfl_xor(ss, 32);
                if (fq == 0) atomicAdd(rowss + row, ss); }
        }
    }
};
struct EpiResid2 {
    static constexpr bool PERM = true, AFTER_DRAIN = false;
    const bf16* HB; const bf16* HL; float* out;
    __device__ __forceinline__ void operator()(const pg8::f32x4 (&acc)[2][2][4][2], const pg8::Unit& u, int wr, int wc, int fr, int fq) const {
        const int row0 = u.pm * 256 + wr * 64 + fr, col0 = u.pn * 256 + wc * 32 + 8 * fq;
#pragma unroll
        for (int p = 0; p < 4; ++p) {
            u32x4 hv[2][2], lv[2][2];
#pragma unroll
            for (int m2 = 0; m2 < 2; ++m2)
#pragma unroll
                for (int bj = 0; bj < 2; ++bj) { const int q = p * 2 + m2; const size_t off = (size_t)(row0 + (q >> 2) * 128 + (q & 3) * 16) * DM + col0 + bj * 128; hv[m2][bj] = *(const u32x4*)(HB + off); lv[m2][bj] = *(const u32x4*)(HL + off); }
            asm volatile("" : "+v"(hv[0][0]), "+v"(hv[0][1]), "+v"(hv[1][0]), "+v"(hv[1][1]), "+v"(lv[0][0]), "+v"(lv[0][1]), "+v"(lv[1][0]), "+v"(lv[1][1]));
#pragma unroll
            for (int m2 = 0; m2 < 2; ++m2) { const int q = p * 2 + m2, ai = q >> 2, m = q & 3; const int row = row0 + ai * 128 + m * 16;
#pragma unroll
                for (int bj = 0; bj < 2; ++bj) { const size_t off = (size_t)row * DM + col0 + bj * 128;
                    const u32x4 h = hv[m2][bj], l = lv[m2][bj];
                    *(pg8::f32x4*)(out + off) = ((pg8::f32x4){bf_lo(h.x), bf_hi(h.x), bf_lo(h.y), bf_hi(h.y)} + (pg8::f32x4){bf_lo(l.x), bf_hi(l.x), bf_lo(l.y), bf_hi(l.y)}) + acc[ai][bj][m][0];
                    *(pg8::f32x4*)(out + off + 4) = ((pg8::f32x4){bf_lo(h.z), bf_hi(h.z), bf_lo(h.w), bf_hi(h.w)} + (pg8::f32x4){bf_lo(l.z), bf_hi(l.z), bf_lo(l.w), bf_hi(l.w)}) + acc[ai][bj][m][1]; } }
        }
    }
};

constexpr int TP = 65, T_SCR_BYTES = 64 * TP * 4;
__device__ __forceinline__ void transpose_item(const float* W, int ldw, const float* gk, int K, int N, bf16* WT, bool glu, LAS float* scr, int item, int lane) {
    const int nblk = N / 64, kb = item / nblk, nb = item % nblk, k0 = 64 * kb, n0 = 64 * nb;
    const int kq = lane >> 4, n4 = (lane & 15) * 4;
    f32x4 v[16];
#pragma unroll
    for (int i = 0; i < 16; ++i) v[i] = *(const f32x4*)(W + (size_t)(k0 + 4 * i + kq) * ldw + n0 + n4);
#pragma unroll
    for (int i = 0; i < 16; ++i) { LAS float* d = scr + (4 * i + kq) * TP + n4; d[0] = v[i].x; d[1] = v[i].y; d[2] = v[i].z; d[3] = v[i].w; }
    LDS_WAIT(); asm volatile("" ::: "memory");
    int d0 = n0; if (glu) { const int half = N / 2, bj = n0 / half, j = n0 % half; d0 = 256 * (j / 128) + 128 * bj + (j % 128); }
    const int c = lane & 7;
    float g[8];
#pragma unroll
    for (int e2 = 0; e2 < 8; ++e2) g[e2] = gk ? gk[k0 + 8 * c + e2] : 1.0f;
#pragma unroll
    for (int j = 0; j < 8; ++j) { const int n = (lane >> 3) + 8 * j; const LAS float* s = scr + (8 * c) * TP + n;
        u32x4 o; o.x = cvt_pk(s[0 * TP] * g[0], s[1 * TP] * g[1]); o.y = cvt_pk(s[2 * TP] * g[2], s[3 * TP] * g[3]); o.z = cvt_pk(s[4 * TP] * g[4], s[5 * TP] * g[5]); o.w = cvt_pk(s[6 * TP] * g[6], s[7 * TP] * g[7]);
        *(u32x4*)(WT + (size_t)(d0 + n) * K + k0 + 8 * c) = o; }
    LDS_WAIT(); asm volatile("" ::: "memory");
}

__device__ __forceinline__ void sincos_small(float x, float& s, float& c) {
    const float n = rintf(x * 0.6366197723675814f);
    float r = fmaf(-n, 1.5703125f, x); r = fmaf(-n, 4.837512969970703125e-4f, r); r = fmaf(-n, 7.54978995489188216e-8f, r);
    const float z = r * r;
    const float sp = r + r * z * (-1.6666654611e-1f + z * (8.3321608736e-3f + z * -1.9515295891e-4f));
    const float cp = 1.0f - 0.5f * z + z * z * (4.166664568298827e-2f + z * (-1.388731625493765e-3f + z * 2.443315711809948e-5f));
    const int q = ((int)n) & 3;
    const float ss = (q & 1) ? cp : sp, cc = (q & 1) ? sp : cp;
    s = (q & 2) ? -ss : ss; c = ((q + 1) & 2) ? -cc : cc;
}

struct Args { const float* in[22]; float* out; unsigned char* ws; long long never; };

__device__ __forceinline__ void p0_prologue(const Args& a, LAS unsigned char* lds, int wave, int lane) {
    unsigned char* ws = a.ws;
    LAS float* scr = (LAS float*)(lds + wave * 16896);
    const int gw = blockIdx.x * NWAVES + wave, NGW = gridDim.x * NWAVES;
    constexpr int I1 = (DM / 64) * (NQKVU / 64), IG = (DM / 64) * (2048 / 64), I2 = (DM / 64) * (2048 / 64), I3 = (DM / 64) * (DM / 64), I4 = (DM / 64) * (2 * DFF / 64), I5 = (DFF / 64) * (DM / 64);
    static_assert(T_SCR_BYTES <= 16896 && 8 * 16896 <= LDS_BYTES - 1024, "transpose scratch");
    constexpr int NITEMS = I1 + IG + I2 + I3 + I4 + I5;
    for (int it = gw; it < NITEMS; it += NGW) {
        int r = it;
        if (r < I1) { transpose_item(a.in[3], INC, a.in[2], DM, NQKVU, (bf16*)(ws + WS_W1), false, scr, r, lane); continue; } r -= I1;
        if (r < IG) { transpose_item(a.in[3] + NQKVU, INC, a.in[2], DM, 2048, (bf16*)(ws + WS_WG), true, scr, r, lane); continue; } r -= IG;
        if (r < I2) { transpose_item(a.in[15], 2048, nullptr, DM, 2048, (bf16*)(ws + WS_W2), true, scr, r, lane); continue; } r -= I2;
        if (r < I3) { transpose_item(a.in[18], DM, nullptr, DM, DM, (bf16*)(ws + WS_W3), false, scr, r, lane); continue; } r -= I3;
        if (r < I4) { transpose_item(a.in[20], 2 * DFF, a.in[19], DM, 2 * DFF, (bf16*)(ws + WS_W4), true, scr, r, lane); continue; } r -= I4;
        transpose_item(a.in[21], DM, nullptr, DFF, DM, (bf16*)(ws + WS_W5), false, scr, r, lane);
    }
    bf16* XB = (bf16*)(ws + WS_XB); float* rstdx = (float*)(ws + WS_RSTDX);
    for (int m0 = gw; m0 < NTOK + 16; m0 += 2 * NGW) {
        const int m1 = m0 + NGW; const bool has1 = m1 < NTOK + 16; const int m1c = has1 ? m1 : m0;
        const float* src0 = m0 < NTOK ? a.in[0] + (size_t)m0 * DM : a.in[1] + (size_t)(m0 - NTOK) * DM;
        const float* src1 = m1c < NTOK ? a.in[0] + (size_t)m1c * DM : a.in[1] + (size_t)(m1c - NTOK) * DM;
        f32x4 v0[4], v1[4]; float s0 = 0.f, s1 = 0.f;
#pragma unroll
        for (int j = 0; j < 4; ++j) { v0[j] = ((const f32x4*)src0)[lane + 64 * j]; v1[j] = ((const f32x4*)src1)[lane + 64 * j]; }
#pragma unroll
        for (int j = 0; j < 4; ++j) { s0 += (v0[j].x * v0[j].x + v0[j].y * v0[j].y) + (v0[j].z * v0[j].z + v0[j].w * v0[j].w); s1 += (v1[j].x * v1[j].x + v1[j].y * v1[j].y) + (v1[j].z * v1[j].z + v1[j].w * v1[j].w); }
        u32x2* o0 = (u32x2*)(XB + (size_t)m0 * DM) + lane; u32x2* o1 = (u32x2*)(XB + (size_t)m1c * DM) + lane;
#pragma unroll
        for (int j = 0; j < 4; ++j) { u32x2 w; w.x = cvt_pk(v0[j].x, v0[j].y); w.y = cvt_pk(v0[j].z, v0[j].w); o0[64 * j] = w; }
        if (has1) {
#pragma unroll
            for (int j = 0; j < 4; ++j) { u32x2 w; w.x = cvt_pk(v1[j].x, v1[j].y); w.y = cvt_pk(v1[j].z, v1[j].w); o1[64 * j] = w; } }
        s0 = wave_sum(s0); s1 = wave_sum(s1);
        if (lane == 0) { rstdx[m0] = __builtin_amdgcn_rsqf(s0 * (1.0f / DM) + EPS); if (has1) rstdx[m1] = __builtin_amdgcn_rsqf(s1 * (1.0f / DM) + EPS); }
    }
    const int gt = blockIdx.x * NTHREADS + threadIdx.x, NGT = gridDim.x * NTHREADS;
    float* rowss = (float*)(ws + WS_ROWSS);
    float* rowsa = (float*)(ws + WS_ROWSA); float* rowsb = (float*)(ws + WS_ROWSB);
    for (int i = gt; i < NTOK; i += NGT) { rowss[i] = 0.f; rowsa[i] = 0.f; rowsb[i] = 0.f; }
    if (gt < NGRP * NST) {
        const int g = gt >> 6, p = gt & 63;
        const float dt = expf(a.in[9][g]), lr = a.in[7][gt], li = a.in[8][gt];
        const float mag = expf(lr * dt); float sn, cs; sincos_small(li * dt, sn, cs);
        const float ar = mag * cs, ai = mag * sn, den = lr * lr + li * li, nr = ar - 1.0f, ni = ai;
        const float fr = (nr * lr + ni * li) / den, fi = (ni * lr - nr * li) / den;
        ((f32x2*)(ws + WS_ATAB))[gt] = (f32x2){ar, ai};
        float pr = ar, pi = ai;
#pragma unroll
        for (int i = 0; i < 8; ++i) { const float tr = pr * pr - pi * pi, ti = 2.0f * pr * pi; pr = tr; pi = ti; }
        ((f32x2*)(ws + WS_ATAB2))[gt] = (f32x2){pr, pi};
        bf16* BB = (bf16*)(ws + WS_BB); bf16* CM = (bf16*)(ws + WS_CM);
        const int rre = g * 128 + (p >> 5) * 64 + (p & 31), rim = rre + 32;
        const float* bre = a.in[10] + (size_t)gt * 16; const float* bim = a.in[11] + (size_t)gt * 16;
#pragma unroll
        for (int c = 0; c < 16; c += 2) {
            const float br0 = bre[c], bi0 = bim[c], br1 = bre[c + 1], bi1 = bim[c + 1];
            *(unsigned*)(BB + (size_t)rre * 16 + c) = cvt_pk(fr * br0 - fi * bi0, fr * br1 - fi * bi1);
            *(unsigned*)(BB + (size_t)rim * 16 + c) = cvt_pk(fr * bi0 + fi * br0, fr * bi1 + fi * br1);
        }
#pragma unroll
        for (int c = 0; c < 16; ++c) {
            const float cr = a.in[12][((size_t)g * 16 + c) * 64 + p], ci = a.in[13][((size_t)g * 16 + c) * 64 + p];
            *(unsigned*)(CM + ((size_t)g * 16 + c) * 128 + 2 * p) = cvt_pk(cr, -ci);
        }
    }
}

constexpr int KP = 144, VP = 144, NKEY = 416;
constexpr int ATT_K_OFF = 0, ATT_V_OFF = NKEY * KP;
static_assert(ATT_V_OFF + NKEY * VP <= 131072, "attention LDS");
__device__ __forceinline__ int crow(int r, int hi) { return (r & 3) + 8 * (r >> 2) + 4 * hi; }

__device__ __forceinline__ void attn_item(const Args& a, LAS unsigned char* lds, int item, int wave, int lane) {
    unsigned char* ws = a.ws;
    const bf16* QB = (const bf16*)(ws + WS_Q); const bf16* KB = (const bf16*)(ws + WS_K); const bf16* VB = (const bf16*)(ws + WS_V); bf16* ATT = (bf16*)(ws + WS_ATT);
    const int blk0 = (item & 31) * 2, kvh = (item >> 5) & 3, b = item >> 7;
    const int tid = threadIdx.x;
    const float* knw = a.in[5];
    for (int idx = tid; idx < NKEY * 8; idx += NTHREADS) {
        const int key = idx >> 3, ck = idx & 7; int row = -1;
        if (key < 16) row = META_ROW + key;
        else if (key < 32) row = -1;
        else if (key < 160) row = blk0 > 0 ? b * SEQ + (blk0 - 1) * 128 + (key - 32) : -1;
        else row = b * SEQ + blk0 * 128 + (key - 160);
        u32x4 kw = (u32x4){0u, 0u, 0u, 0u}, vw = (u32x4){0u, 0u, 0u, 0u};
        if (row >= 0) { kw = *(const u32x4*)(KB + (size_t)row * KVW + kvh * 64 + ck * 8); vw = *(const u32x4*)(VB + (size_t)row * KVW + kvh * 64 + ck * 8); }
        float kf[8] = {bf_lo(kw.x), bf_hi(kw.x), bf_lo(kw.y), bf_hi(kw.y), bf_lo(kw.z), bf_hi(kw.z), bf_lo(kw.w), bf_hi(kw.w)};
        float ss = 0.f;
#pragma unroll
        for (int e = 0; e < 8; ++e) ss += kf[e] * kf[e];
        ss += __shfl_xor(ss, 1); ss += __shfl_xor(ss, 2); ss += __shfl_xor(ss, 4);
        const float rs = __builtin_amdgcn_rsqf(ss * (1.0f / 64.0f) + EPS);
        const f32x4 g0 = *(const f32x4*)(knw + ck * 8), g1 = *(const f32x4*)(knw + ck * 8 + 4);
        u32x4 o; o.x = cvt_pk(kf[0] * rs * g0.x, kf[1] * rs * g0.y); o.y = cvt_pk(kf[2] * rs * g0.z, kf[3] * rs * g0.w);
        o.z = cvt_pk(kf[4] * rs * g1.x, kf[5] * rs * g1.y); o.w = cvt_pk(kf[6] * rs * g1.z, kf[7] * rs * g1.w);
        *(LAS u32x4*)(lds + ATT_K_OFF + key * KP + ck * 16) = o;
        *(LAS u32x4*)(lds + ATT_V_OFF + key * VP + ck * 16) = vw;
    }
    __syncthreads();
    const int r = wave >> 1, qh = wave & 1, hq = kvh * 4 + r, ql = lane & 31, hi = lane >> 5;
    const float sink = a.in[6][hq];
    const float* qnw = a.in[4];
    const float L2E = 1.4426950408889634f;
    for (int q4 = 0; q4 < 4; ++q4) {
        const int bl = q4 >> 1, qb = q4 & 1, blk = blk0 + bl;
        const int qblk = 2 * qh + qb;
        const size_t qrow = (size_t)b * SEQ + blk * 128 + qblk * 32 + ql;
        bf16x8 qf[4];
        {
            u32x4 qw[4]; float ss = 0.f;
#pragma unroll
            for (int ks = 0; ks < 4; ++ks) { qw[ks] = *(const u32x4*)(QB + qrow * DM + hq * 64 + 16 * ks + 8 * hi);
                const unsigned ww[4] = {qw[ks].x, qw[ks].y, qw[ks].z, qw[ks].w};
#pragma unroll
                for (int e = 0; e < 4; ++e) { const float lo = bf_lo(ww[e]), h2 = bf_hi(ww[e]); ss += lo * lo + h2 * h2; } }
            ss += __shfl_xor(ss, 32);
            const float rs = __builtin_amdgcn_rsqf(ss * (1.0f / 64.0f) + EPS) * 0.125f;
#pragma unroll
            for (int ks = 0; ks < 4; ++ks) { const f32x4 g0 = *(const f32x4*)(qnw + 16 * ks + 8 * hi), g1 = *(const f32x4*)(qnw + 16 * ks + 8 * hi + 4);
                u32x4 o; o.x = cvt_pk(bf_lo(qw[ks].x) * rs * g0.x, bf_hi(qw[ks].x) * rs * g0.y); o.y = cvt_pk(bf_lo(qw[ks].y) * rs * g0.z, bf_hi(qw[ks].y) * rs * g0.w);
                o.z = cvt_pk(bf_lo(qw[ks].z) * rs * g1.x, bf_hi(qw[ks].z) * rs * g1.y); o.w = cvt_pk(bf_lo(qw[ks].w) * rs * g1.z, bf_hi(qw[ks].w) * rs * g1.w);
                qf[ks] = __builtin_bit_cast(bf16x8, o); }
        }
        f32x16 S[6];
#pragma unroll
        for (int i = 0; i < 6; ++i) {
            const int kb = (i == 0) ? 0 : 4 * bl + qblk + i;
            f32x16 acc;
#pragma unroll
            for (int e = 0; e < 16; ++e) acc[e] = 0.f;
#pragma unroll
            for (int ks = 0; ks < 4; ++ks) { const bf16x8 kf = *(const LAS bf16x8*)(lds + ATT_K_OFF + (kb * 32 + ql) * KP + (16 * ks + 8 * hi) * 2);
                acc = __builtin_amdgcn_mfma_f32_32x32x16_bf16(kf, qf[ks], acc, 0, 0, 0); }
            S[i] = acc;
        }
        const float NEG = -INFINITY;
#pragma unroll
        for (int e = 0; e < 16; ++e) { const int kr = crow(e, hi);
            if (kr >= 16) S[0][e] = NEG;
            if (!(kr > ql)) S[1][e] = NEG;
            if (!(kr <= ql)) S[5][e] = NEG; }
        if (blk == 0) {
#pragma unroll
            for (int i = 1; i < 6; ++i) if (qblk + i <= 4) {
#pragma unroll
                for (int e = 0; e < 16; ++e) S[i][e] = NEG; }
        }
        float mx = sink;
#pragma unroll
        for (int i = 0; i < 6; ++i)
#pragma unroll
            for (int e = 0; e < 16; ++e) mx = fmaxf(mx, S[i][e]);
        mx = fmaxf(mx, __shfl_xor(mx, 32));
        float den = 0.f; const float mb = mx * L2E;
        bf16x8 pf[6][2];
#pragma unroll
        for (int i = 0; i < 6; ++i) {
            float ev[16];
#pragma unroll
            for (int e = 0; e < 16; ++e) { ev[e] = __builtin_amdgcn_exp2f(S[i][e] * L2E - mb); den += ev[e]; }
#pragma unroll
            for (int h = 0; h < 2; ++h) { u32x4 o; o.x = cvt_pk(ev[8 * h + 0], ev[8 * h + 1]); o.y = cvt_pk(ev[8 * h + 2], ev[8 * h + 3]); o.z = cvt_pk(ev[8 * h + 4], ev[8 * h + 5]); o.w = cvt_pk(ev[8 * h + 6], ev[8 * h + 7]);
                pf[i][h] = __builtin_bit_cast(bf16x8, o); }
        }
        den += __shfl_xor(den, 32);
        den += __builtin_amdgcn_exp2f(sink * L2E - mb);
        const float inv = 1.0f / den; float ssq = 0.f;
        const unsigned vlane = (unsigned)(size_t)lds + (unsigned)ATT_V_OFF + (unsigned)((4 * hi + ((lane & 15) >> 2)) * VP + (16 * ((lane >> 4) & 1) + 4 * (lane & 3)) * 2);
#pragma unroll
        for (int db = 0; db < 2; ++db) {
            f32x16 O;
#pragma unroll
            for (int e = 0; e < 16; ++e) O[e] = 0.f;
            const unsigned baseM = vlane + (unsigned)(db * 64), baseW = baseM + (unsigned)((4 * bl + qblk) * 32 * VP);
            u32x2 tv[24];
            asm volatile("ds_read_b64_tr_b16 %0, %24 offset:0\n\tds_read_b64_tr_b16 %1, %24 offset:1152\n\tds_read_b64_tr_b16 %2, %24 offset:2304\n\tds_read_b64_tr_b16 %3, %24 offset:3456\n\tds_read_b64_tr_b16 %4, %25 offset:4608\n\tds_read_b64_tr_b16 %5, %25 offset:5760\n\tds_read_b64_tr_b16 %6, %25 offset:6912\n\tds_read_b64_tr_b16 %7, %25 offset:8064\n\tds_read_b64_tr_b16 %8, %25 offset:9216\n\tds_read_b64_tr_b16 %9, %25 offset:10368\n\tds_read_b64_tr_b16 %10, %25 offset:11520\n\tds_read_b64_tr_b16 %11, %25 offset:12672\n\tds_read_b64_tr_b16 %12, %25 offset:13824\n\tds_read_b64_tr_b16 %13, %25 offset:14976\n\tds_read_b64_tr_b16 %14, %25 offset:16128\n\tds_read_b64_tr_b16 %15, %25 offset:17280\n\tds_read_b64_tr_b16 %16, %25 offset:18432\n\tds_read_b64_tr_b16 %17, %25 offset:19584\n\tds_read_b64_tr_b16 %18, %25 offset:20736\n\tds_read_b64_tr_b16 %19, %25 offset:21888\n\tds_read_b64_tr_b16 %20, %25 offset:23040\n\tds_read_b64_tr_b16 %21, %25 offset:24192\n\tds_read_b64_tr_b16 %22, %25 offset:25344\n\tds_read_b64_tr_b16 %23, %25 offset:26496\n\ts_waitcnt lgkmcnt(0)"
                         : "=&v"(tv[0]), "=&v"(tv[1]), "=&v"(tv[2]), "=&v"(tv[3]), "=&v"(tv[4]), "=&v"(tv[5]), "=&v"(tv[6]), "=&v"(tv[7]), "=&v"(tv[8]), "=&v"(tv[9]), "=&v"(tv[10]), "=&v"(tv[11]), "=&v"(tv[12]), "=&v"(tv[13]), "=&v"(tv[14]), "=&v"(tv[15]), "=&v"(tv[16]), "=&v"(tv[17]), "=&v"(tv[18]), "=&v"(tv[19]), "=&v"(tv[20]), "=&v"(tv[21]), "=&v"(tv[22]), "=&v"(tv[23])
                         : "v"(baseM), "v"(baseW) : "memory");
#pragma unroll
            for (int i = 0; i < 6; ++i) {
#pragma unroll
                for (int h = 0; h < 2; ++h) { const int k = (i * 2 + h) * 2;
                    const u32x4 vv = (u32x4){tv[k].x, tv[k].y, tv[k + 1].x, tv[k + 1].y};
                    O = __builtin_amdgcn_mfma_f32_32x32x16_bf16(__builtin_bit_cast(bf16x8, vv), pf[i][h], O, 0, 0, 0); } }
#pragma unroll
            for (int g = 0; g < 4; ++g) { const float o0 = O[4 * g] * inv, o1 = O[4 * g + 1] * inv, o2 = O[4 * g + 2] * inv, o3 = O[4 * g + 3] * inv; ssq += (o0 * o0 + o1 * o1) + (o2 * o2 + o3 * o3);
                u32x2 w; w.x = cvt_pk(o0, o1); w.y = cvt_pk(o2, o3);
                *(u32x2*)(ATT + qrow * DM + hq * 64 + db * 32 + 8 * g + 4 * hi) = w; }
        }
        ssq += __shfl_xor(ssq, 32);
        if (hi == 0) atomicAdd((float*)(ws + WS_ROWSA) + qrow, ssq);
    }
    __syncthreads();
}

constexpr int SP = 272;
__device__ __forceinline__ float gelu_tanh(float y) { const float t = y + 0.044715f * y * y * y; return y * __builtin_amdgcn_rcpf(1.0f + __builtin_amdgcn_exp2f(-2.302208198f * t)); }
__device__ __forceinline__ f32x2 pk_fma(f32x2 a, f32x2 b, f32x2 c) { return __builtin_elementwise_fma(a, b, c); }

template <bool FINAL>
__device__ __forceinline__ void ssm_item(const Args& a, LAS unsigned char* lds, int item, int wave, int lane) {
    static_assert(NCHUNK == 32 && CHUNK == 256, "item decode");
    unsigned char* ws = a.ws;
    const bf16* U = (const bf16*)(ws + WS_U); bf16* Z = (bf16*)(ws + WS_Q);
    float* E = (float*)(ws + WS_E);
    const bool meta = (!FINAL) && item >= 256;
    const int oct = item & 7, cp = (item >> 3) & 15, bp = (item >> 7) & 1;
    const int g = oct * 8 + wave, j = lane & 31, hi = lane >> 5;
    const int b0 = bp * 2, c0 = 2 * cp;
    bf16x8 bbf[4];
#pragma unroll
    for (int k = 0; k < 4; ++k) bbf[k] = *(const bf16x8*)((const bf16*)(ws + WS_BB) + ((size_t)g * 128 + k * 32 + j) * 16 + 8 * hi);
    const f32x2 a0 = ((const f32x2*)(ws + WS_ATAB))[g * 64 + j], a1 = ((const f32x2*)(ws + WS_ATAB))[g * 64 + 32 + j];
    const f32x2 a0x = (f32x2){a0.x, a0.x}, a0y = (f32x2){a0.y, a0.y}, na0y = (f32x2){-a0.y, -a0.y}, a1x = (f32x2){a1.x, a1.x}, a1y = (f32x2){a1.y, a1.y}, na1y = (f32x2){-a1.y, -a1.y};
    f32x2 s0r = (f32x2){0.f, 0.f}, s0i = s0r, s1r = s0r, s1i = s0r;
    bf16x8 cmf[4]; f32x4 dsk;
    if (FINAL) {
#pragma unroll
        for (int k = 0; k < 4; ++k) cmf[k] = *(const bf16x8*)((const bf16*)(ws + WS_CM) + ((size_t)g * 16 + (lane & 15)) * 128 + 32 * k + 8 * (lane >> 4));
        dsk = *(const f32x4*)(a.in[14] + g * 16 + 4 * (lane >> 4));
        const f32x2 t0 = ((const f32x2*)(ws + WS_ATAB2))[g * 64 + j], t1 = ((const f32x2*)(ws + WS_ATAB2))[g * 64 + 32 + j];
        const f32x2 m0 = ((const f32x2*)(ws + WS_SMETA))[g * 64 + j], m1 = ((const f32x2*)(ws + WS_SMETA))[g * 64 + 32 + j];
        float c0r = m0.x, c0i = m0.y, c1r = m1.x, c1i = m1.y;
        const f32x2* Eb = (const f32x2*)E + ((size_t)((b0 + hi) * 64 + g) * NCHUNK) * 64;
#pragma unroll
        for (int half = 0; half < 2; ++half) {
            if (half * 16 < c0) {
                f32x2 e0[16], e1[16];
#pragma unroll
                for (int c = 0; c < 16; ++c) { const int cc = half * 16 + c < NCHUNK - 1 ? half * 16 + c : NCHUNK - 2; e0[c] = Eb[cc * 64 + j]; e1[c] = Eb[cc * 64 + 32 + j]; }
#pragma unroll
                for (int c = 0; c < 16; ++c) if (half * 16 + c < c0) {
                    const float n0r = fmaf(t0.x, c0r, fmaf(-t0.y, c0i, e0[c].x)), n0i = fmaf(t0.x, c0i, fmaf(t0.y, c0r, e0[c].y));
                    const float n1r = fmaf(t1.x, c1r, fmaf(-t1.y, c1i, e1[c].x)), n1i = fmaf(t1.x, c1i, fmaf(t1.y, c1r, e1[c].y));
                    c0r = n0r; c0i = n0i; c1r = n1r; c1i = n1i; }
            }
        }
        const f32x2 ec0 = Eb[c0 * 64 + j], ec1 = Eb[c0 * 64 + 32 + j];
        s0r = (f32x2){c0r, fmaf(t0.x, c0r, fmaf(-t0.y, c0i, ec0.x))}; s0i = (f32x2){c0i, fmaf(t0.x, c0i, fmaf(t0.y, c0r, ec0.y))};
        s1r = (f32x2){c1r, fmaf(t1.x, c1r, fmaf(-t1.y, c1i, ec1.x))}; s1i = (f32x2){c1i, fmaf(t1.x, c1i, fmaf(t1.y, c1r, ec1.y))};
    }
    const int bsel = (j >> 2) & 1, csel = j & 1, tt = ((j & 3) >> 1) + 2 * (j >> 3);
    const size_t urow0 = meta ? (size_t)META_ROW + tt : (size_t)(b0 + bsel) * SEQ + (size_t)(c0 + csel) * CHUNK + tt;
    const bf16* up = U + urow0 * DM + g * 16 + 8 * hi;
    LAS unsigned char* sl = lds + wave * (32 * SP);
    const int nsteps = meta ? 2 : CHUNK / 8;
    const size_t erow = (size_t)b0 * SEQ + (size_t)(c0 + ((lane & 15) >> 3)) * CHUNK + (lane & 7);
    const bf16* ue = U + erow * DM + g * 16 + 4 * (lane >> 4);
    bf16* ze = Z + erow * DM + g * 16 + 4 * (lane >> 4);
    bf16x8 uf = *(const bf16x8*)up;
    u32x2 uu0 = (u32x2){0u, 0u}, uu1 = (u32x2){0u, 0u};
    if (FINAL) { uu0 = *(const u32x2*)ue; uu1 = *(const u32x2*)(ue + (size_t)SEQ * DM); }
    for (int st = 0; st < nsteps; ++st) {
        bf16x8 ufn = uf; u32x2 un0 = uu0, un1 = uu1;
        if (st + 1 < nsteps) { ufn = *(const bf16x8*)(up + (size_t)(st + 1) * 8 * DM);
            if (FINAL) { un0 = *(const u32x2*)(ue + (size_t)(st + 1) * 8 * DM); un1 = *(const u32x2*)(ue + (size_t)(st + 1) * 8 * DM + (size_t)SEQ * DM); } }
        f32x16 X[4];
#pragma unroll
        for (int k = 0; k < 4; ++k) { f32x16 z;
#pragma unroll
            for (int e = 0; e < 16; ++e) z[e] = 0.f;
            X[k] = __builtin_amdgcn_mfma_f32_32x32x16_bf16(uf, bbf[k], z, 0, 0, 0); }
#pragma unroll
        for (int t = 0; t < 8; ++t) {
            const f32x2 x0r = (f32x2){X[0][2 * t], X[0][2 * t + 1]}, x0i = (f32x2){X[1][2 * t], X[1][2 * t + 1]}, x1r = (f32x2){X[2][2 * t], X[2][2 * t + 1]}, x1i = (f32x2){X[3][2 * t], X[3][2 * t + 1]};
            const f32x2 n0r = pk_fma(a0x, s0r, pk_fma(na0y, s0i, x0r)), n0i = pk_fma(a0x, s0i, pk_fma(a0y, s0r, x0i));
            const f32x2 n1r = pk_fma(a1x, s1r, pk_fma(na1y, s1i, x1r)), n1i = pk_fma(a1x, s1i, pk_fma(a1y, s1r, x1i));
            s0r = n0r; s0i = n0i; s1r = n1r; s1i = n1i;
            if (FINAL) {
                LAS unsigned char* r0 = sl + ((hi * 2 + 0) * 8 + t) * SP; LAS unsigned char* r1 = sl + ((hi * 2 + 1) * 8 + t) * SP;
                *(LAS unsigned*)(r0 + j * 4) = cvt_pk(n0r.x, n0i.x); *(LAS unsigned*)(r0 + (32 + j) * 4) = cvt_pk(n1r.x, n1i.x);
                *(LAS unsigned*)(r1 + j * 4) = cvt_pk(n0r.y, n0i.y); *(LAS unsigned*)(r1 + (32 + j) * 4) = cvt_pk(n1r.y, n1i.y); }
        }
        if (FINAL) {
            LDS_WAIT(); asm volatile("" ::: "memory");
#pragma unroll
            for (int bh = 0; bh < 2; ++bh) {
                f32x4 Y = (f32x4){0.f, 0.f, 0.f, 0.f};
#pragma unroll
                for (int k = 0; k < 4; ++k) { const bf16x8 sf = *(const LAS bf16x8*)(sl + (bh * 16 + (lane & 15)) * SP + (32 * k + 8 * (lane >> 4)) * 2);
                    Y = __builtin_amdgcn_mfma_f32_16x16x32_bf16(cmf[k], sf, Y, 0, 0, 0); }
                const u32x2 uu = bh ? uu1 : uu0;
                const float y0 = Y[0] + dsk.x * bf_lo(uu.x), y1 = Y[1] + dsk.y * bf_hi(uu.x), y2 = Y[2] + dsk.z * bf_lo(uu.y), y3 = Y[3] + dsk.w * bf_hi(uu.y);
                u32x2 w; w.x = cvt_pk(gelu_tanh(y0), gelu_tanh(y1)); w.y = cvt_pk(gelu_tanh(y2), gelu_tanh(y3));
                *(u32x2*)(ze + (size_t)st * 8 * DM + (size_t)bh * SEQ * DM) = w;
            }
            LDS_WAIT(); asm volatile("" ::: "memory");
        }
        uf = ufn; uu0 = un0; uu1 = un1;
    }
    if (!FINAL) {
        if (meta) { if (hi == 0) { ((f32x2*)(ws + WS_SMETA))[g * 64 + j] = (f32x2){s0r.x, s0i.x}; ((f32x2*)(ws + WS_SMETA))[g * 64 + 32 + j] = (f32x2){s1r.x, s1i.x}; } }
        else { f32x2* Eb = (f32x2*)E + ((size_t)((b0 + hi) * 64 + g) * NCHUNK + c0) * 64;
            Eb[j] = (f32x2){s0r.x, s0i.x}; Eb[32 + j] = (f32x2){s1r.x, s1i.x}; Eb[64 + j] = (f32x2){s0r.y, s0i.y}; Eb[64 + 32 + j] = (f32x2){s1r.y, s1i.y}; }
    }
}

#define XB_TMO      128
#define XB_XCNT(j)  (256  + 64 * (j))
#define XB_XSUB(j)  (1280 + 64 * (j))
#define XB_XGEN(j)  (2304 + 64 * (j))
#define XB_TOP      3328
#define XB_TOPGEN   3392
#define XCD_BAR_WORDS 3456
#define XB_SPIN_CAP (1u << 18)

__device__ __forceinline__ unsigned xb_ld(unsigned* p)              { return __hip_atomic_load(p, __ATOMIC_RELAXED, __HIP_MEMORY_SCOPE_AGENT); }
__device__ __forceinline__ unsigned xb_add(unsigned* p, unsigned v) { return __hip_atomic_fetch_add(p, v, __ATOMIC_RELAXED, __HIP_MEMORY_SCOPE_AGENT); }
__device__ __forceinline__ unsigned xb_xcc_id() { return (unsigned)__builtin_amdgcn_s_getreg((3 << 11) | 20) & 0xFu; }
#define XB_SPIN(cond, bar) do { unsigned _sp = 0; while (cond) { __builtin_amdgcn_s_sleep(1); \
    if ((++_sp & 255u) == 0u) { if (xb_ld(&(bar)[XB_TMO])) break; if (_sp > XB_SPIN_CAP) { atomicAdd(&(bar)[XB_TMO], 1u); break; } } } } while (0)

struct XcdBarrier {
    unsigned* bar; unsigned x;
    volatile LAS unsigned* st;
};

__device__ __forceinline__ XcdBarrier xcd_barrier_post(unsigned* bar, volatile LAS unsigned* st) {
    XcdBarrier b; b.bar = bar; b.x = xb_xcc_id(); b.st = st;
    if (threadIdx.x == 0) (void)xb_add(&bar[XB_XCNT(b.x)], 1u);
    return b;
}
__device__ __forceinline__ void xcd_barrier_complete(unsigned* bar, unsigned x, unsigned& nloc, unsigned& nx) {
    const unsigned G = gridDim.x * gridDim.y * gridDim.z;
    unsigned sum, cnt, mine, sp = 0u;
    for (;;) {
        sum = 0u; cnt = 0u; mine = 0u;
#pragma unroll
        for (unsigned j = 0; j < 16; ++j) { const unsigned c = xb_ld(&bar[XB_XCNT(j)]); sum += c; cnt += (c > 0u) ? 1u : 0u; mine = (j == x) ? c : mine; }
        if (sum == G) break;
        __builtin_amdgcn_s_sleep(1);
        if ((++sp & 255u) == 0u) { if (xb_ld(&bar[XB_TMO])) break; if (sp > XB_SPIN_CAP) { atomicAdd(&bar[XB_TMO], 1u); break; } }
    }
    nloc = mine > 0u ? mine : 1u; nx = cnt > 0u ? cnt : 1u;
}

__device__ __forceinline__ void xcd_barrier(const XcdBarrier& b) {
    asm volatile("s_waitcnt vmcnt(0)" ::: "memory");
    __syncthreads();
    if (threadIdx.x == 0) {
        unsigned* bar = b.bar;
        __builtin_amdgcn_s_waitcnt(0);
        unsigned nloc = b.st[0], nx = b.st[1];
        if (nloc == 0u) { xcd_barrier_complete(bar, b.x, nloc, nx); b.st[0] = nloc; b.st[1] = nx; }
        const unsigned old = xb_add(&bar[XB_XSUB(b.x)], 1u);
        const unsigned gen = old / nloc;
        if (old + 1u == (gen + 1u) * nloc) {
            __builtin_amdgcn_fence(__ATOMIC_RELEASE, "agent");
            asm volatile("s_waitcnt vmcnt(0)" ::: "memory");
            const unsigned og = xb_add(&bar[XB_TOP], 1u);
            const unsigned tg = og / nx;
            if (og + 1u == (tg + 1u) * nx) xb_add(&bar[XB_TOPGEN], 1u);
            else XB_SPIN(xb_ld(&bar[XB_TOPGEN]) == tg, bar);
            __builtin_amdgcn_fence(__ATOMIC_ACQUIRE, "agent");
            xb_add(&bar[XB_XGEN(b.x)], 1u);
            asm volatile("s_waitcnt vmcnt(0)" ::: "memory");
        } else {
            XB_SPIN(xb_ld(&bar[XB_XGEN(b.x)]) == gen, bar);
            __builtin_amdgcn_fence(__ATOMIC_ACQUIRE, "agent");
            asm volatile("s_waitcnt vmcnt(0)" ::: "memory");
        }
    }
    __syncthreads();
}

__device__ __forceinline__ void meta_proj(const Args& a, int wave, int lane) {
    unsigned char* ws = a.ws;
    const bf16* XB = (const bf16*)(ws + WS_XB); const bf16* W1t = (const bf16*)(ws + WS_W1); const float* rstdx = (const float*)(ws + WS_RSTDX);
    for (int gw = blockIdx.x * NWAVES + wave; gw < 1536; gw += gridDim.x * NWAVES) {
    const int n = 1024 + gw;
    float wf[16];
    { const u32x4 w0 = *(const u32x4*)(W1t + (size_t)n * DM + lane * 8), w1 = *(const u32x4*)(W1t + (size_t)n * DM + 512 + lane * 8);
      const unsigned ww[8] = {w0.x, w0.y, w0.z, w0.w, w1.x, w1.y, w1.z, w1.w};
#pragma unroll
      for (int e = 0; e < 8; ++e) { wf[2 * e] = bf_lo(ww[e]); wf[2 * e + 1] = bf_hi(ww[e]); } }
    float mine = 0.f;
#pragma unroll
    for (int r = 0; r < 16; ++r) {
        const u32x4 x0 = *(const u32x4*)(XB + (size_t)(META_ROW + r) * DM + lane * 8), x1 = *(const u32x4*)(XB + (size_t)(META_ROW + r) * DM + 512 + lane * 8);
        const unsigned xx[8] = {x0.x, x0.y, x0.z, x0.w, x1.x, x1.y, x1.z, x1.w};
        float s = 0.f;
#pragma unroll
        for (int e = 0; e < 8; ++e) s += bf_lo(xx[e]) * wf[2 * e] + bf_hi(xx[e]) * wf[2 * e + 1];
        s = wave_sum(s);
        if (lane == r) mine = s;
    }
    if (lane < 16) {
        const unsigned short o = (unsigned short)(cvt_pk(mine * rstdx[META_ROW + lane], 0.f) & 0xffffu);
        const size_t row = META_ROW + lane;
        if (n < 1280) ((bf16*)(ws + WS_K))[row * KVW + (n - 1024)] = o;
        else if (n < 1536) ((bf16*)(ws + WS_V))[row * KVW + (n - 1280)] = o;
        else ((bf16*)(ws + WS_U))[row * DM + (n - 1536)] = o;
    }
    }
}

constexpr int MISC_OFF = LDS_BYTES - 256;
constexpr size_t WS_BAR = 768 * 1024;
__global__ void __launch_bounds__(NTHREADS, 2) mk_fwd(Args a) {
    extern __shared__ __attribute__((aligned(16))) unsigned char lds_raw[];
    cg::grid_group grid = cg::this_grid();
    LAS unsigned char* lds = (LAS unsigned char*)lds_raw;
    const int tid = threadIdx.x, lane = tid & 63, wave = __builtin_amdgcn_readfirstlane(tid >> 6);
    unsigned char* ws = a.ws;
    const int G = gridDim.x, c = blockIdx.x;
    volatile LAS unsigned* MISC = (volatile LAS unsigned*)(lds + MISC_OFF);
    if (tid < 32) MISC[tid] = 0u;
    __syncthreads();
    unsigned* barw = (unsigned*)(ws + WS_BAR);
    XcdBarrier bar = xcd_barrier_post(barw, MISC + 8);
    if (a.never) grid.sync();

    p0_prologue(a, lds, wave, lane);
    xcd_barrier(bar);
    meta_proj(a, wave, lane);
    { pg8::Gemm g{(const pg8::bf16_t*)(ws + WS_XB), (const pg8::bf16_t*)(ws + WS_W1), NTOK, NQKVU, DM}; pg8::StaticOrder S; S.init(NTOK, NQKVU, G, c);
      EpiProj E{(bf16*)(ws + WS_Q), (bf16*)(ws + WS_K), (bf16*)(ws + WS_V), (bf16*)(ws + WS_U), (const float*)(ws + WS_RSTDX)};
      pg8::gemm_phase<EpiProj, pg8::StaticOrder, true, true>(lds, g, S, E); }
    xcd_barrier(bar);
    for (int it = c; it < 512; it += G) attn_item(a, lds, it, wave, lane);
    for (int it = c; it < 256 + 8; it += G) ssm_item<false>(a, lds, it, wave, lane);
    xcd_barrier(bar);
    for (int it = c; it < 256; it += G) ssm_item<true>(a, lds, it, wave, lane);
    xcd_barrier(bar);
    { pg8::Gemm g{(const pg8::bf16_t*)(ws + WS_Q), (const pg8::bf16_t*)(ws + WS_W2), NTOK, 2048, DM}; pg8::StaticOrder S; S.init(NTOK, 2048, G, c);
      EpiGlu E{(bf16*)(ws + WS_U), DM, (float*)(ws + WS_ROWSB)};
      pg8::gemm_phase<EpiGlu, pg8::StaticOrder, true, true>(lds, g, S, E); }
    xcd_barrier(bar);
    { pg8::Gemm g{(const pg8::bf16_t*)(ws + WS_XB), (const pg8::bf16_t*)(ws + WS_WG), NTOK, 2048, DM}; pg8::StaticOrder S; S.init(NTOK, 2048, G, c);
      EpiMerge E{(const bf16*)(ws + WS_ATT), (const bf16*)(ws + WS_U), (bf16*)(ws + WS_Q), (const float*)(ws + WS_RSTDX), (const float*)(ws + WS_ROWSA), (const float*)(ws + WS_ROWSB), a.in[16], a.in[17]};
      pg8::gemm_phase<EpiMerge, pg8::StaticOrder, true, true>(lds, g, S, E); }
    xcd_barrier(bar);
    { pg8::Gemm g{(const pg8::bf16_t*)(ws + WS_Q), (const pg8::bf16_t*)(ws + WS_W3), NTOK, DM, DM}; pg8::StaticOrder S; S.init(NTOK, DM, G, c);
      EpiResid1 E{(const bf16*)(ws + WS_XB), (bf16*)(ws + WS_ATT), (bf16*)(ws + WS_GS), (float*)(ws + WS_ROWSS)};
      pg8::gemm_phase<EpiResid1, pg8::StaticOrder, true, true>(lds, g, S, E); }
    xcd_barrier(bar);
    { pg8::Gemm g{(const pg8::bf16_t*)(ws + WS_ATT), (const pg8::bf16_t*)(ws + WS_W4), NTOK, 2 * DFF, DM}; pg8::StaticOrder S; S.init(NTOK, 2 * DFF, G, c);
      EpiSwiglu E{(bf16*)(ws + WS_ACT), DFF, (const float*)(ws + WS_ROWSS)};
      pg8::gemm_phase<EpiSwiglu, pg8::StaticOrder, true, true>(lds, g, S, E); }
    xcd_barrier(bar);
    { pg8::Gemm g{(const pg8::bf16_t*)(ws + WS_ACT), (const pg8::bf16_t*)(ws + WS_W5), NTOK, DM, DFF}; pg8::StaticOrder S; S.init(NTOK, DM, G, c);
      EpiResid2 E{(const bf16*)(ws + WS_ATT), (const bf16*)(ws + WS_GS), a.out};
      pg8::gemm_phase<EpiResid2, pg8::StaticOrder, true, true>(lds, g, S, E); }
}

extern "C" void kernel_launch(void* const* d_in, const int* in_sizes, int n_in, void* d_out, int out_size, void* d_ws, size_t ws_size, hipStream_t stream) {
    static int grid = 0;
    if (grid == 0) {
        if (n_in != 22 || in_sizes[0] != NTOK * DM || out_size != NTOK * DM || ws_size < WS_END) { fprintf(stderr, "kernel_launch: unexpected shapes (n_in %d, in0 %d, out %d, ws %zu)\n", n_in, n_in > 0 ? in_sizes[0] : -1, out_size, ws_size); grid = -1; return; }
        int dev = 0, cus = 0, per_cu = 0;
        (void)hipGetDevice(&dev); (void)hipDeviceGetAttribute(&cus, hipDeviceAttributeMultiprocessorCount, dev);
        if (hipFuncSetAttribute((const void*)mk_fwd, hipFuncAttributeMaxDynamicSharedMemorySize, LDS_BYTES) != hipSuccess) { fprintf(stderr, "kernel_launch: hipFuncSetAttribute failed\n"); grid = -1; return; }
        if (hipOccupancyMaxActiveBlocksPerMultiprocessor(&per_cu, (const void*)mk_fwd, NTHREADS, LDS_BYTES) != hipSuccess || per_cu < 1) { fprintf(stderr, "kernel_launch: occupancy query says %d; nothing launched\n", per_cu); grid = -1; return; }
        (void)hipGetLastError();
        grid = cus;
    }
    if (grid < 0) return;
    Args a{};
    for (int i = 0; i < 22; ++i) a.in[i] = (const float*)d_in[i];
    a.out = (float*)d_out; a.ws = (unsigned char*)d_ws;
    if (hipMemsetAsync((unsigned char*)d_ws + WS_BAR, 0, XCD_BAR_WORDS * 4, stream) != hipSuccess) { fprintf(stderr, "kernel_launch: memset of the barrier words failed\n"); return; }
    void* args[] = {&a};
    hipError_t e = hipLaunchCooperativeKernel((const void*)mk_fwd, dim3(grid), dim3(NTHREADS), args, LDS_BYTES, stream);
    if (e != hipSuccess) fprintf(stderr, "cooperative launch failed: %s (grid %d)\n", hipGetErrorString(e), grid);
}
```

```cpp
#include <hip/hip_runtime.h>
#include <hip/hip_cooperative_groups.h>
#include <cstdio>
#include <cstdint>
namespace cg = cooperative_groups;
namespace pg8 {
#define PG8_LAS __attribute__((address_space(3)))
typedef unsigned short bf16_t;
typedef short bf16x8 __attribute__((ext_vector_type(8)));
typedef float f32x4 __attribute__((ext_vector_type(4)));
typedef unsigned u32x4 __attribute__((ext_vector_type(4)));
constexpr int BM = 256, BK = 64, HALF = 128, HTB = HALF * BK * 2  , STAGE_BYTES = 8 * HTB, NXCD = 8, WGM = 8;

__host__ __device__ __forceinline__ int lds_byte(int r, int c) { const int st = (r >> 4) * 2 + (c >> 5), rr = r & 15, cc = c & 31, ob = rr * 64 + cc * 2; return st * 1024 + (ob ^ (((ob >> 9) & 1) << 5)); }
__host__ __device__ __forceinline__ void stage_rc(int b, int& R, int& C) { const int st = b / 1024, sb = b % 1024, swz = sb ^ (((sb >> 9) & 1) << 5); R = (st >> 1) * 16 + swz / 64; C = (st & 1) * 32 + (swz % 64) / 2; }
__host__ __device__ __forceinline__ int perm32(int rho) { const int n = rho >> 4, i = rho & 15; return 8 * (i >> 2) + 4 * n + (i & 3); }

struct Unit { int pm, pn; };
struct Gemm { const bf16_t* A; const bf16_t* Bt; int M, N, K; };

struct StaticOrder {
    int nM, nN, nwg, G, c;
    __host__ __device__ void init(int M, int N, int G_, int c_) { nM = M / BM; nN = N / BM; nwg = nM * nN; G = G_; c = c_; }
    __host__ __device__ bool next(int i, Unit& u) const {
        const long L = (long)i * G + c; if (L >= nwg) return false;
        int wgid = (int)L; { const int q = nwg / NXCD, r = nwg % NXCD, xcd = wgid % NXCD, off = wgid / NXCD; wgid = (xcd < r ? xcd * (q + 1) : r * (q + 1) + (xcd - r) * q) + off; }
        const int nig = WGM * nN, gid = wgid / nig, fm = gid * WGM, gsz = (nM - fm) < WGM ? (nM - fm) : WGM;
        u.pm = fm + ((wgid % nig) % gsz); u.pn = (wgid % nig) / gsz; return true;
    }
    __device__ __forceinline__ void a_ready(const Unit&) const {}
    __device__ __forceinline__ void done(const Unit&) const {}
};

__device__ __forceinline__ unsigned cvt_pk_bf16(float lo, float hi) { unsigned r; asm volatile("v_cvt_pk_bf16_f32 %0, %1, %2" : "=v"(r) : "v"(lo), "v"(hi)); return r; }
typedef float f32x2 __attribute__((ext_vector_type(2)));
__device__ __forceinline__ f32x2 gelu_pk(f32x2 v) {
    const f32x2 av = __builtin_elementwise_abs(v), d = av * 0.2316418882f + 1.0f;
    f32x2 t; t.x = __builtin_amdgcn_rcpf(d.x); t.y = __builtin_amdgcn_rcpf(d.y);
    f32x2 q = t * 0.5307027145f + (-0.7265760135f); q = q * t + 0.7107068705f; q = q * t + (-0.142248368f); q = q * t + 0.127414796f; q = q * t;
    const f32x2 s = (v * v) * (-0.72134752044f);
    f32x2 e; e.x = __builtin_amdgcn_exp2f(s.x); e.y = __builtin_amdgcn_exp2f(s.y);
    const f32x2 m = v * (q * e), r = v - m;
    f32x2 o; o.x = v.x < 0.f ? m.x : r.x; o.y = v.y < 0.f ? m.y : r.y; return o;
}

template <int ACT  > struct EpiBf16 {
    static constexpr bool PERM = true, AFTER_DRAIN = false; static_assert(ACT == 0 || ACT == 1, "EpiBf16: ACT is 0 (none) or 1 (gelu_pk)");
    bf16_t* O; int ldc; const float* bias; int split_cols; size_t split_stride; float scale0;
    __device__ __forceinline__ void operator()(const f32x4 (&acc)[2][2][4][2], const Unit& u, int wr, int wc, int fr, int fq) const {
        const int row0 = u.pm * BM + wr * 64 + fr; int colt = u.pn * BM; bf16_t* base = O;
        float sc = 1.f; if (split_cols) { const int t = colt / split_cols; base += (size_t)t * split_stride; colt -= t * split_cols; if (t == 0) sc = scale0; }
        const int col0 = colt + wc * 32 + 8 * fq, bcol0 = u.pn * BM + wc * 32 + 8 * fq;
        f32x4 bv[2][2];
#pragma unroll
        for (int bj = 0; bj < 2; ++bj)
#pragma unroll
            for (int n = 0; n < 2; ++n) bv[bj][n] = bias ? *(const f32x4*)(bias + bcol0 + bj * HALF + 4 * n) : (f32x4){0.f, 0.f, 0.f, 0.f};
#pragma unroll
        for (int ai = 0; ai < 2; ++ai)
#pragma unroll
            for (int m = 0; m < 4; ++m) { bf16_t* rowp = base + (size_t)(row0 + ai * HALF + m * 16) * ldc + col0;
#pragma unroll
                for (int bj = 0; bj < 2; ++bj) { f32x4 v0 = acc[ai][bj][m][0] + bv[bj][0], v1 = acc[ai][bj][m][1] + bv[bj][1];
                    if (ACT == 1) { f32x2 a = gelu_pk((f32x2){v0[0], v0[1]}), b = gelu_pk((f32x2){v0[2], v0[3]}), c = gelu_pk((f32x2){v1[0], v1[1]}), d = gelu_pk((f32x2){v1[2], v1[3]});
                        v0 = (f32x4){a.x, a.y, b.x, b.y}; v1 = (f32x4){c.x, c.y, d.x, d.y}; }
                    v0 = v0 * sc; v1 = v1 * sc; u32x4 w; w.x = cvt_pk_bf16(v0[0], v0[1]); w.y = cvt_pk_bf16(v0[2], v0[3]); w.z = cvt_pk_bf16(v1[0], v1[1]); w.w = cvt_pk_bf16(v1[2], v1[3]);
                    *(u32x4*)(rowp + bj * HALF) = w; } }
    }
};
template <class Epi, class Sched, bool ALIGN_EPI = false, bool SP2 = false>
__device__ __forceinline__ void gemm_phase(PG8_LAS unsigned char* lds, const Gemm g, const Sched& S, const Epi& E) {
    const int tid = threadIdx.x, wid = __builtin_amdgcn_readfirstlane(tid >> 6), lane = tid & 63, wr = wid >> 2, wc = wid & 3, fr = lane & 15, fq = lane >> 4;
    const int K = g.K, nt = K / BK;
    unsigned voffA[2], voffB[2];
#pragma unroll
    for (int i = 0; i < 2; ++i) { int R, C; stage_rc(tid * 16 + i * 8192, R, C); const int Rb = Epi::PERM ? ((R & ~31) + perm32(R & 31)) : R;
        voffA[i] = (unsigned)(R * K + C) * 2u; voffB[i] = (unsigned)(Rb * K + C) * 2u; }
    const size_t kstep = (size_t)(BK * 2);
    const size_t hstep = (size_t)HALF * K * 2;
    const size_t tstep = 2 * hstep;
    const unsigned ldsw = (unsigned)wid * 1024u;
    const int aoff = lds_byte(wr * 64 + fr, fq * 8), boff = lds_byte(wc * 32 + fr, fq * 8);
#define PG8_SA(b, h) (((b) * 2 + (h)) * HTB)
#define PG8_SB(b, h) ((4 + (b) * 2 + (h)) * HTB)
#define PG8_STAGE(bufoff, gbase, voff) do { _Pragma("unroll") for (int _i = 0; _i < 2; ++_i) \
        __builtin_amdgcn_global_load_lds((const unsigned*)((const char*)(gbase) + (voff)[_i]), (PG8_LAS unsigned*)(lds + (bufoff) + ldsw + _i * 8192), 16, 0, 0); } while (0)
#define PG8_LDA(dst, b, h) do { _Pragma("unroll") for (int m = 0; m < 4; ++m) _Pragma("unroll") for (int k = 0; k < 2; ++k) dst[m][k] = *(const PG8_LAS bf16x8*)(lds + PG8_SA(b, h) + aoff + m * 2048 + k * 1024); } while (0)
#define PG8_LDB(dst, b, h) do { _Pragma("unroll") for (int n = 0; n < 2; ++n) _Pragma("unroll") for (int k = 0; k < 2; ++k) dst[n][k] = *(const PG8_LAS bf16x8*)(lds + PG8_SB(b, h) + boff + n * 2048 + k * 1024); } while (0)
#define PG8_MMA(ai, bj, At, Bt) do { __builtin_amdgcn_s_setprio(1); _Pragma("unroll") for (int m = 0; m < 4; ++m) _Pragma("unroll") for (int n = 0; n < 2; ++n) _Pragma("unroll") for (int k = 0; k < 2; ++k) \
        acc[ai][bj][m][n] = __builtin_amdgcn_mfma_f32_16x16x32_bf16(Bt[n][k], At[m][k], acc[ai][bj][m][n], 0, 0, 0); __builtin_amdgcn_s_setprio(0); } while (0)
#define PG8_WAIT_V(n) asm volatile("s_waitcnt vmcnt(" #n ")" ::: "memory")
#define PG8_WAIT_L(n) asm volatile("s_waitcnt lgkmcnt(" #n ")" ::: "memory")
#define PG8_BAR __builtin_amdgcn_s_barrier()
#define PG8_SCHED __builtin_amdgcn_sched_barrier(0)
    Unit cur, nxt; int ui = 0;
    if (!S.next(0, cur)) return;
    f32x4 acc[2][2][4][2];
#pragma unroll
    for (int a = 0; a < 2; ++a)
#pragma unroll
        for (int b = 0; b < 2; ++b)
#pragma unroll
            for (int m = 0; m < 4; ++m)
#pragma unroll
                for (int n = 0; n < 2; ++n) acc[a][b][m][n] = (f32x4){0.f, 0.f, 0.f, 0.f};
    bf16x8 At[4][2], B0[2][2], B1[2][2];
    const char* cA = (const char*)g.A + (size_t)cur.pm * tstep; const char* cB = (const char*)g.Bt + (size_t)cur.pn * tstep;
    S.a_ready(cur);
    if constexpr (SP2) {
        PG8_STAGE(PG8_SB(0, 0), cB, voffB); PG8_STAGE(PG8_SB(0, 1), cB + hstep, voffB); PG8_STAGE(PG8_SA(0, 0), cA, voffA); PG8_STAGE(PG8_SA(0, 1), cA + hstep, voffA);
        if (wr == 1) PG8_BAR;
        PG8_WAIT_V(2); PG8_BAR;
        PG8_STAGE(PG8_SB(1, 0), cB + kstep, voffB); PG8_STAGE(PG8_SA(1, 0), cA + kstep, voffA); PG8_STAGE(PG8_SB(1, 1), cB + hstep + kstep, voffB);
        PG8_WAIT_V(6); PG8_BAR;
    } else {
        PG8_STAGE(PG8_SB(0, 0), cB, voffB); PG8_STAGE(PG8_SA(0, 0), cA, voffA); PG8_STAGE(PG8_SB(0, 1), cB + hstep, voffB); PG8_STAGE(PG8_SA(0, 1), cA + hstep, voffA);
        if (wr == 1) PG8_BAR;
        PG8_WAIT_V(4); PG8_BAR;
        PG8_STAGE(PG8_SB(1, 0), cB + kstep, voffB); PG8_STAGE(PG8_SA(1, 0), cA + kstep, voffA); PG8_STAGE(PG8_SB(1, 1), cB + hstep + kstep, voffB);
        PG8_WAIT_V(6); PG8_BAR;
    }
    for (;;) {
        const bool has_next = S.next(ui + 1, nxt);
        const char* nA = has_next ? (const char*)g.A + (size_t)nxt.pm * tstep : cA; const char* nB = has_next ? (const char*)g.Bt + (size_t)nxt.pn * tstep : cB;
        for (int t = 0; t < nt; t += 2) {
            const bool last = (t == nt - 2);
            const char* a1 = cA + (size_t)(t + 1) * kstep;
            const char* a2 = last ? nA : cA + (size_t)(t + 2) * kstep; const char* b2 = last ? nB : cB + (size_t)(t + 2) * kstep;
            const char* a3 = a2 + kstep; const char* b3 = b2 + kstep;
            if (last && has_next) S.a_ready(nxt);
            if constexpr (SP2) {
            PG8_LDB(B0, 0, 0); PG8_LDB(B1, 0, 1); PG8_SCHED; PG8_LDA(At, 0, 0); PG8_STAGE(PG8_SA(1, 1), a1 + hstep, voffA);
            PG8_WAIT_V(8); PG8_WAIT_L(0); PG8_BAR; PG8_MMA(0, 0, At, B0); PG8_MMA(0, 1, At, B1); PG8_BAR; PG8_SCHED;
            PG8_LDA(At, 0, 1); PG8_STAGE(PG8_SB(0, 0), b2, voffB); PG8_STAGE(PG8_SB(0, 1), b2 + hstep, voffB); PG8_STAGE(PG8_SA(0, 0), a2, voffA);
            PG8_WAIT_V(8); PG8_WAIT_L(0); PG8_BAR; PG8_MMA(1, 0, At, B0); PG8_MMA(1, 1, At, B1); PG8_BAR; PG8_SCHED;
            PG8_LDB(B0, 1, 0); PG8_LDB(B1, 1, 1); PG8_SCHED; PG8_LDA(At, 1, 0); PG8_STAGE(PG8_SA(0, 1), a2 + hstep, voffA);
            PG8_WAIT_V(8); PG8_WAIT_L(0); PG8_BAR; PG8_MMA(0, 0, At, B0); PG8_MMA(0, 1, At, B1); PG8_BAR; PG8_SCHED;
            PG8_LDA(At, 1, 1); PG8_STAGE(PG8_SB(1, 0), b3, voffB); PG8_STAGE(PG8_SB(1, 1), b3 + hstep, voffB); PG8_STAGE(PG8_SA(1, 0), a3, voffA);
            PG8_WAIT_V(8); PG8_WAIT_L(0); PG8_BAR; PG8_MMA(1, 0, At, B0); PG8_MMA(1, 1, At, B1); PG8_BAR; PG8_SCHED;
            } else {
            PG8_LDB(B0, 0, 0); PG8_SCHED; PG8_LDA(At, 0, 0); PG8_STAGE(PG8_SA(1, 1), a1 + hstep, voffA);
            PG8_WAIT_L(8); PG8_BAR; PG8_WAIT_L(0); PG8_MMA(0, 0, At, B0); PG8_BAR; PG8_SCHED;
            PG8_LDB(B1, 0, 1); PG8_STAGE(PG8_SB(0, 0), b2, voffB);
            PG8_BAR; PG8_WAIT_L(0); PG8_MMA(0, 1, At, B1); PG8_BAR;
            PG8_LDA(At, 0, 1); PG8_STAGE(PG8_SA(0, 0), a2, voffA);
            PG8_BAR; PG8_WAIT_L(0); PG8_MMA(1, 0, At, B0); PG8_BAR; PG8_SCHED;
            PG8_STAGE(PG8_SB(0, 1), b2 + hstep, voffB);
            PG8_WAIT_V(6); PG8_BAR; PG8_MMA(1, 1, At, B1); PG8_BAR;
            PG8_LDB(B0, 1, 0); PG8_SCHED; PG8_LDA(At, 1, 0); PG8_STAGE(PG8_SA(0, 1), a2 + hstep, voffA);
            PG8_WAIT_L(8); PG8_BAR; PG8_WAIT_L(0); PG8_MMA(0, 0, At, B0); PG8_BAR; PG8_SCHED;
            PG8_LDB(B1, 1, 1); PG8_STAGE(PG8_SB(1, 0), b3, voffB);
            PG8_BAR; PG8_WAIT_L(0); PG8_MMA(0, 1, At, B1); PG8_BAR;
            PG8_LDA(At, 1, 1); PG8_STAGE(PG8_SA(1, 0), a3, voffA);
            PG8_BAR; PG8_WAIT_L(0); PG8_MMA(1, 0, At, B0); PG8_BAR; PG8_SCHED;
            PG8_STAGE(PG8_SB(1, 1), b3 + hstep, voffB);
            PG8_WAIT_V(6); PG8_BAR; PG8_MMA(1, 1, At, B1); PG8_BAR;
            }
        }
        if constexpr (ALIGN_EPI) { if (wr == 0) PG8_BAR; }
        if constexpr (!Epi::AFTER_DRAIN) { E(acc, cur, wr, wc, fr, fq); S.done(cur); }
        if (!has_next) break;
#pragma unroll
        for (int a = 0; a < 2; ++a)
#pragma unroll
            for (int b = 0; b < 2; ++b)
#pragma unroll
                for (int m = 0; m < 4; ++m)
#pragma unroll
                    for (int n = 0; n < 2; ++n) acc[a][b][m][n] = (f32x4){0.f, 0.f, 0.f, 0.f};
        cur = nxt; cA = nA; cB = nB; ++ui;
        if constexpr (ALIGN_EPI) { if (wr == 1) PG8_BAR; }
    }
    PG8_WAIT_V(0);
    if constexpr (!ALIGN_EPI) { if (wr == 0) PG8_BAR; }
    PG8_BAR;
    if constexpr (Epi::AFTER_DRAIN) { E.fused(acc, cur, wr, wc, fr, fq, lds, wid, lane); S.done(cur); }
#undef PG8_SA
#undef PG8_SB
#undef PG8_STAGE
#undef PG8_LDA
#undef PG8_LDB
#undef PG8_MMA
#undef PG8_WAIT_V
#undef PG8_WAIT_L
#undef PG8_BAR
#undef PG8_SCHED
}
}

#define LAS __attribute__((address_space(3)))
typedef unsigned short bf16;
typedef float f32x4 __attribute__((ext_vector_type(4)));
typedef float f32x2 __attribute__((ext_vector_type(2)));
typedef float f32x16 __attribute__((ext_vector_type(16)));
typedef short bf16x8 __attribute__((ext_vector_type(8)));
typedef short s16x4 __attribute__((ext_vector_type(4)));
typedef unsigned u32x4 __attribute__((ext_vector_type(4)));
typedef unsigned u32x2 __attribute__((ext_vector_type(2)));

constexpr int NB = 4, SEQ = 8192, DM = 1024, NTOK = NB * SEQ, MROWS = NTOK + 256, META_ROW = NTOK;
constexpr int INC = 4608, DFF = 2816, KVW = 256;
constexpr int NGRP = 64, NST = 64, CHUNK = 256, NCHUNK = SEQ / CHUNK;
constexpr float EPS = 1e-6f;
constexpr int NTHREADS = 512, NWAVES = 8;
constexpr int LDS_BYTES = 147456;

constexpr size_t MiB = 1u << 20;
constexpr size_t WS_RSTDX = 0;
constexpr size_t WS_ROWSS = 256 * 1024;
constexpr size_t WS_ROWSA = 384 * 1024;
constexpr size_t WS_ROWSB = 800 * 1024;
constexpr size_t WS_ATAB = 512 * 1024;
constexpr size_t WS_ATAB2 = 512 * 1024 + 32768;
constexpr size_t WS_SMETA = 512 * 1024 + 65536;
constexpr size_t WS_BB = 1 * MiB;
constexpr size_t WS_CM = 1 * MiB + 262144;
constexpr size_t WS_WG = 7 * MiB;
constexpr int NQKVU = 2560;
constexpr size_t WS_W1 = 2 * MiB, WS_W2 = 11 * MiB, WS_W3 = 15 * MiB, WS_W4 = 17 * MiB, WS_W5 = 28 * MiB;
constexpr size_t WS_E = 34 * MiB;
constexpr size_t ROWBUF = (size_t)MROWS * DM * 2;
constexpr size_t WS_XB = 44 * MiB;
constexpr size_t WS_Q = 110 * MiB;
constexpr size_t WS_K = 175 * MiB, WS_V = 192 * MiB;
constexpr size_t WS_U = 209 * MiB;
constexpr size_t WS_GA = 274 * MiB, WS_GS = 339 * MiB;
constexpr size_t WS_ATT = 404 * MiB;
constexpr size_t WS_ACT = 110 * MiB;
constexpr size_t WS_END = 470 * MiB;
static_assert(WS_XB + ROWBUF <= WS_Q && WS_Q + ROWBUF <= WS_K && WS_U + ROWBUF <= WS_GA && WS_GA + ROWBUF <= WS_GS && WS_GS + ROWBUF <= WS_ATT && WS_ATT + ROWBUF <= WS_END, "ws map");
static_assert(WS_K + (size_t)MROWS * KVW * 2 <= WS_V && WS_V + (size_t)MROWS * KVW * 2 <= WS_U, "ws map kv");
static_assert(WS_ACT + (size_t)NTOK * DFF * 2 <= WS_GS, "act overlay");

__device__ __forceinline__ unsigned cvt_pk(float lo, float hi) { unsigned r; asm volatile("v_cvt_pk_bf16_f32 %0, %1, %2" : "=v"(r) : "v"(lo), "v"(hi)); return r; }
__device__ __forceinline__ float bf_lo(unsigned w) { return __uint_as_float(w << 16); }
__device__ __forceinline__ float bf_hi(unsigned w) { return __uint_as_float(w & 0xffff0000u); }
__device__ __forceinline__ unsigned pk_f16(float lo, float hi) { const _Float16 a = (_Float16)lo, b = (_Float16)hi; return (unsigned)__builtin_bit_cast(unsigned short, a) | ((unsigned)__builtin_bit_cast(unsigned short, b) << 16); }
__device__ __forceinline__ float f16_lo(unsigned w) { return (float)__builtin_bit_cast(_Float16, (unsigned short)(w & 0xffffu)); }
__device__ __forceinline__ float f16_hi(unsigned w) { return (float)__builtin_bit_cast(_Float16, (unsigned short)(w >> 16)); }
__device__ __forceinline__ float fast_sigmoid(float v) { return __builtin_amdgcn_rcpf(1.0f + __builtin_amdgcn_exp2f(-1.4426950408889634f * v)); }
__device__ __forceinline__ float wave_sum(float v) {
#pragma unroll
    for (int o = 1; o < 64; o <<= 1) v += __shfl_xor(v, o);
    return v;
}
#define LDS_WAIT() asm volatile("s_waitcnt lgkmcnt(0)" ::: "memory")

struct EpiProj {
    static constexpr bool PERM = true, AFTER_DRAIN = false;
    bf16 *Q, *K, *V, *U; const float* rstd;
    __device__ __forceinline__ void operator()(const pg8::f32x4 (&acc)[2][2][4][2], const pg8::Unit& u, int wr, int wc, int fr, int fq) const {
        const int pn = u.pn; bf16* base; int ld, ct;
        if (pn < 4) { base = Q; ld = DM; ct = pn; } else if (pn == 4) { base = K; ld = KVW; ct = 0; } else if (pn == 5) { base = V; ld = KVW; ct = 0; } else { base = U; ld = DM; ct = pn - 6; }
        const int row0 = u.pm * 256 + wr * 64 + fr, col0 = ct * 256 + wc * 32 + 8 * fq;
        float rsv[8];
#pragma unroll
        for (int q = 0; q < 8; ++q) rsv[q] = rstd[row0 + (q >> 2) * 128 + (q & 3) * 16];
        asm volatile("" : "+v"(rsv[0]), "+v"(rsv[1]), "+v"(rsv[2]), "+v"(rsv[3]), "+v"(rsv[4]), "+v"(rsv[5]), "+v"(rsv[6]), "+v"(rsv[7]));
#pragma unroll
        for (int ai = 0; ai < 2; ++ai)
#pragma unroll
            for (int m = 0; m < 4; ++m) { const int row = row0 + ai * 128 + m * 16; const float rs = rsv[ai * 4 + m]; bf16* rowp = base + (size_t)row * ld + col0;
#pragma unroll
                for (int bj = 0; bj < 2; ++bj) { pg8::f32x4 v0 = acc[ai][bj][m][0] * rs, v1 = acc[ai][bj][m][1] * rs;
                    u32x4 w; w.x = cvt_pk(v0[0], v0[1]); w.y = cvt_pk(v0[2], v0[3]); w.z = cvt_pk(v1[0], v1[1]); w.w = cvt_pk(v1[2], v1[3]);
                    *(u32x4*)(rowp + bj * 128) = w; } }
    }
};
struct EpiMerge {
    static constexpr bool PERM = true, AFTER_DRAIN = false;
    const bf16* ATT; const bf16* SSM; bf16* MG; const float* rstd; const float* rowsa; const float* rowsb; const float* wa; const float* wsn;
    __device__ __forceinline__ void operator()(const pg8::f32x4 (&acc)[2][2][4][2], const pg8::Unit& u, int wr, int wc, int fr, int fq) const {
        const int row0 = u.pm * 256 + wr * 64 + fr, col0 = u.pn * 128 + wc * 32 + 8 * fq;
        const pg8::f32x4 wa0 = *(const pg8::f32x4*)(wa + col0), wa1 = *(const pg8::f32x4*)(wa + col0 + 4), ws0 = *(const pg8::f32x4*)(wsn + col0), ws1 = *(const pg8::f32x4*)(wsn + col0 + 4);
        float rsv[8], rav[8], rbv[8];
#pragma unroll
        for (int q = 0; q < 8; ++q) { const int row = row0 + (q >> 2) * 128 + (q & 3) * 16; rsv[q] = rstd[row]; rav[q] = rowsa[row]; rbv[q] = rowsb[row]; }
#pragma unroll
        for (int p = 0; p < 4; ++p) {
            u32x4 awv[2], swv[2];
#pragma unroll
            for (int m2 = 0; m2 < 2; ++m2) { const int q = p * 2 + m2; const size_t off = (size_t)(row0 + (q >> 2) * 128 + (q & 3) * 16) * DM + col0; awv[m2] = *(const u32x4*)(ATT + off); swv[m2] = *(const u32x4*)(SSM + off); }
            asm volatile("" : "+v"(awv[0]), "+v"(awv[1]), "+v"(swv[0]), "+v"(swv[1]));
#pragma unroll
            for (int m2 = 0; m2 < 2; ++m2) { const int q = p * 2 + m2, ai = q >> 2, m = q & 3; const int row = row0 + ai * 128 + m * 16; const size_t off = (size_t)row * DM + col0;
                const u32x4 aw = awv[m2], sw = swv[m2];
                const float rs = rsv[q], ra = __builtin_amdgcn_rsqf(rav[q] * (1.0f / DM) + EPS), rb = __builtin_amdgcn_rsqf(rbv[q] * (1.0f / DM) + EPS);
                const float av[8] = {bf_lo(aw.x), bf_hi(aw.x), bf_lo(aw.y), bf_hi(aw.y), bf_lo(aw.z), bf_hi(aw.z), bf_lo(aw.w), bf_hi(aw.w)};
                const float sv[8] = {bf_lo(sw.x), bf_hi(sw.x), bf_lo(sw.y), bf_hi(sw.y), bf_lo(sw.z), bf_hi(sw.z), bf_lo(sw.w), bf_hi(sw.w)};
                float o[8];
#pragma unroll
                for (int n = 0; n < 2; ++n)
#pragma unroll
                    for (int e = 0; e < 4; ++e) { const float wl = n ? wa1[e] : wa0[e], vl = n ? ws1[e] : ws0[e];
                        o[n * 4 + e] = fast_sigmoid(acc[ai][0][m][n][e] * rs) * av[n * 4 + e] * (ra * wl) + fast_sigmoid(acc[ai][1][m][n][e] * rs) * sv[n * 4 + e] * (rb * vl); }
                u32x4 w; w.x = cvt_pk(o[0], o[1]); w.y = cvt_pk(o[2], o[3]); w.z = cvt_pk(o[4], o[5]); w.w = cvt_pk(o[6], o[7]);
                *(u32x4*)(MG + off) = w; }
        }
    }
};
struct EpiGlu {
    static constexpr bool PERM = true, AFTER_DRAIN = false;
    bf16* O; int ldc; float* rowsb;
    __device__ __forceinline__ void operator()(const pg8::f32x4 (&acc)[2][2][4][2], const pg8::Unit& u, int wr, int wc, int fr, int fq) const {
        const int row0 = u.pm * 256 + wr * 64 + fr, col0 = u.pn * 128 + wc * 32 + 8 * fq;
#pragma unroll
        for (int ai = 0; ai < 2; ++ai)
#pragma unroll
            for (int m = 0; m < 4; ++m) { const int row = row0 + ai * 128 + m * 16; float o[8]; float ss = 0.f;
#pragma unroll
                for (int n = 0; n < 2; ++n)
#pragma unroll
                    for (int e = 0; e < 4; ++e) { const float v = acc[ai][0][m][n][e] * fast_sigmoid(acc[ai][1][m][n][e]); o[n * 4 + e] = v; ss += v * v; }
                u32x4 w; w.x = cvt_pk(o[0], o[1]); w.y = cvt_pk(o[2], o[3]); w.z = cvt_pk(o[4], o[5]); w.w = cvt_pk(o[6], o[7]);
                *(u32x4*)(O + (size_t)row * ldc + col0) = w;
                ss += __shfl_xor(ss, 16); ss += __shfl_xor(ss, 32);
                if (fq == 0) atomicAdd(rowsb + row, ss); }
    }
};
struct EpiSwiglu {
    static constexpr bool PERM = true, AFTER_DRAIN = false;
    bf16* O; int ldc; const float* rowss;
    __device__ __forceinline__ void operator()(const pg8::f32x4 (&acc)[2][2][4][2], const pg8::Unit& u, int wr, int wc, int fr, int fq) const {
        const int row0 = u.pm * 256 + wr * 64 + fr, col0 = u.pn * 128 + wc * 32 + 8 * fq;
        float rsv[8];
#pragma unroll
        for (int q = 0; q < 8; ++q) rsv[q] = rowss[row0 + (q >> 2) * 128 + (q & 3) * 16];
        asm volatile("" : "+v"(rsv[0]), "+v"(rsv[1]), "+v"(rsv[2]), "+v"(rsv[3]), "+v"(rsv[4]), "+v"(rsv[5]), "+v"(rsv[6]), "+v"(rsv[7]));
#pragma unroll
        for (int ai = 0; ai < 2; ++ai)
#pragma unroll
            for (int m = 0; m < 4; ++m) { const int row = row0 + ai * 128 + m * 16; const float rs = __builtin_amdgcn_rsqf(rsv[ai * 4 + m] * (1.0f / DM) + EPS); float o[8];
#pragma unroll
                for (int n = 0; n < 2; ++n)
#pragma unroll
                    for (int e = 0; e < 4; ++e) { const float g = acc[ai][0][m][n][e] * rs, up = acc[ai][1][m][n][e] * rs; o[n * 4 + e] = g * fast_sigmoid(g) * up; }
                u32x4 w; w.x = cvt_pk(o[0], o[1]); w.y = cvt_pk(o[2], o[3]); w.z = cvt_pk(o[4], o[5]); w.w = cvt_pk(o[6], o[7]);
                *(u32x4*)(O + (size_t)row * ldc + col0) = w; }
    }
};
struct EpiResid1 {
    static constexpr bool PERM = true, AFTER_DRAIN = false;
    const bf16* XBp; bf16* HB; bf16* HL; float* rowss;
    __device__ __forceinline__ void operator()(const pg8::f32x4 (&acc)[2][2][4][2], const pg8::Unit& u, int wr, int wc, int fr, int fq) const {
        const int row0 = u.pm * 256 + wr * 64 + fr, col0 = u.pn * 256 + wc * 32 + 8 * fq;
#pragma unroll
        for (int ai = 0; ai < 2; ++ai) {
            u32x4 xwv[4][2];
#pragma unroll
            for (int m = 0; m < 4; ++m)
#pragma unroll
                for (int bj = 0; bj < 2; ++bj) xwv[m][bj] = *(const u32x4*)(XBp + (size_t)(row0 + ai * 128 + m * 16) * DM + col0 + bj * 128);
            asm volatile("" : "+v"(xwv[0][0]), "+v"(xwv[0][1]), "+v"(xwv[1][0]), "+v"(xwv[1][1]), "+v"(xwv[2][0]), "+v"(xwv[2][1]), "+v"(xwv[3][0]), "+v"(xwv[3][1]));
#pragma unroll
            for (int m = 0; m < 4; ++m) { const int row = row0 + ai * 128 + m * 16; float ss = 0.f;
#pragma unroll
                for (int bj = 0; bj < 2; ++bj) { const size_t off = (size_t)row * DM + col0 + bj * 128;
                    const u32x4 xw = xwv[m][bj];
                    const pg8::f32x4 h0 = (pg8::f32x4){bf_lo(xw.x), bf_hi(xw.x), bf_lo(xw.y), bf_hi(xw.y)} + acc[ai][bj][m][0], h1 = (pg8::f32x4){bf_lo(xw.z), bf_hi(xw.z), bf_lo(xw.w), bf_hi(xw.w)} + acc[ai][bj][m][1];
                    ss += (h0[0] * h0[0] + h0[1] * h0[1]) + (h0[2] * h0[2] + h0[3] * h0[3]) + (h1[0] * h1[0] + h1[1] * h1[1]) + (h1[2] * h1[2] + h1[3] * h1[3]);
                    u32x4 w; w.x = cvt_pk(h0[0], h0[1]); w.y = cvt_pk(h0[2], h0[3]); w.z = cvt_pk(h1[0], h1[1]); w.w = cvt_pk(h1[2], h1[3]);
                    *(u32x4*)(HB + off) = w;
                    u32x4 l; l.x = pk_f16(h0[0], h0[1]); l.y = pk_f16(h0[2], h0[3]); l.z = pk_f16(h1[0], h1[1]); l.w = pk_f16(h1[2], h1[3]);
                    *(u32x4*)(HL + off) = l; }
                ss += __shfl_xor(ss, 16); ss += __shfl_xor(ss, 32);
                if (fq == 0) atomicAdd(rowss + row, ss); }
        }
    }
};
struct EpiResid2 {
    static constexpr bool PERM = true, AFTER_DRAIN = false;
    const bf16* HF; float* out;
    __device__ __forceinline__ void operator()(const pg8::f32x4 (&acc)[2][2][4][2], const pg8::Unit& u, int wr, int wc, int fr, int fq) const {
        const int row0 = u.pm * 256 + wr * 64 + fr, col0 = u.pn * 256 + wc * 32 + 8 * fq;
#pragma unroll
        for (int ai = 0; ai < 2; ++ai) {
            u32x4 hv[4][2];
#pragma unroll
            for (int m = 0; m < 4; ++m)
#pragma unroll
                for (int bj = 0; bj < 2; ++bj) hv[m][bj] = *(const u32x4*)(HF + (size_t)(row0 + ai * 128 + m * 16) * DM + col0 + bj * 128);
            asm volatile("" : "+v"(hv[0][0]), "+v"(hv[0][1]), "+v"(hv[1][0]), "+v"(hv[1][1]), "+v"(hv[2][0]), "+v"(hv[2][1]), "+v"(hv[3][0]), "+v"(hv[3][1]));
#pragma unroll
            for (int m = 0; m < 4; ++m) { const int row = row0 + ai * 128 + m * 16;
#pragma unroll
                for (int bj = 0; bj < 2; ++bj) { const size_t off = (size_t)row * DM + col0 + bj * 128; const u32x4 h = hv[m][bj];
                    *(pg8::f32x4*)(out + off) = (pg8::f32x4){f16_lo(h.x), f16_hi(h.x), f16_lo(h.y), f16_hi(h.y)} + acc[ai][bj][m][0];
                    *(pg8::f32x4*)(out + off + 4) = (pg8::f32x4){f16_lo(h.z), f16_hi(h.z), f16_lo(h.w), f16_hi(h.w)} + acc[ai][bj][m][1]; } }
        }
    }
};

constexpr int TP = 65, T_SCR_BYTES = 64 * TP * 4;
__device__ __forceinline__ void transpose_item(const float* W, int ldw, const float* gk, int K, int N, bf16* WT, bool glu, LAS float* scr, int item, int lane) {
    const int nblk = N / 64, kb = item / nblk, nb = item % nblk, k0 = 64 * kb, n0 = 64 * nb;
    const int kq = lane >> 4, n4 = (lane & 15) * 4;
    f32x4 v[16];
#pragma unroll
    for (int i = 0; i < 16; ++i) v[i] = *(const f32x4*)(W + (size_t)(k0 + 4 * i + kq) * ldw + n0 + n4);
#pragma unroll
    for (int i = 0; i < 16; ++i) { LAS float* d = scr + (4 * i + kq) * TP + n4; d[0] = v[i].x; d[1] = v[i].y; d[2] = v[i].z; d[3] = v[i].w; }
    LDS_WAIT(); asm volatile("" ::: "memory");
    int d0 = n0; if (glu) { const int half = N / 2, bj = n0 / half, j = n0 % half; d0 = 256 * (j / 128) + 128 * bj + (j % 128); }
    const int c = lane & 7;
    float g[8];
#pragma unroll
    for (int e2 = 0; e2 < 8; ++e2) g[e2] = gk ? gk[k0 + 8 * c + e2] : 1.0f;
#pragma unroll
    for (int j = 0; j < 8; ++j) { const int n = (lane >> 3) + 8 * j; const LAS float* s = scr + (8 * c) * TP + n;
        u32x4 o; o.x = cvt_pk(s[0 * TP] * g[0], s[1 * TP] * g[1]); o.y = cvt_pk(s[2 * TP] * g[2], s[3 * TP] * g[3]); o.z = cvt_pk(s[4 * TP] * g[4], s[5 * TP] * g[5]); o.w = cvt_pk(s[6 * TP] * g[6], s[7 * TP] * g[7]);
        *(u32x4*)(WT + (size_t)(d0 + n) * K + k0 + 8 * c) = o; }
    LDS_WAIT(); asm volatile("" ::: "memory");
}

__device__ __forceinline__ void sincos_small(float x, float& s, float& c) {
    const float n = rintf(x * 0.6366197723675814f);
    float r = fmaf(-n, 1.5703125f, x); r = fmaf(-n, 4.837512969970703125e-4f, r); r = fmaf(-n, 7.54978995489188216e-8f, r);
    const float z = r * r;
    const float sp = r + r * z * (-1.6666654611e-1f + z * (8.3321608736e-3f + z * -1.9515295891e-4f));
    const float cp = 1.0f - 0.5f * z + z * z * (4.166664568298827e-2f + z * (-1.388731625493765e-3f + z * 2.443315711809948e-5f));
    const int q = ((int)n) & 3;
    const float ss = (q & 1) ? cp : sp, cc = (q & 1) ? sp : cp;
    s = (q & 2) ? -ss : ss; c = ((q + 1) & 2) ? -cc : cc;
}

struct Args { const float* in[22]; float* out; unsigned char* ws; long long never; };

__device__ __forceinline__ void p0_prologue(const Args& a, LAS unsigned char* lds, int wave, int lane) {
    unsigned char* ws = a.ws;
    LAS float* scr = (LAS float*)(lds + wave * 16896);
    const int gw = blockIdx.x * NWAVES + wave, NGW = gridDim.x * NWAVES;
    constexpr int I1 = (DM / 64) * (NQKVU / 64), IG = (DM / 64) * (2048 / 64), I2 = (DM / 64) * (2048 / 64), I3 = (DM / 64) * (DM / 64), I4 = (DM / 64) * (2 * DFF / 64), I5 = (DFF / 64) * (DM / 64);
    static_assert(T_SCR_BYTES <= 16896 && 8 * 16896 <= LDS_BYTES - 1024, "transpose scratch");
    constexpr int NITEMS = I1 + IG + I2 + I3 + I4 + I5;
    for (int it = gw; it < NITEMS; it += NGW) {
        int r = it;
        if (r < I1) { transpose_item(a.in[3], INC, a.in[2], DM, NQKVU, (bf16*)(ws + WS_W1), false, scr, r, lane); continue; } r -= I1;
        if (r < IG) { transpose_item(a.in[3] + NQKVU, INC, a.in[2], DM, 2048, (bf16*)(ws + WS_WG), true, scr, r, lane); continue; } r -= IG;
        if (r < I2) { transpose_item(a.in[15], 2048, nullptr, DM, 2048, (bf16*)(ws + WS_W2), true, scr, r, lane); continue; } r -= I2;
        if (r < I3) { transpose_item(a.in[18], DM, nullptr, DM, DM, (bf16*)(ws + WS_W3), false, scr, r, lane); continue; } r -= I3;
        if (r < I4) { transpose_item(a.in[20], 2 * DFF, a.in[19], DM, 2 * DFF, (bf16*)(ws + WS_W4), true, scr, r, lane); continue; } r -= I4;
        transpose_item(a.in[21], DM, nullptr, DFF, DM, (bf16*)(ws + WS_W5), false, scr, r, lane);
    }
    bf16* XB = (bf16*)(ws + WS_XB); float* rstdx = (float*)(ws + WS_RSTDX);
    for (int m0 = gw; m0 < NTOK + 16; m0 += 2 * NGW) {
        const int m1 = m0 + NGW; const bool has1 = m1 < NTOK + 16; const int m1c = has1 ? m1 : m0;
        const float* src0 = m0 < NTOK ? a.in[0] + (size_t)m0 * DM : a.in[1] + (size_t)(m0 - NTOK) * DM;
        const float* src1 = m1c < NTOK ? a.in[0] + (size_t)m1c * DM : a.in[1] + (size_t)(m1c - NTOK) * DM;
        f32x4 v0[4], v1[4]; float s0 = 0.f, s1 = 0.f;
#pragma unroll
        for (int j = 0; j < 4; ++j) { v0[j] = ((const f32x4*)src0)[lane + 64 * j]; v1[j] = ((const f32x4*)src1)[lane + 64 * j]; }
#pragma unroll
        for (int j = 0; j < 4; ++j) { s0 += (v0[j].x * v0[j].x + v0[j].y * v0[j].y) + (v0[j].z * v0[j].z + v0[j].w * v0[j].w); s1 += (v1[j].x * v1[j].x + v1[j].y * v1[j].y) + (v1[j].z * v1[j].z + v1[j].w * v1[j].w); }
        u32x2* o0 = (u32x2*)(XB + (size_t)m0 * DM) + lane; u32x2* o1 = (u32x2*)(XB + (size_t)m1c * DM) + lane;
#pragma unroll
        for (int j = 0; j < 4; ++j) { u32x2 w; w.x = cvt_pk(v0[j].x, v0[j].y); w.y = cvt_pk(v0[j].z, v0[j].w); o0[64 * j] = w; }
        if (has1) {
#pragma unroll
            for (int j = 0; j < 4; ++j) { u32x2 w; w.x = cvt_pk(v1[j].x, v1[j].y); w.y = cvt_pk(v1[j].z, v1[j].w); o1[64 * j] = w; } }
        s0 = wave_sum(s0); s1 = wave_sum(s1);
        if (lane == 0) { rstdx[m0] = __builtin_amdgcn_rsqf(s0 * (1.0f / DM) + EPS); if (has1) rstdx[m1] = __builtin_amdgcn_rsqf(s1 * (1.0f / DM) + EPS); }
    }
    const int gt = blockIdx.x * NTHREADS + threadIdx.x, NGT = gridDim.x * NTHREADS;
    float* rowss = (float*)(ws + WS_ROWSS);
    float* rowsa = (float*)(ws + WS_ROWSA); float* rowsb = (float*)(ws + WS_ROWSB);
    for (int i = gt; i < NTOK; i += NGT) { rowss[i] = 0.f; rowsa[i] = 0.f; rowsb[i] = 0.f; }
    if (gt < NGRP * NST) {
        const int g = gt >> 6, p = gt & 63;
        const float dt = expf(a.in[9][g]), lr = a.in[7][gt], li = a.in[8][gt];
        const float mag = expf(lr * dt); float sn, cs; sincos_small(li * dt, sn, cs);
        const float ar = mag * cs, ai = mag * sn, den = lr * lr + li * li, nr = ar - 1.0f, ni = ai;
        const float fr = (nr * lr + ni * li) / den, fi = (ni * lr - nr * li) / den;
        ((f32x2*)(ws + WS_ATAB))[gt] = (f32x2){ar, ai};
        float pr = ar, pi = ai;
#pragma unroll
        for (int i = 0; i < 8; ++i) { const float tr = pr * pr - pi * pi, ti = 2.0f * pr * pi; pr = tr; pi = ti; }
        ((f32x2*)(ws + WS_ATAB2))[gt] = (f32x2){pr, pi};
        bf16* BB = (bf16*)(ws + WS_BB); bf16* CM = (bf16*)(ws + WS_CM);
        const int rre = g * 128 + (p >> 5) * 64 + (p & 31), rim = rre + 32;
        const float* bre = a.in[10] + (size_t)gt * 16; const float* bim = a.in[11] + (size_t)gt * 16;
#pragma unroll
        for (int c = 0; c < 16; c += 2) {
            const float br0 = bre[c], bi0 = bim[c], br1 = bre[c + 1], bi1 = bim[c + 1];
            *(unsigned*)(BB + (size_t)rre * 16 + c) = cvt_pk(fr * br0 - fi * bi0, fr * br1 - fi * bi1);
            *(unsigned*)(BB + (size_t)rim * 16 + c) = cvt_pk(fr * bi0 + fi * br0, fr * bi1 + fi * br1);
        }
#pragma unroll
        for (int c = 0; c < 16; ++c) {
            const float cr = a.in[12][((size_t)g * 16 + c) * 64 + p], ci = a.in[13][((size_t)g * 16 + c) * 64 + p];
            *(unsigned*)(CM + ((size_t)g * 16 + c) * 128 + 2 * p) = cvt_pk(cr, -ci);
        }
    }
}

constexpr int KP = 144, VP = 840, NKEY = 416;
constexpr int ATT_K_OFF = 0, ATT_V_OFF = NKEY * KP;
static_assert(ATT_V_OFF + 64 * VP <= 131072, "attention LDS");
__device__ __forceinline__ int crow(int r, int hi) { return (r & 3) + 8 * (r >> 2) + 4 * hi; }

__device__ __forceinline__ void attn_item(const Args& a, LAS unsigned char* lds, int item, int wave, int lane) {
    unsigned char* ws = a.ws;
    const bf16* QB = (const bf16*)(ws + WS_Q); const bf16* KB = (const bf16*)(ws + WS_K); const bf16* VB = (const bf16*)(ws + WS_V); bf16* ATT = (bf16*)(ws + WS_ATT);
    const int blk0 = (item & 31) * 2, kvh = (item >> 5) & 3, b = item >> 7;
    const int tid = threadIdx.x;
    const float* knw = a.in[5];
    for (int idx = tid; idx < NKEY * 8; idx += NTHREADS) {
        const int key = idx >> 3, ck = idx & 7; int row = -1;
        if (key < 16) row = META_ROW + key;
        else if (key < 32) row = -1;
        else if (key < 160) row = blk0 > 0 ? b * SEQ + (blk0 - 1) * 128 + (key - 32) : -1;
        else row = b * SEQ + blk0 * 128 + (key - 160);
        u32x4 kw = (u32x4){0u, 0u, 0u, 0u}, vw = (u32x4){0u, 0u, 0u, 0u};
        if (row >= 0) { kw = *(const u32x4*)(KB + (size_t)row * KVW + kvh * 64 + ck * 8); vw = *(const u32x4*)(VB + (size_t)row * KVW + kvh * 64 + ck * 8); }
        float kf[8] = {bf_lo(kw.x), bf_hi(kw.x), bf_lo(kw.y), bf_hi(kw.y), bf_lo(kw.z), bf_hi(kw.z), bf_lo(kw.w), bf_hi(kw.w)};
        float ss = 0.f;
#pragma unroll
        for (int e = 0; e < 8; ++e) ss += kf[e] * kf[e];
        ss += __shfl_xor(ss, 1); ss += __shfl_xor(ss, 2); ss += __shfl_xor(ss, 4);
        const float rs = __builtin_amdgcn_rsqf(ss * (1.0f / 64.0f) + EPS);
        const f32x4 g0 = *(const f32x4*)(knw + ck * 8), g1 = *(const f32x4*)(knw + ck * 8 + 4);
        u32x4 o; o.x = cvt_pk(kf[0] * rs * g0.x, kf[1] * rs * g0.y); o.y = cvt_pk(kf[2] * rs * g0.z, kf[3] * rs * g0.w);
        o.z = cvt_pk(kf[4] * rs * g1.x, kf[5] * rs * g1.y); o.w = cvt_pk(kf[6] * rs * g1.z, kf[7] * rs * g1.w);
        *(LAS u32x4*)(lds + ATT_K_OFF + key * KP + ck * 16) = o;
        LAS unsigned short* vt = (LAS unsigned short*)(lds + ATT_V_OFF + (ck * 8) * VP + key * 2);
        const unsigned vv[4] = {vw.x, vw.y, vw.z, vw.w};
#pragma unroll
        for (int e = 0; e < 4; ++e) { vt[(2 * e) * (VP / 2)] = (unsigned short)(vv[e] & 0xffffu); vt[(2 * e + 1) * (VP / 2)] = (unsigned short)(vv[e] >> 16); }
    }
    __syncthreads();
    const int r = wave >> 1, qh = wave & 1, hq = kvh * 4 + r, ql = lane & 31, hi = lane >> 5;
    const float sink = a.in[6][hq];
    const float* qnw = a.in[4];
    const float L2E = 1.4426950408889634f;
    for (int q4 = 0; q4 < 4; ++q4) {
        const int bl = q4 >> 1, qb = q4 & 1, blk = blk0 + bl;
        const int qblk = 2 * qh + qb;
        const size_t qrow = (size_t)b * SEQ + blk * 128 + qblk * 32 + ql;
        bf16x8 qf[4];
        {
            u32x4 qw[4]; float ss = 0.f;
#pragma unroll
            for (int ks = 0; ks < 4; ++ks) { qw[ks] = *(const u32x4*)(QB + qrow * DM + hq * 64 + 16 * ks + 8 * hi);
                const unsigned ww[4] = {qw[ks].x, qw[ks].y, qw[ks].z, qw[ks].w};
#pragma unroll
                for (int e = 0; e < 4; ++e) { const float lo = bf_lo(ww[e]), h2 = bf_hi(ww[e]); ss += lo * lo + h2 * h2; } }
            ss += __shfl_xor(ss, 32);
            const float rs = __builtin_amdgcn_rsqf(ss * (1.0f / 64.0f) + EPS) * 0.125f;
#pragma unroll
            for (int ks = 0; ks < 4; ++ks) { const f32x4 g0 = *(const f32x4*)(qnw + 16 * ks + 8 * hi), g1 = *(const f32x4*)(qnw + 16 * ks + 8 * hi + 4);
                u32x4 o; o.x = cvt_pk(bf_lo(qw[ks].x) * rs * g0.x, bf_hi(qw[ks].x) * rs * g0.y); o.y = cvt_pk(bf_lo(qw[ks].y) * rs * g0.z, bf_hi(qw[ks].y) * rs * g0.w);
                o.z = cvt_pk(bf_lo(qw[ks].z) * rs * g1.x, bf_hi(qw[ks].z) * rs * g1.y); o.w = cvt_pk(bf_lo(qw[ks].w) * rs * g1.z, bf_hi(qw[ks].w) * rs * g1.w);
                qf[ks] = __builtin_bit_cast(bf16x8, o); }
        }
        f32x16 S[6];
#pragma unroll
        for (int i = 0; i < 6; ++i) {
            const int kb = (i == 0) ? 0 : 4 * bl + qblk + i;
            f32x16 acc;
#pragma unroll
            for (int e = 0; e < 16; ++e) acc[e] = 0.f;
#pragma unroll
            for (int ks = 0; ks < 4; ++ks) { const bf16x8 kf = *(const LAS bf16x8*)(lds + ATT_K_OFF + (kb * 32 + ql) * KP + (16 * ks + 8 * hi) * 2);
                acc = __builtin_amdgcn_mfma_f32_32x32x16_bf16(kf, qf[ks], acc, 0, 0, 0); }
            S[i] = acc;
        }
        const float NEG = -INFINITY;
#pragma unroll
        for (int e = 0; e < 16; ++e) { const int kr = crow(e, hi);
            if (kr >= 16) S[0][e] = NEG;
            if (!(kr > ql)) S[1][e] = NEG;
            if (!(kr <= ql)) S[5][e] = NEG; }
        if (blk == 0) {
#pragma unroll
            for (int i = 1; i < 6; ++i) if (qblk + i <= 4) {
#pragma unroll
                for (int e = 0; e < 16; ++e) S[i][e] = NEG; }
        }
        float mx = sink;
#pragma unroll
        for (int i = 0; i < 6; ++i)
#pragma unroll
            for (int e = 0; e < 16; ++e) mx = fmaxf(mx, S[i][e]);
        mx = fmaxf(mx, __shfl_xor(mx, 32));
        float den = 0.f; const float mb = mx * L2E;
        bf16x8 pf[6][2];
#pragma unroll
        for (int i = 0; i < 6; ++i) {
            float ev[16];
#pragma unroll
            for (int e = 0; e < 16; ++e) { ev[e] = __builtin_amdgcn_exp2f(S[i][e] * L2E - mb); den += ev[e]; }
#pragma unroll
            for (int h = 0; h < 2; ++h) { u32x4 o; o.x = cvt_pk(ev[8 * h + 0], ev[8 * h + 1]); o.y = cvt_pk(ev[8 * h + 2], ev[8 * h + 3]); o.z = cvt_pk(ev[8 * h + 4], ev[8 * h + 5]); o.w = cvt_pk(ev[8 * h + 6], ev[8 * h + 7]);
                pf[i][h] = __builtin_bit_cast(bf16x8, o); }
        }
        den += __shfl_xor(den, 32);
        den += __builtin_amdgcn_exp2f(sink * L2E - mb);
        const float inv = 1.0f / den; float ssq = 0.f;
#pragma unroll
        for (int db = 0; db < 2; ++db) {
            f32x16 O;
#pragma unroll
            for (int e = 0; e < 16; ++e) O[e] = 0.f;
#pragma unroll
            for (int i = 0; i < 6; ++i) { const int kb = (i == 0) ? 0 : 4 * bl + qblk + i;
#pragma unroll
                for (int h = 0; h < 2; ++h) {
                    const LAS unsigned char* vp = lds + ATT_V_OFF + (db * 32 + ql) * VP + (kb * 32 + 16 * h + 4 * hi) * 2;
                    const u32x2 v0 = *(const LAS u32x2*)vp, v1 = *(const LAS u32x2*)(vp + 16);
                    const u32x4 vv = (u32x4){v0.x, v0.y, v1.x, v1.y};
                    O = __builtin_amdgcn_mfma_f32_32x32x16_bf16(__builtin_bit_cast(bf16x8, vv), pf[i][h], O, 0, 0, 0); } }
#pragma unroll
            for (int g = 0; g < 4; ++g) { const float o0 = O[4 * g] * inv, o1 = O[4 * g + 1] * inv, o2 = O[4 * g + 2] * inv, o3 = O[4 * g + 3] * inv; ssq += (o0 * o0 + o1 * o1) + (o2 * o2 + o3 * o3);
                u32x2 w; w.x = cvt_pk(o0, o1); w.y = cvt_pk(o2, o3);
                *(u32x2*)(ATT + qrow * DM + hq * 64 + db * 32 + 8 * g + 4 * hi) = w; }
        }
        ssq += __shfl_xor(ssq, 32);
        if (hi == 0) atomicAdd((float*)(ws + WS_ROWSA) + qrow, ssq);
    }
    __syncthreads();
}

constexpr int SP = 272;
__device__ __forceinline__ float gelu_tanh(float y) { const float t = y + 0.044715f * y * y * y; return y * __builtin_amdgcn_rcpf(1.0f + __builtin_amdgcn_exp2f(-2.302208198f * t)); }
__device__ __forceinline__ f32x2 pk_fma(f32x2 a, f32x2 b, f32x2 c) { return __builtin_elementwise_fma(a, b, c); }

template <bool FINAL>
__device__ __forceinline__ void ssm_item(const Args& a, LAS unsigned char* lds, int item, int wave, int lane) {
    static_assert(NCHUNK == 32 && CHUNK == 256, "item decode");
    unsigned char* ws = a.ws;
    const bf16* U = (const bf16*)(ws + WS_U); bf16* Z = (bf16*)(ws + WS_Q);
    float* E = (float*)(ws + WS_E);
    const bool meta = (!FINAL) && item >= 256;
    const int oct = item & 7, cp = (item >> 3) & 15, bp = (item >> 7) & 1;
    const int g = oct * 8 + wave, j = lane & 31, hi = lane >> 5;
    const int b0 = bp * 2, c0 = 2 * cp;
    bf16x8 bbf[4];
#pragma unroll
    for (int k = 0; k < 4; ++k) bbf[k] = *(const bf16x8*)((const bf16*)(ws + WS_BB) + ((size_t)g * 128 + k * 32 + j) * 16 + 8 * hi);
    const f32x2 a0 = ((const f32x2*)(ws + WS_ATAB))[g * 64 + j], a1 = ((const f32x2*)(ws + WS_ATAB))[g * 64 + 32 + j];
    const f32x2 a0x = (f32x2){a0.x, a0.x}, a0y = (f32x2){a0.y, a0.y}, na0y = (f32x2){-a0.y, -a0.y}, a1x = (f32x2){a1.x, a1.x}, a1y = (f32x2){a1.y, a1.y}, na1y = (f32x2){-a1.y, -a1.y};
    f32x2 s0r = (f32x2){0.f, 0.f}, s0i = s0r, s1r = s0r, s1i = s0r;
    bf16x8 cmf[4]; f32x4 dsk;
    if (FINAL) {
#pragma unroll
        for (int k = 0; k < 4; ++k) cmf[k] = *(const bf16x8*)((const bf16*)(ws + WS_CM) + ((size_t)g * 16 + (lane & 15)) * 128 + 32 * k + 8 * (lane >> 4));
        dsk = *(const f32x4*)(a.in[14] + g * 16 + 4 * (lane >> 4));
        const f32x2 t0 = ((const f32x2*)(ws + WS_ATAB2))[g * 64 + j], t1 = ((const f32x2*)(ws + WS_ATAB2))[g * 64 + 32 + j];
        const f32x2 m0 = ((const f32x2*)(ws + WS_SMETA))[g * 64 + j], m1 = ((const f32x2*)(ws + WS_SMETA))[g * 64 + 32 + j];
        float c0r = m0.x, c0i = m0.y, c1r = m1.x, c1i = m1.y;
        const f32x2* Eb = (const f32x2*)E + ((size_t)((b0 + hi) * 64 + g) * NCHUNK) * 64;
#pragma unroll
        for (int half = 0; half < 2; ++half) {
            if (half * 16 < c0) {
                f32x2 e0[16], e1[16];
#pragma unroll
                for (int c = 0; c < 16; ++c) { const int cc = half * 16 + c < NCHUNK - 1 ? half * 16 + c : NCHUNK - 2; e0[c] = Eb[cc * 64 + j]; e1[c] = Eb[cc * 64 + 32 + j]; }
#pragma unroll
                for (int c = 0; c < 16; ++c) if (half * 16 + c < c0) {
                    const float n0r = fmaf(t0.x, c0r, fmaf(-t0.y, c0i, e0[c].x)), n0i = fmaf(t0.x, c0i, fmaf(t0.y, c0r, e0[c].y));
                    const float n1r = fmaf(t1.x, c1r, fmaf(-t1.y, c1i, e1[c].x)), n1i = fmaf(t1.x, c1i, fmaf(t1.y, c1r, e1[c].y));
                    c0r = n0r; c0i = n0i; c1r = n1r; c1i = n1i; }
            }
        }
        const f32x2 ec0 = Eb[c0 * 64 + j], ec1 = Eb[c0 * 64 + 32 + j];
        s0r = (f32x2){c0r, fmaf(t0.x, c0r, fmaf(-t0.y, c0i, ec0.x))}; s0i = (f32x2){c0i, fmaf(t0.x, c0i, fmaf(t0.y, c0r, ec0.y))};
        s1r = (f32x2){c1r, fmaf(t1.x, c1r, fmaf(-t1.y, c1i, ec1.x))}; s1i = (f32x2){c1i, fmaf(t1.x, c1i, fmaf(t1.y, c1r, ec1.y))};
    }
    const int bsel = (j >> 2) & 1, csel = j & 1, tt = ((j & 3) >> 1) + 2 * (j >> 3);
    const size_t urow0 = meta ? (size_t)META_ROW + tt : (size_t)(b0 + bsel) * SEQ + (size_t)(c0 + csel) * CHUNK + tt;
    const bf16* up = U + urow0 * DM + g * 16 + 8 * hi;
    LAS unsigned char* sl = lds + wave * (32 * SP);
    const int nsteps = meta ? 2 : CHUNK / 8;
    const size_t erow = (size_t)b0 * SEQ + (size_t)(c0 + ((lane & 15) >> 3)) * CHUNK + (lane & 7);
    const bf16* ue = U + erow * DM + g * 16 + 4 * (lane >> 4);
    bf16* ze = Z + erow * DM + g * 16 + 4 * (lane >> 4);
    bf16x8 uf = *(const bf16x8*)up;
    u32x2 uu0 = (u32x2){0u, 0u}, uu1 = (u32x2){0u, 0u};
    if (FINAL) { uu0 = *(const u32x2*)ue; uu1 = *(const u32x2*)(ue + (size_t)SEQ * DM); }
    for (int st = 0; st < nsteps; ++st) {
        bf16x8 ufn = uf; u32x2 un0 = uu0, un1 = uu1;
        if (st + 1 < nsteps) { ufn = *(const bf16x8*)(up + (size_t)(st + 1) * 8 * DM);
            if (FINAL) { un0 = *(const u32x2*)(ue + (size_t)(st + 1) * 8 * DM); un1 = *(const u32x2*)(ue + (size_t)(st + 1) * 8 * DM + (size_t)SEQ * DM); } }
        f32x16 X[4];
#pragma unroll
        for (int k = 0; k < 4; ++k) { f32x16 z;
#pragma unroll
            for (int e = 0; e < 16; ++e) z[e] = 0.f;
            X[k] = __builtin_amdgcn_mfma_f32_32x32x16_bf16(uf, bbf[k], z, 0, 0, 0); }
#pragma unroll
        for (int t = 0; t < 8; ++t) {
            const f32x2 x0r = (f32x2){X[0][2 * t], X[0][2 * t + 1]}, x0i = (f32x2){X[1][2 * t], X[1][2 * t + 1]}, x1r = (f32x2){X[2][2 * t], X[2][2 * t + 1]}, x1i = (f32x2){X[3][2 * t], X[3][2 * t + 1]};
            const f32x2 n0r = pk_fma(a0x, s0r, pk_fma(na0y, s0i, x0r)), n0i = pk_fma(a0x, s0i, pk_fma(a0y, s0r, x0i));
            const f32x2 n1r = pk_fma(a1x, s1r, pk_fma(na1y, s1i, x1r)), n1i = pk_fma(a1x, s1i, pk_fma(a1y, s1r, x1i));
            s0r = n0r; s0i = n0i; s1r = n1r; s1i = n1i;
            if (FINAL) {
                LAS unsigned char* r0 = sl + ((hi * 2 + 0) * 8 + t) * SP; LAS unsigned char* r1 = sl + ((hi * 2 + 1) * 8 + t) * SP;
                *(LAS unsigned*)(r0 + j * 4) = cvt_pk(n0r.x, n0i.x); *(LAS unsigned*)(r0 + (32 + j) * 4) = cvt_pk(n1r.x, n1i.x);
                *(LAS unsigned*)(r1 + j * 4) = cvt_pk(n0r.y, n0i.y); *(LAS unsigned*)(r1 + (32 + j) * 4) = cvt_pk(n1r.y, n1i.y); }
        }
        if (FINAL) {
            LDS_WAIT(); asm volatile("" ::: "memory");
#pragma unroll
            for (int bh = 0; bh < 2; ++bh) {
                f32x4 Y = (f32x4){0.f, 0.f, 0.f, 0.f};
#pragma unroll
                for (int k = 0; k < 4; ++k) { const bf16x8 sf = *(const LAS bf16x8*)(sl + (bh * 16 + (lane & 15)) * SP + (32 * k + 8 * (lane >> 4)) * 2);
                    Y = __builtin_amdgcn_mfma_f32_16x16x32_bf16(cmf[k], sf, Y, 0, 0, 0); }
                const u32x2 uu = bh ? uu1 : uu0;
                const float y0 = Y[0] + dsk.x * bf_lo(uu.x), y1 = Y[1] + dsk.y * bf_hi(uu.x), y2 = Y[2] + dsk.z * bf_lo(uu.y), y3 = Y[3] + dsk.w * bf_hi(uu.y);
                u32x2 w; w.x = cvt_pk(gelu_tanh(y0), gelu_tanh(y1)); w.y = cvt_pk(gelu_tanh(y2), gelu_tanh(y3));
                *(u32x2*)(ze + (size_t)st * 8 * DM + (size_t)bh * SEQ * DM) = w;
            }
            LDS_WAIT(); asm volatile("" ::: "memory");
        }
        uf = ufn; uu0 = un0; uu1 = un1;
    }
    if (!FINAL) {
        if (meta) { if (hi == 0) { ((f32x2*)(ws + WS_SMETA))[g * 64 + j] = (f32x2){s0r.x, s0i.x}; ((f32x2*)(ws + WS_SMETA))[g * 64 + 32 + j] = (f32x2){s1r.x, s1i.x}; } }
        else { f32x2* Eb = (f32x2*)E + ((size_t)((b0 + hi) * 64 + g) * NCHUNK + c0) * 64;
            Eb[j] = (f32x2){s0r.x, s0i.x}; Eb[32 + j] = (f32x2){s1r.x, s1i.x}; Eb[64 + j] = (f32x2){s0r.y, s0i.y}; Eb[64 + 32 + j] = (f32x2){s1r.y, s1i.y}; }
    }
}

#define XB_TMO      128
#define XB_XCNT(j)  (256  + 64 * (j))
#define XB_XSUB(j)  (1280 + 64 * (j))
#define XB_XGEN(j)  (2304 + 64 * (j))
#define XB_TOP      3328
#define XB_TOPGEN   3392
#define XCD_BAR_WORDS 3456
#define XB_SPIN_CAP (1u << 18)

__device__ __forceinline__ unsigned xb_ld(unsigned* p)              { return __hip_atomic_load(p, __ATOMIC_RELAXED, __HIP_MEMORY_SCOPE_AGENT); }
__device__ __forceinline__ unsigned xb_add(unsigned* p, unsigned v) { return __hip_atomic_fetch_add(p, v, __ATOMIC_RELAXED, __HIP_MEMORY_SCOPE_AGENT); }
__device__ __forceinline__ unsigned xb_xcc_id() { return (unsigned)__builtin_amdgcn_s_getreg((3 << 11) | 20) & 0xFu; }
#define XB_SPIN(cond, bar) do { unsigned _sp = 0; while (cond) { __builtin_amdgcn_s_sleep(1); \
    if ((++_sp & 255u) == 0u) { if (xb_ld(&(bar)[XB_TMO])) break; if (_sp > XB_SPIN_CAP) { atomicAdd(&(bar)[XB_TMO], 1u); break; } } } } while (0)

struct XcdBarrier {
    unsigned* bar; unsigned x;
    volatile LAS unsigned* st;
};

__device__ __forceinline__ XcdBarrier xcd_barrier_post(unsigned* bar, volatile LAS unsigned* st) {
    XcdBarrier b; b.bar = bar; b.x = xb_xcc_id(); b.st = st;
    if (threadIdx.x == 0) (void)xb_add(&bar[XB_XCNT(b.x)], 1u);
    return b;
}
__device__ __forceinline__ void xcd_barrier_complete(unsigned* bar, unsigned x, unsigned& nloc, unsigned& nx) {
    const unsigned G = gridDim.x * gridDim.y * gridDim.z;
    unsigned sum, cnt, mine, sp = 0u;
    for (;;) {
        sum = 0u; cnt = 0u; mine = 0u;
#pragma unroll
        for (unsigned j = 0; j < 16; ++j) { const unsigned c = xb_ld(&bar[XB_XCNT(j)]); sum += c; cnt += (c > 0u) ? 1u : 0u; mine = (j == x) ? c : mine; }
        if (sum == G) break;
        __builtin_amdgcn_s_sleep(1);
        if ((++sp & 255u) == 0u) { if (xb_ld(&bar[XB_TMO])) break; if (sp > XB_SPIN_CAP) { atomicAdd(&bar[XB_TMO], 1u); break; } }
    }
    nloc = mine > 0u ? mine : 1u; nx = cnt > 0u ? cnt : 1u;
}

__device__ __forceinline__ void xcd_barrier(const XcdBarrier& b) {
    asm volatile("s_waitcnt vmcnt(0)" ::: "memory");
    __syncthreads();
    if (threadIdx.x == 0) {
        unsigned* bar = b.bar;
        __builtin_amdgcn_s_waitcnt(0);
        unsigned nloc = b.st[0], nx = b.st[1];
        if (nloc == 0u) { xcd_barrier_complete(bar, b.x, nloc, nx); b.st[0] = nloc; b.st[1] = nx; }
        const unsigned old = xb_add(&bar[XB_XSUB(b.x)], 1u);
        const unsigned gen = old / nloc;
        if (old + 1u == (gen + 1u) * nloc) {
            __builtin_amdgcn_fence(__ATOMIC_RELEASE, "agent");
            asm volatile("s_waitcnt vmcnt(0)" ::: "memory");
            const unsigned og = xb_add(&bar[XB_TOP], 1u);
            const unsigned tg = og / nx;
            if (og + 1u == (tg + 1u) * nx) xb_add(&bar[XB_TOPGEN], 1u);
            else XB_SPIN(xb_ld(&bar[XB_TOPGEN]) == tg, bar);
            __builtin_amdgcn_fence(__ATOMIC_ACQUIRE, "agent");
            xb_add(&bar[XB_XGEN(b.x)], 1u);
            asm volatile("s_waitcnt vmcnt(0)" ::: "memory");
        } else {
            XB_SPIN(xb_ld(&bar[XB_XGEN(b.x)]) == gen, bar);
            __builtin_amdgcn_fence(__ATOMIC_ACQUIRE, "agent");
            asm volatile("s_waitcnt vmcnt(0)" ::: "memory");
        }
    }
    __syncthreads();
}

__device__ __forceinline__ void meta_proj(const Args& a, int wave, int lane) {
    unsigned char* ws = a.ws;
    const bf16* XB = (const bf16*)(ws + WS_XB); const bf16* W1t = (const bf16*)(ws + WS_W1); const float* rstdx = (const float*)(ws + WS_RSTDX);
    for (int gw = blockIdx.x * NWAVES + wave; gw < 1536; gw += gridDim.x * NWAVES) {
    const int n = 1024 + gw;
    float wf[16];
    { const u32x4 w0 = *(const u32x4*)(W1t + (size_t)n * DM + lane * 8), w1 = *(const u32x4*)(W1t + (size_t)n * DM + 512 + lane * 8);
      const unsigned ww[8] = {w0.x, w0.y, w0.z, w0.w, w1.x, w1.y, w1.z, w1.w};
#pragma unroll
      for (int e = 0; e < 8; ++e) { wf[2 * e] = bf_lo(ww[e]); wf[2 * e + 1] = bf_hi(ww[e]); } }
    float mine = 0.f;
#pragma unroll
    for (int r = 0; r < 16; ++r) {
        const u32x4 x0 = *(const u32x4*)(XB + (size_t)(META_ROW + r) * DM + lane * 8), x1 = *(const u32x4*)(XB + (size_t)(META_ROW + r) * DM + 512 + lane * 8);
        const unsigned xx[8] = {x0.x, x0.y, x0.z, x0.w, x1.x, x1.y, x1.z, x1.w};
        float s = 0.f;
#pragma unroll
        for (int e = 0; e < 8; ++e) s += bf_lo(xx[e]) * wf[2 * e] + bf_hi(xx[e]) * wf[2 * e + 1];
        s = wave_sum(s);
        if (lane == r) mine = s;
    }
    if (lane < 16) {
        const unsigned short o = (unsigned short)(cvt_pk(mine * rstdx[META_ROW + lane], 0.f) & 0xffffu);
        const size_t row = META_ROW + lane;
        if (n < 1280) ((bf16*)(ws + WS_K))[row * KVW + (n - 1024)] = o;
        else if (n < 1536) ((bf16*)(ws + WS_V))[row * KVW + (n - 1280)] = o;
        else ((bf16*)(ws + WS_U))[row * DM + (n - 1536)] = o;
    }
    }
}

constexpr int MISC_OFF = LDS_BYTES - 256;
constexpr size_t WS_BAR = 768 * 1024;
__global__ void __launch_bounds__(NTHREADS, 2) mk_fwd(Args a) {
    extern __shared__ __attribute__((aligned(16))) unsigned char lds_raw[];
    cg::grid_group grid = cg::this_grid();
    LAS unsigned char* lds = (LAS unsigned char*)lds_raw;
    const int tid = threadIdx.x, lane = tid & 63, wave = __builtin_amdgcn_readfirstlane(tid >> 6);
    unsigned char* ws = a.ws;
    const int G = gridDim.x, c = blockIdx.x;
    volatile LAS unsigned* MISC = (volatile LAS unsigned*)(lds + MISC_OFF);
    if (tid < 32) MISC[tid] = 0u;
    __syncthreads();
    unsigned* barw = (unsigned*)(ws + WS_BAR);
    XcdBarrier bar = xcd_barrier_post(barw, MISC + 8);
    if (a.never) grid.sync();

    p0_prologue(a, lds, wave, lane);
    xcd_barrier(bar);
    meta_proj(a, wave, lane);
    { pg8::Gemm g{(const pg8::bf16_t*)(ws + WS_XB), (const pg8::bf16_t*)(ws + WS_W1), NTOK, NQKVU, DM}; pg8::StaticOrder S; S.init(NTOK, NQKVU, G, c);
      EpiProj E{(bf16*)(ws + WS_Q), (bf16*)(ws + WS_K), (bf16*)(ws + WS_V), (bf16*)(ws + WS_U), (const float*)(ws + WS_RSTDX)};
      pg8::gemm_phase<EpiProj, pg8::StaticOrder, true, true>(lds, g, S, E); }
    xcd_barrier(bar);
    for (int it = c; it < 512; it += G) attn_item(a, lds, it, wave, lane);
    for (int it = c; it < 256 + 8; it += G) ssm_item<false>(a, lds, it, wave, lane);
    xcd_barrier(bar);
    for (int it = c; it < 256; it += G) ssm_item<true>(a, lds, it, wave, lane);
    xcd_barrier(bar);
    { pg8::Gemm g{(const pg8::bf16_t*)(ws + WS_Q), (const pg8::bf16_t*)(ws + WS_W2), NTOK, 2048, DM}; pg8::StaticOrder S; S.init(NTOK, 2048, G, c);
      EpiGlu E{(bf16*)(ws + WS_U), DM, (float*)(ws + WS_ROWSB)};
      pg8::gemm_phase<EpiGlu, pg8::StaticOrder, true, true>(lds, g, S, E); }
    xcd_barrier(bar);
    { pg8::Gemm g{(const pg8::bf16_t*)(ws + WS_XB), (const pg8::bf16_t*)(ws + WS_WG), NTOK, 2048, DM}; pg8::StaticOrder S; S.init(NTOK, 2048, G, c);
      EpiMerge E{(const bf16*)(ws + WS_ATT), (const bf16*)(ws + WS_U), (bf16*)(ws + WS_Q), (const float*)(ws + WS_RSTDX), (const float*)(ws + WS_ROWSA), (const float*)(ws + WS_ROWSB), a.in[16], a.in[17]};
      pg8::gemm_phase<EpiMerge, pg8::StaticOrder, true, true>(lds, g, S, E); }
    xcd_barrier(bar);
    { pg8::Gemm g{(const pg8::bf16_t*)(ws + WS_Q), (const pg8::bf16_t*)(ws + WS_W3), NTOK, DM, DM}; pg8::StaticOrder S; S.init(NTOK, DM, G, c);
      EpiResid1 E{(const bf16*)(ws + WS_XB), (bf16*)(ws + WS_ATT), (bf16*)(ws + WS_GS), (float*)(ws + WS_ROWSS)};
      pg8::gemm_phase<EpiResid1, pg8::StaticOrder, true, true>(lds, g, S, E); }
    xcd_barrier(bar);
    { pg8::Gemm g{(const pg8::bf16_t*)(ws + WS_ATT), (const pg8::bf16_t*)(ws + WS_W4), NTOK, 2 * DFF, DM}; pg8::StaticOrder S; S.init(NTOK, 2 * DFF, G, c);
      EpiSwiglu E{(bf16*)(ws + WS_ACT), DFF, (const float*)(ws + WS_ROWSS)};
      pg8::gemm_phase<EpiSwiglu, pg8::StaticOrder, true, true>(lds, g, S, E); }
    xcd_barrier(bar);
    { pg8::Gemm g{(const pg8::bf16_t*)(ws + WS_ACT), (const pg8::bf16_t*)(ws + WS_W5), NTOK, DM, DFF}; pg8::StaticOrder S; S.init(NTOK, DM, G, c);
      EpiResid2 E{(const bf16*)(ws + WS_GS), a.out};
      pg8::gemm_phase<EpiResid2, pg8::StaticOrder, true, true>(lds, g, S, E); }
}

extern "C" void kernel_launch(void* const* d_in, const int* in_sizes, int n_in, void* d_out, int out_size, void* d_ws, size_t ws_size, hipStream_t stream) {
    static int grid = 0;
    if (grid == 0) {
        if (n_in != 22 || in_sizes[0] != NTOK * DM || out_size != NTOK * DM || ws_size < WS_END) { fprintf(stderr, "kernel_launch: unexpected shapes (n_in %d, in0 %d, out %d, ws %zu)\n", n_in, n_in > 0 ? in_sizes[0] : -1, out_size, ws_size); grid = -1; return; }
        int dev = 0, cus = 0, per_cu = 0;
        (void)hipGetDevice(&dev); (void)hipDeviceGetAttribute(&cus, hipDeviceAttributeMultiprocessorCount, dev);
        if (hipFuncSetAttribute((const void*)mk_fwd, hipFuncAttributeMaxDynamicSharedMemorySize, LDS_BYTES) != hipSuccess) { fprintf(stderr, "kernel_launch: hipFuncSetAttribute failed\n"); grid = -1; return; }
        if (hipOccupancyMaxActiveBlocksPerMultiprocessor(&per_cu, (const void*)mk_fwd, NTHREADS, LDS_BYTES) != hipSuccess || per_cu < 1) { fprintf(stderr, "kernel_launch: occupancy query says %d; nothing launched\n", per_cu); grid = -1; return; }
        (void)hipGetLastError();
        grid = cus;
    }
    if (grid < 0) return;
    Args a{};
    for (int i = 0; i < 22; ++i) a.in[i] = (const float*)d_in[i];
    a.out = (float*)d_out; a.ws = (unsigned char*)d_ws;
    if (hipMemsetAsync((unsigned char*)d_ws + WS_BAR, 0, XCD_BAR_WORDS * 4, stream) != hipSuccess) { fprintf(stderr, "kernel_launch: memset of the barrier words failed\n"); return; }
    void* args[] = {&a};
    hipError_t e = hipLaunchCooperativeKernel((const void*)mk_fwd, dim3(grid), dim3(NTHREADS), args, LDS_BYTES, stream);
    if (e != hipSuccess) fprintf(stderr, "cooperative launch failed: %s (grid %d)\n", hipGetErrorString(e), grid);
}
```

```cpp
#include <hip/hip_runtime.h>
#include <hip/hip_cooperative_groups.h>
#include <cstdio>
#include <cstdint>
namespace cg = cooperative_groups;
namespace pg8 {
#define PG8_LAS __attribute__((address_space(3)))
typedef unsigned short bf16_t;
typedef short bf16x8 __attribute__((ext_vector_type(8)));
typedef float f32x4 __attribute__((ext_vector_type(4)));
typedef unsigned u32x4 __attribute__((ext_vector_type(4)));
constexpr int BM = 256, BK = 64, HALF = 128, HTB = HALF * BK * 2  , STAGE_BYTES = 8 * HTB, NXCD = 8, WGM = 8;

__host__ __device__ __forceinline__ int lds_byte(int r, int c) { const int st = (r >> 4) * 2 + (c >> 5), rr = r & 15, cc = c & 31, ob = rr * 64 + cc * 2; return st * 1024 + (ob ^ (((ob >> 9) & 1) << 5)); }
__host__ __device__ __forceinline__ void stage_rc(int b, int& R, int& C) { const int st = b / 1024, sb = b % 1024, swz = sb ^ (((sb >> 9) & 1) << 5); R = (st >> 1) * 16 + swz / 64; C = (st & 1) * 32 + (swz % 64) / 2; }
__host__ __device__ __forceinline__ int perm32(int rho) { const int n = rho >> 4, i = rho & 15; return 8 * (i >> 2) + 4 * n + (i & 3); }

struct Unit { int pm, pn; };
struct Gemm { const bf16_t* A; const bf16_t* Bt; int M, N, K; };

struct StaticOrder {
    int nM, nN, nwg, G, c;
    __host__ __device__ void init(int M, int N, int G_, int c_) { nM = M / BM; nN = N / BM; nwg = nM * nN; G = G_; c = c_; }
    __host__ __device__ bool next(int i, Unit& u) const {
        const long L = (long)i * G + c; if (L >= nwg) return false;
        int wgid = (int)L; { const int q = nwg / NXCD, r = nwg % NXCD, xcd = wgid % NXCD, off = wgid / NXCD; wgid = (xcd < r ? xcd * (q + 1) : r * (q + 1) + (xcd - r) * q) + off; }
        const int nig = WGM * nN, gid = wgid / nig, fm = gid * WGM, gsz = (nM - fm) < WGM ? (nM - fm) : WGM;
        u.pm = fm + ((wgid % nig) % gsz); u.pn = (wgid % nig) / gsz; return true;
    }
    __device__ __forceinline__ void a_ready(const Unit&) const {}
    __device__ __forceinline__ void done(const Unit&) const {}
};

__device__ __forceinline__ unsigned cvt_pk_bf16(float lo, float hi) { unsigned r; asm volatile("v_cvt_pk_bf16_f32 %0, %1, %2" : "=v"(r) : "v"(lo), "v"(hi)); return r; }
typedef float f32x2 __attribute__((ext_vector_type(2)));
__device__ __forceinline__ f32x2 gelu_pk(f32x2 v) {
    const f32x2 av = __builtin_elementwise_abs(v), d = av * 0.2316418882f + 1.0f;
    f32x2 t; t.x = __builtin_amdgcn_rcpf(d.x); t.y = __builtin_amdgcn_rcpf(d.y);
    f32x2 q = t * 0.5307027145f + (-0.7265760135f); q = q * t + 0.7107068705f; q = q * t + (-0.142248368f); q = q * t + 0.127414796f; q = q * t;
    const f32x2 s = (v * v) * (-0.72134752044f);
    f32x2 e; e.x = __builtin_amdgcn_exp2f(s.x); e.y = __builtin_amdgcn_exp2f(s.y);
    const f32x2 m = v * (q * e), r = v - m;
    f32x2 o; o.x = v.x < 0.f ? m.x : r.x; o.y = v.y < 0.f ? m.y : r.y; return o;
}

template <int ACT  > struct EpiBf16 {
    static constexpr bool PERM = true, AFTER_DRAIN = false; static_assert(ACT == 0 || ACT == 1, "EpiBf16: ACT is 0 (none) or 1 (gelu_pk)");
    bf16_t* O; int ldc; const float* bias; int split_cols; size_t split_stride; float scale0;
    __device__ __forceinline__ void operator()(const f32x4 (&acc)[2][2][4][2], const Unit& u, int wr, int wc, int fr, int fq) const {
        const int row0 = u.pm * BM + wr * 64 + fr; int colt = u.pn * BM; bf16_t* base = O;
        float sc = 1.f; if (split_cols) { const int t = colt / split_cols; base += (size_t)t * split_stride; colt -= t * split_cols; if (t == 0) sc = scale0; }
        const int col0 = colt + wc * 32 + 8 * fq, bcol0 = u.pn * BM + wc * 32 + 8 * fq;
        f32x4 bv[2][2];
#pragma unroll
        for (int bj = 0; bj < 2; ++bj)
#pragma unroll
            for (int n = 0; n < 2; ++n) bv[bj][n] = bias ? *(const f32x4*)(bias + bcol0 + bj * HALF + 4 * n) : (f32x4){0.f, 0.f, 0.f, 0.f};
#pragma unroll
        for (int ai = 0; ai < 2; ++ai)
#pragma unroll
            for (int m = 0; m < 4; ++m) { bf16_t* rowp = base + (size_t)(row0 + ai * HALF + m * 16) * ldc + col0;
#pragma unroll
                for (int bj = 0; bj < 2; ++bj) { f32x4 v0 = acc[ai][bj][m][0] + bv[bj][0], v1 = acc[ai][bj][m][1] + bv[bj][1];
                    if (ACT == 1) { f32x2 a = gelu_pk((f32x2){v0[0], v0[1]}), b = gelu_pk((f32x2){v0[2], v0[3]}), c = gelu_pk((f32x2){v1[0], v1[1]}), d = gelu_pk((f32x2){v1[2], v1[3]});
                        v0 = (f32x4){a.x, a.y, b.x, b.y}; v1 = (f32x4){c.x, c.y, d.x, d.y}; }
                    v0 = v0 * sc; v1 = v1 * sc; u32x4 w; w.x = cvt_pk_bf16(v0[0], v0[1]); w.y = cvt_pk_bf16(v0[2], v0[3]); w.z = cvt_pk_bf16(v1[0], v1[1]); w.w = cvt_pk_bf16(v1[2], v1[3]);
                    *(u32x4*)(rowp + bj * HALF) = w; } }
    }
};
template <bool F16> __device__ __forceinline__ f32x4 mma16(bf16x8 b, bf16x8 a, f32x4 c) {
    if constexpr (F16) { typedef _Float16 h16x8 __attribute__((ext_vector_type(8))); return __builtin_amdgcn_mfma_f32_16x16x32_f16(__builtin_bit_cast(h16x8, b), __builtin_bit_cast(h16x8, a), c, 0, 0, 0); }
    else return __builtin_amdgcn_mfma_f32_16x16x32_bf16(b, a, c, 0, 0, 0);
}
template <class Epi, class Sched, bool ALIGN_EPI = false, bool SP2 = false, bool F16 = false>
__device__ __forceinline__ void gemm_phase(PG8_LAS unsigned char* lds, const Gemm g, const Sched& S, const Epi& E) {
    const int tid = threadIdx.x, wid = __builtin_amdgcn_readfirstlane(tid >> 6), lane = tid & 63, wr = wid >> 2, wc = wid & 3, fr = lane & 15, fq = lane >> 4;
    const int K = g.K, nt = K / BK;
    unsigned voffA[2], voffB[2];
#pragma unroll
    for (int i = 0; i < 2; ++i) { int R, C; stage_rc(tid * 16 + i * 8192, R, C); const int Rb = Epi::PERM ? ((R & ~31) + perm32(R & 31)) : R;
        voffA[i] = (unsigned)(R * K + C) * 2u; voffB[i] = (unsigned)(Rb * K + C) * 2u; }
    const size_t kstep = (size_t)(BK * 2);
    const size_t hstep = (size_t)HALF * K * 2;
    const size_t tstep = 2 * hstep;
    const unsigned ldsw = (unsigned)wid * 1024u;
    const int aoff = lds_byte(wr * 64 + fr, fq * 8), boff = lds_byte(wc * 32 + fr, fq * 8);
#define PG8_SA(b, h) (((b) * 2 + (h)) * HTB)
#define PG8_SB(b, h) ((4 + (b) * 2 + (h)) * HTB)
#define PG8_STAGE(bufoff, gbase, voff) do { _Pragma("unroll") for (int _i = 0; _i < 2; ++_i) \
        __builtin_amdgcn_global_load_lds((const unsigned*)((const char*)(gbase) + (voff)[_i]), (PG8_LAS unsigned*)(lds + (bufoff) + ldsw + _i * 8192), 16, 0, 0); } while (0)
#define PG8_LDA(dst, b, h) do { _Pragma("unroll") for (int m = 0; m < 4; ++m) _Pragma("unroll") for (int k = 0; k < 2; ++k) dst[m][k] = *(const PG8_LAS bf16x8*)(lds + PG8_SA(b, h) + aoff + m * 2048 + k * 1024); } while (0)
#define PG8_LDB(dst, b, h) do { _Pragma("unroll") for (int n = 0; n < 2; ++n) _Pragma("unroll") for (int k = 0; k < 2; ++k) dst[n][k] = *(const PG8_LAS bf16x8*)(lds + PG8_SB(b, h) + boff + n * 2048 + k * 1024); } while (0)
#define PG8_MMA(ai, bj, At, Bt) do { __builtin_amdgcn_s_setprio(1); _Pragma("unroll") for (int m = 0; m < 4; ++m) _Pragma("unroll") for (int n = 0; n < 2; ++n) _Pragma("unroll") for (int k = 0; k < 2; ++k) \
        acc[ai][bj][m][n] = mma16<F16>(Bt[n][k], At[m][k], acc[ai][bj][m][n]); __builtin_amdgcn_s_setprio(0); } while (0)
#define PG8_WAIT_V(n) asm volatile("s_waitcnt vmcnt(" #n ")" ::: "memory")
#define PG8_WAIT_L(n) asm volatile("s_waitcnt lgkmcnt(" #n ")" ::: "memory")
#define PG8_BAR __builtin_amdgcn_s_barrier()
#define PG8_SCHED __builtin_amdgcn_sched_barrier(0)
    Unit cur, nxt; int ui = 0;
    if (!S.next(0, cur)) return;
    f32x4 acc[2][2][4][2];
#pragma unroll
    for (int a = 0; a < 2; ++a)
#pragma unroll
        for (int b = 0; b < 2; ++b)
#pragma unroll
            for (int m = 0; m < 4; ++m)
#pragma unroll
                for (int n = 0; n < 2; ++n) acc[a][b][m][n] = (f32x4){0.f, 0.f, 0.f, 0.f};
    bf16x8 At[4][2], B0[2][2], B1[2][2];
    const char* cA = (const char*)g.A + (size_t)cur.pm * tstep; const char* cB = (const char*)g.Bt + (size_t)cur.pn * tstep;
    S.a_ready(cur);
    if constexpr (SP2) {
        PG8_STAGE(PG8_SB(0, 0), cB, voffB); PG8_STAGE(PG8_SB(0, 1), cB + hstep, voffB); PG8_STAGE(PG8_SA(0, 0), cA, voffA); PG8_STAGE(PG8_SA(0, 1), cA + hstep, voffA);
        if (wr == 1) PG8_BAR;
        PG8_WAIT_V(2); PG8_BAR;
        PG8_STAGE(PG8_SB(1, 0), cB + kstep, voffB); PG8_STAGE(PG8_SA(1, 0), cA + kstep, voffA); PG8_STAGE(PG8_SB(1, 1), cB + hstep + kstep, voffB);
        PG8_WAIT_V(6); PG8_BAR;
    } else {
        PG8_STAGE(PG8_SB(0, 0), cB, voffB); PG8_STAGE(PG8_SA(0, 0), cA, voffA); PG8_STAGE(PG8_SB(0, 1), cB + hstep, voffB); PG8_STAGE(PG8_SA(0, 1), cA + hstep, voffA);
        if (wr == 1) PG8_BAR;
        PG8_WAIT_V(4); PG8_BAR;
        PG8_STAGE(PG8_SB(1, 0), cB + kstep, voffB); PG8_STAGE(PG8_SA(1, 0), cA + kstep, voffA); PG8_STAGE(PG8_SB(1, 1), cB + hstep + kstep, voffB);
        PG8_WAIT_V(6); PG8_BAR;
    }
    for (;;) {
        const bool has_next = S.next(ui + 1, nxt);
        const char* nA = has_next ? (const char*)g.A + (size_t)nxt.pm * tstep : cA; const char* nB = has_next ? (const char*)g.Bt + (size_t)nxt.pn * tstep : cB;
        for (int t = 0; t < nt; t += 2) {
            const bool last = (t == nt - 2);
            const char* a1 = cA + (size_t)(t + 1) * kstep;
            const char* a2 = last ? nA : cA + (size_t)(t + 2) * kstep; const char* b2 = last ? nB : cB + (size_t)(t + 2) * kstep;
            const char* a3 = a2 + kstep; const char* b3 = b2 + kstep;
            if (last && has_next) S.a_ready(nxt);
            if constexpr (SP2) {
            PG8_LDB(B0, 0, 0); PG8_LDB(B1, 0, 1); PG8_SCHED; PG8_LDA(At, 0, 0); PG8_STAGE(PG8_SA(1, 1), a1 + hstep, voffA);
            PG8_WAIT_V(8); PG8_WAIT_L(0); PG8_BAR; PG8_MMA(0, 0, At, B0); PG8_MMA(0, 1, At, B1); PG8_BAR; PG8_SCHED;
            PG8_LDA(At, 0, 1); PG8_STAGE(PG8_SB(0, 0), b2, voffB); PG8_STAGE(PG8_SB(0, 1), b2 + hstep, voffB); PG8_STAGE(PG8_SA(0, 0), a2, voffA);
            PG8_WAIT_V(8); PG8_WAIT_L(0); PG8_BAR; PG8_MMA(1, 0, At, B0); PG8_MMA(1, 1, At, B1); PG8_BAR; PG8_SCHED;
            PG8_LDB(B0, 1, 0); PG8_LDB(B1, 1, 1); PG8_SCHED; PG8_LDA(At, 1, 0); PG8_STAGE(PG8_SA(0, 1), a2 + hstep, voffA);
            PG8_WAIT_V(8); PG8_WAIT_L(0); PG8_BAR; PG8_MMA(0, 0, At, B0); PG8_MMA(0, 1, At, B1); PG8_BAR; PG8_SCHED;
            PG8_LDA(At, 1, 1); PG8_STAGE(PG8_SB(1, 0), b3, voffB); PG8_STAGE(PG8_SB(1, 1), b3 + hstep, voffB); PG8_STAGE(PG8_SA(1, 0), a3, voffA);
            PG8_WAIT_V(8); PG8_WAIT_L(0); PG8_BAR; PG8_MMA(1, 0, At, B0); PG8_MMA(1, 1, At, B1); PG8_BAR; PG8_SCHED;
            } else {
            PG8_LDB(B0, 0, 0); PG8_SCHED; PG8_LDA(At, 0, 0); PG8_STAGE(PG8_SA(1, 1), a1 + hstep, voffA);
            PG8_WAIT_L(8); PG8_BAR; PG8_WAIT_L(0); PG8_MMA(0, 0, At, B0); PG8_BAR; PG8_SCHED;
            PG8_LDB(B1, 0, 1); PG8_STAGE(PG8_SB(0, 0), b2, voffB);
            PG8_BAR; PG8_WAIT_L(0); PG8_MMA(0, 1, At, B1); PG8_BAR;
            PG8_LDA(At, 0, 1); PG8_STAGE(PG8_SA(0, 0), a2, voffA);
            PG8_BAR; PG8_WAIT_L(0); PG8_MMA(1, 0, At, B0); PG8_BAR; PG8_SCHED;
            PG8_STAGE(PG8_SB(0, 1), b2 + hstep, voffB);
            PG8_WAIT_V(6); PG8_BAR; PG8_MMA(1, 1, At, B1); PG8_BAR;
            PG8_LDB(B0, 1, 0); PG8_SCHED; PG8_LDA(At, 1, 0); PG8_STAGE(PG8_SA(0, 1), a2 + hstep, voffA);
            PG8_WAIT_L(8); PG8_BAR; PG8_WAIT_L(0); PG8_MMA(0, 0, At, B0); PG8_BAR; PG8_SCHED;
            PG8_LDB(B1, 1, 1); PG8_STAGE(PG8_SB(1, 0), b3, voffB);
            PG8_BAR; PG8_WAIT_L(0); PG8_MMA(0, 1, At, B1); PG8_BAR;
            PG8_LDA(At, 1, 1); PG8_STAGE(PG8_SA(1, 0), a3, voffA);
            PG8_BAR; PG8_WAIT_L(0); PG8_MMA(1, 0, At, B0); PG8_BAR; PG8_SCHED;
            PG8_STAGE(PG8_SB(1, 1), b3 + hstep, voffB);
            PG8_WAIT_V(6); PG8_BAR; PG8_MMA(1, 1, At, B1); PG8_BAR;
            }
        }
        if constexpr (ALIGN_EPI) { if (wr == 0) PG8_BAR; }
        if constexpr (!Epi::AFTER_DRAIN) { E(acc, cur, wr, wc, fr, fq); S.done(cur); }
        if (!has_next) break;
#pragma unroll
        for (int a = 0; a < 2; ++a)
#pragma unroll
            for (int b = 0; b < 2; ++b)
#pragma unroll
                for (int m = 0; m < 4; ++m)
#pragma unroll
                    for (int n = 0; n < 2; ++n) acc[a][b][m][n] = (f32x4){0.f, 0.f, 0.f, 0.f};
        cur = nxt; cA = nA; cB = nB; ++ui;
        if constexpr (ALIGN_EPI) { if (wr == 1) PG8_BAR; }
    }
    PG8_WAIT_V(0);
    if constexpr (!ALIGN_EPI) { if (wr == 0) PG8_BAR; }
    PG8_BAR;
    if constexpr (Epi::AFTER_DRAIN) { E.fused(acc, cur, wr, wc, fr, fq, lds, wid, lane); S.done(cur); }
#undef PG8_SA
#undef PG8_SB
#undef PG8_STAGE
#undef PG8_LDA
#undef PG8_LDB
#undef PG8_MMA
#undef PG8_WAIT_V
#undef PG8_WAIT_L
#undef PG8_BAR
#undef PG8_SCHED
}
}

#define LAS __attribute__((address_space(3)))
typedef unsigned short bf16;
typedef float f32x4 __attribute__((ext_vector_type(4)));
typedef float f32x2 __attribute__((ext_vector_type(2)));
typedef float f32x16 __attribute__((ext_vector_type(16)));
typedef short bf16x8 __attribute__((ext_vector_type(8)));
typedef short s16x4 __attribute__((ext_vector_type(4)));
typedef unsigned u32x4 __attribute__((ext_vector_type(4)));
typedef unsigned u32x2 __attribute__((ext_vector_type(2)));

constexpr int NB = 4, SEQ = 8192, DM = 1024, NTOK = NB * SEQ, MROWS = NTOK + 256, META_ROW = NTOK;
constexpr int INC = 4608, DFF = 2816, KVW = 256;
constexpr int NGRP = 64, NST = 64, CHUNK = 256, NCHUNK = SEQ / CHUNK;
constexpr float EPS = 1e-6f;
constexpr int NTHREADS = 512, NWAVES = 8;
constexpr int LDS_BYTES = 147456;

constexpr size_t MiB = 1u << 20;
constexpr size_t WS_RSTDX = 0;
constexpr size_t WS_ROWSS = 256 * 1024;
constexpr size_t WS_ROWSA = 384 * 1024;
constexpr size_t WS_ROWSB = 800 * 1024;
constexpr size_t WS_ATAB = 512 * 1024;
constexpr size_t WS_ATAB2 = 512 * 1024 + 32768;
constexpr size_t WS_SMETA = 512 * 1024 + 65536;
constexpr size_t WS_BB = 1 * MiB;
constexpr size_t WS_CM = 1 * MiB + 262144;
constexpr size_t WS_WG = 7 * MiB;
constexpr int NQKVU = 2560;
constexpr size_t WS_W1 = 2 * MiB, WS_W2 = 11 * MiB, WS_W3 = 15 * MiB, WS_W4 = 17 * MiB, WS_W5 = 28 * MiB;
constexpr size_t WS_E = 34 * MiB;
constexpr size_t ROWBUF = (size_t)MROWS * DM * 2;
constexpr size_t WS_XB = 44 * MiB;
constexpr size_t WS_Q = 110 * MiB;
constexpr size_t WS_K = 175 * MiB, WS_V = 192 * MiB;
constexpr size_t WS_U = 209 * MiB;
constexpr size_t WS_GA = 274 * MiB, WS_GS = 339 * MiB;
constexpr size_t WS_ATT = 404 * MiB;
constexpr size_t WS_ACT = 110 * MiB;
constexpr size_t WS_END = 470 * MiB;
static_assert(WS_XB + ROWBUF <= WS_Q && WS_Q + ROWBUF <= WS_K && WS_U + ROWBUF <= WS_GA && WS_GA + ROWBUF <= WS_GS && WS_GS + ROWBUF <= WS_ATT && WS_ATT + ROWBUF <= WS_END, "ws map");
static_assert(WS_K + (size_t)MROWS * KVW * 2 <= WS_V && WS_V + (size_t)MROWS * KVW * 2 <= WS_U, "ws map kv");
static_assert(WS_ACT + (size_t)NTOK * DFF * 2 <= WS_GS, "act overlay");

__device__ __forceinline__ unsigned cvt_pk(float lo, float hi) { unsigned r; asm volatile("v_cvt_pk_bf16_f32 %0, %1, %2" : "=v"(r) : "v"(lo), "v"(hi)); return r; }
__device__ __forceinline__ float bf_lo(unsigned w) { return __uint_as_float(w << 16); }
__device__ __forceinline__ float bf_hi(unsigned w) { return __uint_as_float(w & 0xffff0000u); }
__device__ __forceinline__ unsigned pk_f16(float lo, float hi) { const _Float16 a = (_Float16)lo, b = (_Float16)hi; return (unsigned)__builtin_bit_cast(unsigned short, a) | ((unsigned)__builtin_bit_cast(unsigned short, b) << 16); }
__device__ __forceinline__ float f16_lo(unsigned w) { return (float)__builtin_bit_cast(_Float16, (unsigned short)(w & 0xffffu)); }
__device__ __forceinline__ float f16_hi(unsigned w) { return (float)__builtin_bit_cast(_Float16, (unsigned short)(w >> 16)); }
__device__ __forceinline__ float fast_sigmoid(float v) { return __builtin_amdgcn_rcpf(1.0f + __builtin_amdgcn_exp2f(-1.4426950408889634f * v)); }
__device__ __forceinline__ float wave_sum(float v) {
#pragma unroll
    for (int o = 1; o < 64; o <<= 1) v += __shfl_xor(v, o);
    return v;
}
#define LDS_WAIT() asm volatile("s_waitcnt lgkmcnt(0)" ::: "memory")

struct EpiProj {
    static constexpr bool PERM = true, AFTER_DRAIN = false;
    bf16 *Q, *K, *V, *U; const float* rstd;
    __device__ __forceinline__ void operator()(const pg8::f32x4 (&acc)[2][2][4][2], const pg8::Unit& u, int wr, int wc, int fr, int fq) const {
        const int pn = u.pn; bf16* base; int ld, ct;
        if (pn < 4) { base = Q; ld = DM; ct = pn; } else if (pn == 4) { base = K; ld = KVW; ct = 0; } else if (pn == 5) { base = V; ld = KVW; ct = 0; } else { base = U; ld = DM; ct = pn - 6; }
        const int row0 = u.pm * 256 + wr * 64 + fr, col0 = ct * 256 + wc * 32 + 8 * fq;
        float rsv[8];
#pragma unroll
        for (int q = 0; q < 8; ++q) rsv[q] = rstd[row0 + (q >> 2) * 128 + (q & 3) * 16];
        asm volatile("" : "+v"(rsv[0]), "+v"(rsv[1]), "+v"(rsv[2]), "+v"(rsv[3]), "+v"(rsv[4]), "+v"(rsv[5]), "+v"(rsv[6]), "+v"(rsv[7]));
#pragma unroll
        for (int ai = 0; ai < 2; ++ai)
#pragma unroll
            for (int m = 0; m < 4; ++m) { const int row = row0 + ai * 128 + m * 16; const float rs = rsv[ai * 4 + m]; bf16* rowp = base + (size_t)row * ld + col0;
#pragma unroll
                for (int bj = 0; bj < 2; ++bj) { pg8::f32x4 v0 = acc[ai][bj][m][0] * rs, v1 = acc[ai][bj][m][1] * rs;
                    u32x4 w; w.x = cvt_pk(v0[0], v0[1]); w.y = cvt_pk(v0[2], v0[3]); w.z = cvt_pk(v1[0], v1[1]); w.w = cvt_pk(v1[2], v1[3]);
                    *(u32x4*)(rowp + bj * 128) = w; } }
    }
};
struct EpiMerge {
    static constexpr bool PERM = true, AFTER_DRAIN = false;
    const bf16* ATT; const bf16* SSM; bf16* MG; const float* rstd; const float* rowsa; const float* rowsb; const float* wa; const float* wsn;
    __device__ __forceinline__ void operator()(const pg8::f32x4 (&acc)[2][2][4][2], const pg8::Unit& u, int wr, int wc, int fr, int fq) const {
        const int row0 = u.pm * 256 + wr * 64 + fr, col0 = u.pn * 128 + wc * 32 + 8 * fq;
        const pg8::f32x4 wa0 = *(const pg8::f32x4*)(wa + col0), wa1 = *(const pg8::f32x4*)(wa + col0 + 4), ws0 = *(const pg8::f32x4*)(wsn + col0), ws1 = *(const pg8::f32x4*)(wsn + col0 + 4);
        float rsv[8], rav[8], rbv[8];
#pragma unroll
        for (int q = 0; q < 8; ++q) { const int row = row0 + (q >> 2) * 128 + (q & 3) * 16; rsv[q] = rstd[row]; rav[q] = rowsa[row]; rbv[q] = rowsb[row]; }
#pragma unroll
        for (int p = 0; p < 4; ++p) {
            u32x4 awv[2], swv[2];
#pragma unroll
            for (int m2 = 0; m2 < 2; ++m2) { const int q = p * 2 + m2; const size_t off = (size_t)(row0 + (q >> 2) * 128 + (q & 3) * 16) * DM + col0; awv[m2] = *(const u32x4*)(ATT + off); swv[m2] = *(const u32x4*)(SSM + off); }
            asm volatile("" : "+v"(awv[0]), "+v"(awv[1]), "+v"(swv[0]), "+v"(swv[1]));
#pragma unroll
            for (int m2 = 0; m2 < 2; ++m2) { const int q = p * 2 + m2, ai = q >> 2, m = q & 3; const int row = row0 + ai * 128 + m * 16; const size_t off = (size_t)row * DM + col0;
                const u32x4 aw = awv[m2], sw = swv[m2];
                const float rs = rsv[q], ra = __builtin_amdgcn_rsqf(rav[q] * (1.0f / DM) + EPS), rb = __builtin_amdgcn_rsqf(rbv[q] * (1.0f / DM) + EPS);
                const float av[8] = {bf_lo(aw.x), bf_hi(aw.x), bf_lo(aw.y), bf_hi(aw.y), bf_lo(aw.z), bf_hi(aw.z), bf_lo(aw.w), bf_hi(aw.w)};
                const float sv[8] = {bf_lo(sw.x), bf_hi(sw.x), bf_lo(sw.y), bf_hi(sw.y), bf_lo(sw.z), bf_hi(sw.z), bf_lo(sw.w), bf_hi(sw.w)};
                float o[8];
#pragma unroll
                for (int n = 0; n < 2; ++n)
#pragma unroll
                    for (int e = 0; e < 4; ++e) { const float wl = n ? wa1[e] : wa0[e], vl = n ? ws1[e] : ws0[e];
                        o[n * 4 + e] = fast_sigmoid(acc[ai][0][m][n][e] * rs) * av[n * 4 + e] * (ra * wl) + fast_sigmoid(acc[ai][1][m][n][e] * rs) * sv[n * 4 + e] * (rb * vl); }
                u32x4 w; w.x = cvt_pk(o[0], o[1]); w.y = cvt_pk(o[2], o[3]); w.z = cvt_pk(o[4], o[5]); w.w = cvt_pk(o[6], o[7]);
                *(u32x4*)(MG + off) = w; }
        }
    }
};
struct EpiGlu {
    static constexpr bool PERM = true, AFTER_DRAIN = false;
    bf16* O; int ldc; float* rowsb;
    __device__ __forceinline__ void operator()(const pg8::f32x4 (&acc)[2][2][4][2], const pg8::Unit& u, int wr, int wc, int fr, int fq) const {
        const int row0 = u.pm * 256 + wr * 64 + fr, col0 = u.pn * 128 + wc * 32 + 8 * fq;
#pragma unroll
        for (int ai = 0; ai < 2; ++ai)
#pragma unroll
            for (int m = 0; m < 4; ++m) { const int row = row0 + ai * 128 + m * 16; float o[8]; float ss = 0.f;
#pragma unroll
                for (int n = 0; n < 2; ++n)
#pragma unroll
                    for (int e = 0; e < 4; ++e) { const float v = acc[ai][0][m][n][e] * fast_sigmoid(acc[ai][1][m][n][e]); o[n * 4 + e] = v; ss += v * v; }
                u32x4 w; w.x = cvt_pk(o[0], o[1]); w.y = cvt_pk(o[2], o[3]); w.z = cvt_pk(o[4], o[5]); w.w = cvt_pk(o[6], o[7]);
                *(u32x4*)(O + (size_t)row * ldc + col0) = w;
                ss += __shfl_xor(ss, 16); ss += __shfl_xor(ss, 32);
                if (fq == 0) atomicAdd(rowsb + row, ss); }
    }
};
struct EpiSwiglu {
    static constexpr bool PERM = true, AFTER_DRAIN = false;
    bf16* O; int ldc; const float* rowss;
    __device__ __forceinline__ void operator()(const pg8::f32x4 (&acc)[2][2][4][2], const pg8::Unit& u, int wr, int wc, int fr, int fq) const {
        const int row0 = u.pm * 256 + wr * 64 + fr, col0 = u.pn * 128 + wc * 32 + 8 * fq;
        float rsv[8];
#pragma unroll
        for (int q = 0; q < 8; ++q) rsv[q] = rowss[row0 + (q >> 2) * 128 + (q & 3) * 16];
        asm volatile("" : "+v"(rsv[0]), "+v"(rsv[1]), "+v"(rsv[2]), "+v"(rsv[3]), "+v"(rsv[4]), "+v"(rsv[5]), "+v"(rsv[6]), "+v"(rsv[7]));
#pragma unroll
        for (int ai = 0; ai < 2; ++ai)
#pragma unroll
            for (int m = 0; m < 4; ++m) { const int row = row0 + ai * 128 + m * 16; const float rs = __builtin_amdgcn_rsqf(rsv[ai * 4 + m] * (1.0f / DM) + EPS); float o[8];
#pragma unroll
                for (int n = 0; n < 2; ++n)
#pragma unroll
                    for (int e = 0; e < 4; ++e) { const float g = acc[ai][0][m][n][e] * rs, up = acc[ai][1][m][n][e] * rs; o[n * 4 + e] = g * fast_sigmoid(g) * up; }
                u32x4 w; w.x = cvt_pk(o[0], o[1]); w.y = cvt_pk(o[2], o[3]); w.z = cvt_pk(o[4], o[5]); w.w = cvt_pk(o[6], o[7]);
                *(u32x4*)(O + (size_t)row * ldc + col0) = w; }
    }
};
struct EpiResid1 {
    static constexpr bool PERM = true, AFTER_DRAIN = false;
    const bf16* XBp; bf16* HF; float* rowss;
    __device__ __forceinline__ void operator()(const pg8::f32x4 (&acc)[2][2][4][2], const pg8::Unit& u, int wr, int wc, int fr, int fq) const {
        const int row0 = u.pm * 256 + wr * 64 + fr, col0 = u.pn * 256 + wc * 32 + 8 * fq;
#pragma unroll
        for (int ai = 0; ai < 2; ++ai) {
            u32x4 xwv[4][2];
#pragma unroll
            for (int m = 0; m < 4; ++m)
#pragma unroll
                for (int bj = 0; bj < 2; ++bj) xwv[m][bj] = *(const u32x4*)(XBp + (size_t)(row0 + ai * 128 + m * 16) * DM + col0 + bj * 128);
            asm volatile("" : "+v"(xwv[0][0]), "+v"(xwv[0][1]), "+v"(xwv[1][0]), "+v"(xwv[1][1]), "+v"(xwv[2][0]), "+v"(xwv[2][1]), "+v"(xwv[3][0]), "+v"(xwv[3][1]));
#pragma unroll
            for (int m = 0; m < 4; ++m) { const int row = row0 + ai * 128 + m * 16; float ss = 0.f;
#pragma unroll
                for (int bj = 0; bj < 2; ++bj) { const size_t off = (size_t)row * DM + col0 + bj * 128;
                    const u32x4 xw = xwv[m][bj];
                    const pg8::f32x4 h0 = (pg8::f32x4){bf_lo(xw.x), bf_hi(xw.x), bf_lo(xw.y), bf_hi(xw.y)} + acc[ai][bj][m][0], h1 = (pg8::f32x4){bf_lo(xw.z), bf_hi(xw.z), bf_lo(xw.w), bf_hi(xw.w)} + acc[ai][bj][m][1];
                    ss += (h0[0] * h0[0] + h0[1] * h0[1]) + (h0[2] * h0[2] + h0[3] * h0[3]) + (h1[0] * h1[0] + h1[1] * h1[1]) + (h1[2] * h1[2] + h1[3] * h1[3]);
                    u32x4 l; l.x = pk_f16(h0[0], h0[1]); l.y = pk_f16(h0[2], h0[3]); l.z = pk_f16(h1[0], h1[1]); l.w = pk_f16(h1[2], h1[3]);
                    *(u32x4*)(HF + off) = l; }
                ss += __shfl_xor(ss, 16); ss += __shfl_xor(ss, 32);
                if (fq == 0) atomicAdd(rowss + row, ss); }
        }
    }
};
struct EpiResid2 {
    static constexpr bool PERM = true, AFTER_DRAIN = false;
    const bf16* HF; float* out;
    __device__ __forceinline__ void operator()(const pg8::f32x4 (&acc)[2][2][4][2], const pg8::Unit& u, int wr, int wc, int fr, int fq) const {
        const int row0 = u.pm * 256 + wr * 64 + fr, col0 = u.pn * 256 + wc * 32 + 8 * fq;
#pragma unroll
        for (int ai = 0; ai < 2; ++ai) {
            u32x4 hv[4][2];
#pragma unroll
            for (int m = 0; m < 4; ++m)
#pragma unroll
                for (int bj = 0; bj < 2; ++bj) hv[m][bj] = *(const u32x4*)(HF + (size_t)(row0 + ai * 128 + m * 16) * DM + col0 + bj * 128);
            asm volatile("" : "+v"(hv[0][0]), "+v"(hv[0][1]), "+v"(hv[1][0]), "+v"(hv[1][1]), "+v"(hv[2][0]), "+v"(hv[2][1]), "+v"(hv[3][0]), "+v"(hv[3][1]));
#pragma unroll
            for (int m = 0; m < 4; ++m) { const int row = row0 + ai * 128 + m * 16;
#pragma unroll
                for (int bj = 0; bj < 2; ++bj) { const size_t off = (size_t)row * DM + col0 + bj * 128; const u32x4 h = hv[m][bj];
                    *(pg8::f32x4*)(out + off) = (pg8::f32x4){f16_lo(h.x), f16_hi(h.x), f16_lo(h.y), f16_hi(h.y)} + acc[ai][bj][m][0];
                    *(pg8::f32x4*)(out + off + 4) = (pg8::f32x4){f16_lo(h.z), f16_hi(h.z), f16_lo(h.w), f16_hi(h.w)} + acc[ai][bj][m][1]; } }
        }
    }
};

constexpr int TP = 65, T_SCR_BYTES = 64 * TP * 4;
__device__ __forceinline__ void transpose_item(const float* W, int ldw, const float* gk, int K, int N, bf16* WT, bool glu, LAS float* scr, int item, int lane, bool f16 = false) {
    const int nblk = N / 64, kb = item / nblk, nb = item % nblk, k0 = 64 * kb, n0 = 64 * nb;
    const int kq = lane >> 4, n4 = (lane & 15) * 4;
    f32x4 v[16];
#pragma unroll
    for (int i = 0; i < 16; ++i) v[i] = *(const f32x4*)(W + (size_t)(k0 + 4 * i + kq) * ldw + n0 + n4);
#pragma unroll
    for (int i = 0; i < 16; ++i) { LAS float* d = scr + (4 * i + kq) * TP + n4; d[0] = v[i].x; d[1] = v[i].y; d[2] = v[i].z; d[3] = v[i].w; }
    LDS_WAIT(); asm volatile("" ::: "memory");
    int d0 = n0; if (glu) { const int half = N / 2, bj = n0 / half, j = n0 % half; d0 = 256 * (j / 128) + 128 * bj + (j % 128); }
    const int c = lane & 7;
    float g[8];
#pragma unroll
    for (int e2 = 0; e2 < 8; ++e2) g[e2] = gk ? gk[k0 + 8 * c + e2] : 1.0f;
#pragma unroll
    for (int j = 0; j < 8; ++j) { const int n = (lane >> 3) + 8 * j; const LAS float* s = scr + (8 * c) * TP + n;
        u32x4 o;
        if (f16) { o.x = pk_f16(s[0 * TP] * g[0], s[1 * TP] * g[1]); o.y = pk_f16(s[2 * TP] * g[2], s[3 * TP] * g[3]); o.z = pk_f16(s[4 * TP] * g[4], s[5 * TP] * g[5]); o.w = pk_f16(s[6 * TP] * g[6], s[7 * TP] * g[7]); }
        else { o.x = cvt_pk(s[0 * TP] * g[0], s[1 * TP] * g[1]); o.y = cvt_pk(s[2 * TP] * g[2], s[3 * TP] * g[3]); o.z = cvt_pk(s[4 * TP] * g[4], s[5 * TP] * g[5]); o.w = cvt_pk(s[6 * TP] * g[6], s[7 * TP] * g[7]); }
        *(u32x4*)(WT + (size_t)(d0 + n) * K + k0 + 8 * c) = o; }
    LDS_WAIT(); asm volatile("" ::: "memory");
}

__device__ __forceinline__ void sincos_small(float x, float& s, float& c) {
    const float n = rintf(x * 0.6366197723675814f);
    float r = fmaf(-n, 1.5703125f, x); r = fmaf(-n, 4.837512969970703125e-4f, r); r = fmaf(-n, 7.54978995489188216e-8f, r);
    const float z = r * r;
    const float sp = r + r * z * (-1.6666654611e-1f + z * (8.3321608736e-3f + z * -1.9515295891e-4f));
    const float cp = 1.0f - 0.5f * z + z * z * (4.166664568298827e-2f + z * (-1.388731625493765e-3f + z * 2.443315711809948e-5f));
    const int q = ((int)n) & 3;
    const float ss = (q & 1) ? cp : sp, cc = (q & 1) ? sp : cp;
    s = (q & 2) ? -ss : ss; c = ((q + 1) & 2) ? -cc : cc;
}

struct Args { const float* in[22]; float* out; unsigned char* ws; long long never; };

__device__ __forceinline__ void p0_prologue(const Args& a, LAS unsigned char* lds, int wave, int lane) {
    unsigned char* ws = a.ws;
    LAS float* scr = (LAS float*)(lds + wave * 16896);
    const int gw = blockIdx.x * NWAVES + wave, NGW = gridDim.x * NWAVES;
    constexpr int I1 = (DM / 64) * (NQKVU / 64), IG = (DM / 64) * (2048 / 64), I2 = (DM / 64) * (2048 / 64), I3 = (DM / 64) * (DM / 64), I4 = (DM / 64) * (2 * DFF / 64), I5 = (DFF / 64) * (DM / 64);
    static_assert(T_SCR_BYTES <= 16896 && 8 * 16896 <= LDS_BYTES - 1024, "transpose scratch");
    constexpr int NITEMS = I1 + IG + I2 + I3 + I4 + I5;
    for (int it = gw; it < NITEMS; it += NGW) {
        int r = it;
        if (r < I1) { transpose_item(a.in[3], INC, a.in[2], DM, NQKVU, (bf16*)(ws + WS_W1), false, scr, r, lane); continue; } r -= I1;
        if (r < IG) { transpose_item(a.in[3] + NQKVU, INC, a.in[2], DM, 2048, (bf16*)(ws + WS_WG), true, scr, r, lane); continue; } r -= IG;
        if (r < I2) { transpose_item(a.in[15], 2048, nullptr, DM, 2048, (bf16*)(ws + WS_W2), true, scr, r, lane); continue; } r -= I2;
        if (r < I3) { transpose_item(a.in[18], DM, nullptr, DM, DM, (bf16*)(ws + WS_W3), false, scr, r, lane); continue; } r -= I3;
        if (r < I4) { transpose_item(a.in[20], 2 * DFF, a.in[19], DM, 2 * DFF, (bf16*)(ws + WS_W4), true, scr, r, lane, true); continue; } r -= I4;
        transpose_item(a.in[21], DM, nullptr, DFF, DM, (bf16*)(ws + WS_W5), false, scr, r, lane);
    }
    bf16* XB = (bf16*)(ws + WS_XB); float* rstdx = (float*)(ws + WS_RSTDX);
    for (int m0 = gw; m0 < NTOK + 16; m0 += 2 * NGW) {
        const int m1 = m0 + NGW; const bool has1 = m1 < NTOK + 16; const int m1c = has1 ? m1 : m0;
        const float* src0 = m0 < NTOK ? a.in[0] + (size_t)m0 * DM : a.in[1] + (size_t)(m0 - NTOK) * DM;
        const float* src1 = m1c < NTOK ? a.in[0] + (size_t)m1c * DM : a.in[1] + (size_t)(m1c - NTOK) * DM;
        f32x4 v0[4], v1[4]; float s0 = 0.f, s1 = 0.f;
#pragma unroll
        for (int j = 0; j < 4; ++j) { v0[j] = ((const f32x4*)src0)[lane + 64 * j]; v1[j] = ((const f32x4*)src1)[lane + 64 * j]; }
#pragma unroll
        for (int j = 0; j < 4; ++j) { s0 += (v0[j].x * v0[j].x + v0[j].y * v0[j].y) + (v0[j].z * v0[j].z + v0[j].w * v0[j].w); s1 += (v1[j].x * v1[j].x + v1[j].y * v1[j].y) + (v1[j].z * v1[j].z + v1[j].w * v1[j].w); }
        u32x2* o0 = (u32x2*)(XB + (size_t)m0 * DM) + lane; u32x2* o1 = (u32x2*)(XB + (size_t)m1c * DM) + lane;
#pragma unroll
        for (int j = 0; j < 4; ++j) { u32x2 w; w.x = cvt_pk(v0[j].x, v0[j].y); w.y = cvt_pk(v0[j].z, v0[j].w); o0[64 * j] = w; }
        if (has1) {
#pragma unroll
            for (int j = 0; j < 4; ++j) { u32x2 w; w.x = cvt_pk(v1[j].x, v1[j].y); w.y = cvt_pk(v1[j].z, v1[j].w); o1[64 * j] = w; } }
        s0 = wave_sum(s0); s1 = wave_sum(s1);
        if (lane == 0) { rstdx[m0] = __builtin_amdgcn_rsqf(s0 * (1.0f / DM) + EPS); if (has1) rstdx[m1] = __builtin_amdgcn_rsqf(s1 * (1.0f / DM) + EPS); }
    }
    const int gt = blockIdx.x * NTHREADS + threadIdx.x, NGT = gridDim.x * NTHREADS;
    float* rowss = (float*)(ws + WS_ROWSS);
    float* rowsa = (float*)(ws + WS_ROWSA); float* rowsb = (float*)(ws + WS_ROWSB);
    for (int i = gt; i < NTOK; i += NGT) { rowss[i] = 0.f; rowsa[i] = 0.f; rowsb[i] = 0.f; }
    if (gt < NGRP * NST) {
        const int g = gt >> 6, p = gt & 63;
        const float dt = expf(a.in[9][g]), lr = a.in[7][gt], li = a.in[8][gt];
        const float mag = expf(lr * dt); float sn, cs; sincos_small(li * dt, sn, cs);
        const float ar = mag * cs, ai = mag * sn, den = lr * lr + li * li, nr = ar - 1.0f, ni = ai;
        const float fr = (nr * lr + ni * li) / den, fi = (ni * lr - nr * li) / den;
        ((f32x2*)(ws + WS_ATAB))[gt] = (f32x2){ar, ai};
        float pr = ar, pi = ai;
#pragma unroll
        for (int i = 0; i < 8; ++i) { const float tr = pr * pr - pi * pi, ti = 2.0f * pr * pi; pr = tr; pi = ti; }
        ((f32x2*)(ws + WS_ATAB2))[gt] = (f32x2){pr, pi};
        bf16* BB = (bf16*)(ws + WS_BB); bf16* CM = (bf16*)(ws + WS_CM);
        const int rre = g * 128 + (p >> 5) * 64 + (p & 31), rim = rre + 32;
        const float* bre = a.in[10] + (size_t)gt * 16; const float* bim = a.in[11] + (size_t)gt * 16;
#pragma unroll
        for (int c = 0; c < 16; c += 2) {
            const float br0 = bre[c], bi0 = bim[c], br1 = bre[c + 1], bi1 = bim[c + 1];
            *(unsigned*)(BB + (size_t)rre * 16 + c) = cvt_pk(fr * br0 - fi * bi0, fr * br1 - fi * bi1);
            *(unsigned*)(BB + (size_t)rim * 16 + c) = cvt_pk(fr * bi0 + fi * br0, fr * bi1 + fi * br1);
        }
#pragma unroll
        for (int c = 0; c < 16; ++c) {
            const float cr = a.in[12][((size_t)g * 16 + c) * 64 + p], ci = a.in[13][((size_t)g * 16 + c) * 64 + p];
            *(unsigned*)(CM + ((size_t)g * 16 + c) * 128 + 2 * p) = cvt_pk(cr, -ci);
        }
    }
}

constexpr int KP = 144, VP = 840, NKEY = 416;
constexpr int ATT_K_OFF = 0, ATT_V_OFF = NKEY * KP;
static_assert(ATT_V_OFF + 64 * VP <= 131072, "attention LDS");
__device__ __forceinline__ int crow(int r, int hi) { return (r & 3) + 8 * (r >> 2) + 4 * hi; }

__device__ __forceinline__ void attn_item(const Args& a, LAS unsigned char* lds, int item, int wave, int lane) {
    unsigned char* ws = a.ws;
    const bf16* QB = (const bf16*)(ws + WS_Q); const bf16* KB = (const bf16*)(ws + WS_K); const bf16* VB = (const bf16*)(ws + WS_V); bf16* ATT = (bf16*)(ws + WS_ATT);
    const int blk0 = (item & 31) * 2, kvh = (item >> 5) & 3, b = item >> 7;
    const int tid = threadIdx.x;
    const float* knw = a.in[5];
    for (int idx = tid; idx < NKEY * 8; idx += NTHREADS) {
        const int key = idx >> 3, ck = idx & 7; int row = -1;
        if (key < 16) row = META_ROW + key;
        else if (key < 32) row = -1;
        else if (key < 160) row = blk0 > 0 ? b * SEQ + (blk0 - 1) * 128 + (key - 32) : -1;
        else row = b * SEQ + blk0 * 128 + (key - 160);
        u32x4 kw = (u32x4){0u, 0u, 0u, 0u}, vw = (u32x4){0u, 0u, 0u, 0u};
        if (row >= 0) { kw = *(const u32x4*)(KB + (size_t)row * KVW + kvh * 64 + ck * 8); vw = *(const u32x4*)(VB + (size_t)row * KVW + kvh * 64 + ck * 8); }
        float kf[8] = {bf_lo(kw.x), bf_hi(kw.x), bf_lo(kw.y), bf_hi(kw.y), bf_lo(kw.z), bf_hi(kw.z), bf_lo(kw.w), bf_hi(kw.w)};
        float ss = 0.f;
#pragma unroll
        for (int e = 0; e < 8; ++e) ss += kf[e] * kf[e];
        ss += __shfl_xor(ss, 1); ss += __shfl_xor(ss, 2); ss += __shfl_xor(ss, 4);
        const float rs = __builtin_amdgcn_rsqf(ss * (1.0f / 64.0f) + EPS);
        const f32x4 g0 = *(const f32x4*)(knw + ck * 8), g1 = *(const f32x4*)(knw + ck * 8 + 4);
        u32x4 o; o.x = cvt_pk(kf[0] * rs * g0.x, kf[1] * rs * g0.y); o.y = cvt_pk(kf[2] * rs * g0.z, kf[3] * rs * g0.w);
        o.z = cvt_pk(kf[4] * rs * g1.x, kf[5] * rs * g1.y); o.w = cvt_pk(kf[6] * rs * g1.z, kf[7] * rs * g1.w);
        *(LAS u32x4*)(lds + ATT_K_OFF + key * KP + ck * 16) = o;
        LAS unsigned short* vt = (LAS unsigned short*)(lds + ATT_V_OFF + (ck * 8) * VP + key * 2);
        const unsigned vv[4] = {vw.x, vw.y, vw.z, vw.w};
#pragma unroll
        for (int e = 0; e < 4; ++e) { vt[(2 * e) * (VP / 2)] = (unsigned short)(vv[e] & 0xffffu); vt[(2 * e + 1) * (VP / 2)] = (unsigned short)(vv[e] >> 16); }
    }
    __syncthreads();
    const int r = wave >> 1, qh = wave & 1, hq = kvh * 4 + r, ql = lane & 31, hi = lane >> 5;
    const float sink = a.in[6][hq];
    const float* qnw = a.in[4];
    const float L2E = 1.4426950408889634f;
    for (int q4 = 0; q4 < 4; ++q4) {
        const int bl = q4 >> 1, qb = q4 & 1, blk = blk0 + bl;
        const int qblk = 2 * qh + qb;
        const size_t qrow = (size_t)b * SEQ + blk * 128 + qblk * 32 + ql;
        bf16x8 qf[4];
        {
            u32x4 qw[4]; float ss = 0.f;
#pragma unroll
            for (int ks = 0; ks < 4; ++ks) { qw[ks] = *(const u32x4*)(QB + qrow * DM + hq * 64 + 16 * ks + 8 * hi);
                const unsigned ww[4] = {qw[ks].x, qw[ks].y, qw[ks].z, qw[ks].w};
#pragma unroll
                for (int e = 0; e < 4; ++e) { const float lo = bf_lo(ww[e]), h2 = bf_hi(ww[e]); ss += lo * lo + h2 * h2; } }
            ss += __shfl_xor(ss, 32);
            const float rs = __builtin_amdgcn_rsqf(ss * (1.0f / 64.0f) + EPS) * 0.125f;
#pragma unroll
            for (int ks = 0; ks < 4; ++ks) { const f32x4 g0 = *(const f32x4*)(qnw + 16 * ks + 8 * hi), g1 = *(const f32x4*)(qnw + 16 * ks + 8 * hi + 4);
                u32x4 o; o.x = cvt_pk(bf_lo(qw[ks].x) * rs * g0.x, bf_hi(qw[ks].x) * rs * g0.y); o.y = cvt_pk(bf_lo(qw[ks].y) * rs * g0.z, bf_hi(qw[ks].y) * rs * g0.w);
                o.z = cvt_pk(bf_lo(qw[ks].z) * rs * g1.x, bf_hi(qw[ks].z) * rs * g1.y); o.w = cvt_pk(bf_lo(qw[ks].w) * rs * g1.z, bf_hi(qw[ks].w) * rs * g1.w);
                qf[ks] = __builtin_bit_cast(bf16x8, o); }
        }
        f32x16 S[6];
#pragma unroll
        for (int i = 0; i < 6; ++i) {
            const int kb = (i == 0) ? 0 : 4 * bl + qblk + i;
            f32x16 acc;
#pragma unroll
            for (int e = 0; e < 16; ++e) acc[e] = 0.f;
#pragma unroll
            for (int ks = 0; ks < 4; ++ks) { const bf16x8 kf = *(const LAS bf16x8*)(lds + ATT_K_OFF + (kb * 32 + ql) * KP + (16 * ks + 8 * hi) * 2);
                acc = __builtin_amdgcn_mfma_f32_32x32x16_bf16(kf, qf[ks], acc, 0, 0, 0); }
            S[i] = acc;
        }
        const float NEG = -INFINITY;
#pragma unroll
        for (int e = 0; e < 16; ++e) { const int kr = crow(e, hi);
            if (kr >= 16) S[0][e] = NEG;
            if (!(kr > ql)) S[1][e] = NEG;
            if (!(kr <= ql)) S[5][e] = NEG; }
        if (blk == 0) {
#pragma unroll
            for (int i = 1; i < 6; ++i) if (qblk + i <= 4) {
#pragma unroll
                for (int e = 0; e < 16; ++e) S[i][e] = NEG; }
        }
        float mx = sink;
#pragma unroll
        for (int i = 0; i < 6; ++i)
#pragma unroll
            for (int e = 0; e < 16; ++e) mx = fmaxf(mx, S[i][e]);
        mx = fmaxf(mx, __shfl_xor(mx, 32));
        float den = 0.f; const float mb = mx * L2E;
        bf16x8 pf[6][2];
#pragma unroll
        for (int i = 0; i < 6; ++i) {
            float ev[16];
#pragma unroll
            for (int e = 0; e < 16; ++e) { ev[e] = __builtin_amdgcn_exp2f(S[i][e] * L2E - mb); den += ev[e]; }
#pragma unroll
            for (int h = 0; h < 2; ++h) { u32x4 o; o.x = cvt_pk(ev[8 * h + 0], ev[8 * h + 1]); o.y = cvt_pk(ev[8 * h + 2], ev[8 * h + 3]); o.z = cvt_pk(ev[8 * h + 4], ev[8 * h + 5]); o.w = cvt_pk(ev[8 * h + 6], ev[8 * h + 7]);
                pf[i][h] = __builtin_bit_cast(bf16x8, o); }
        }
        den += __shfl_xor(den, 32);
        den += __builtin_amdgcn_exp2f(sink * L2E - mb);
        const float inv = 1.0f / den; float ssq = 0.f;
#pragma unroll
        for (int db = 0; db < 2; ++db) {
            f32x16 O;
#pragma unroll
            for (int e = 0; e < 16; ++e) O[e] = 0.f;
#pragma unroll
            for (int i = 0; i < 6; ++i) { const int kb = (i == 0) ? 0 : 4 * bl + qblk + i;
#pragma unroll
                for (int h = 0; h < 2; ++h) {
                    const LAS unsigned char* vp = lds + ATT_V_OFF + (db * 32 + ql) * VP + (kb * 32 + 16 * h + 4 * hi) * 2;
                    const u32x2 v0 = *(const LAS u32x2*)vp, v1 = *(const LAS u32x2*)(vp + 16);
                    const u32x4 vv = (u32x4){v0.x, v0.y, v1.x, v1.y};
                    O = __builtin_amdgcn_mfma_f32_32x32x16_bf16(__builtin_bit_cast(bf16x8, vv), pf[i][h], O, 0, 0, 0); } }
#pragma unroll
            for (int g = 0; g < 4; ++g) { const float o0 = O[4 * g] * inv, o1 = O[4 * g + 1] * inv, o2 = O[4 * g + 2] * inv, o3 = O[4 * g + 3] * inv; ssq += (o0 * o0 + o1 * o1) + (o2 * o2 + o3 * o3);
                u32x2 w; w.x = cvt_pk(o0, o1); w.y = cvt_pk(o2, o3);
                *(u32x2*)(ATT + qrow * DM + hq * 64 + db * 32 + 8 * g + 4 * hi) = w; }
        }
        ssq += __shfl_xor(ssq, 32);
        if (hi == 0) atomicAdd((float*)(ws + WS_ROWSA) + qrow, ssq);
    }
    __syncthreads();
}

constexpr int SP = 272;
__device__ __forceinline__ float gelu_tanh(float y) { const float t = y + 0.044715f * y * y * y; return y * __builtin_amdgcn_rcpf(1.0f + __builtin_amdgcn_exp2f(-2.302208198f * t)); }
__device__ __forceinline__ f32x2 pk_fma(f32x2 a, f32x2 b, f32x2 c) { return __builtin_elementwise_fma(a, b, c); }

template <bool FINAL>
__device__ __forceinline__ void ssm_item(const Args& a, LAS unsigned char* lds, int item, int wave, int lane) {
    static_assert(NCHUNK == 32 && CHUNK == 256, "item decode");
    unsigned char* ws = a.ws;
    const bf16* U = (const bf16*)(ws + WS_U); bf16* Z = (bf16*)(ws + WS_Q);
    float* E = (float*)(ws + WS_E);
    const bool meta = (!FINAL) && item >= 256;
    const int oct = item & 7, cp = (item >> 3) & 15, bp = (item >> 7) & 1;
    const int g = oct * 8 + wave, j = lane & 31, hi = lane >> 5;
    const int b0 = bp * 2, c0 = 2 * cp;
    bf16x8 bbf[4];
#pragma unroll
    for (int k = 0; k < 4; ++k) bbf[k] = *(const bf16x8*)((const bf16*)(ws + WS_BB) + ((size_t)g * 128 + k * 32 + j) * 16 + 8 * hi);
    const f32x2 a0 = ((const f32x2*)(ws + WS_ATAB))[g * 64 + j], a1 = ((const f32x2*)(ws + WS_ATAB))[g * 64 + 32 + j];
    const f32x2 a0x = (f32x2){a0.x, a0.x}, a0y = (f32x2){a0.y, a0.y}, na0y = (f32x2){-a0.y, -a0.y}, a1x = (f32x2){a1.x, a1.x}, a1y = (f32x2){a1.y, a1.y}, na1y = (f32x2){-a1.y, -a1.y};
    f32x2 s0r = (f32x2){0.f, 0.f}, s0i = s0r, s1r = s0r, s1i = s0r;
    bf16x8 cmf[4]; f32x4 dsk;
    if (FINAL) {
#pragma unroll
        for (int k = 0; k < 4; ++k) cmf[k] = *(const bf16x8*)((const bf16*)(ws + WS_CM) + ((size_t)g * 16 + (lane & 15)) * 128 + 32 * k + 8 * (lane >> 4));
        dsk = *(const f32x4*)(a.in[14] + g * 16 + 4 * (lane >> 4));
        const f32x2 t0 = ((const f32x2*)(ws + WS_ATAB2))[g * 64 + j], t1 = ((const f32x2*)(ws + WS_ATAB2))[g * 64 + 32 + j];
        const f32x2 m0 = ((const f32x2*)(ws + WS_SMETA))[g * 64 + j], m1 = ((const f32x2*)(ws + WS_SMETA))[g * 64 + 32 + j];
        float c0r = m0.x, c0i = m0.y, c1r = m1.x, c1i = m1.y;
        const f32x2* Eb = (const f32x2*)E + ((size_t)((b0 + hi) * 64 + g) * NCHUNK) * 64;
#pragma unroll
        for (int half = 0; half < 2; ++half) {
            if (half * 16 < c0) {
                f32x2 e0[16], e1[16];
#pragma unroll
                for (int c = 0; c < 16; ++c) { const int cc = half * 16 + c < NCHUNK - 1 ? half * 16 + c : NCHUNK - 2; e0[c] = Eb[cc * 64 + j]; e1[c] = Eb[cc * 64 + 32 + j]; }
#pragma unroll
                for (int c = 0; c < 16; ++c) if (half * 16 + c < c0) {
                    const float n0r = fmaf(t0.x, c0r, fmaf(-t0.y, c0i, e0[c].x)), n0i = fmaf(t0.x, c0i, fmaf(t0.y, c0r, e0[c].y));
                    const float n1r = fmaf(t1.x, c1r, fmaf(-t1.y, c1i, e1[c].x)), n1i = fmaf(t1.x, c1i, fmaf(t1.y, c1r, e1[c].y));
                    c0r = n0r; c0i = n0i; c1r = n1r; c1i = n1i; }
            }
        }
        const f32x2 ec0 = Eb[c0 * 64 + j], ec1 = Eb[c0 * 64 + 32 + j];
        s0r = (f32x2){c0r, fmaf(t0.x, c0r, fmaf(-t0.y, c0i, ec0.x))}; s0i = (f32x2){c0i, fmaf(t0.x, c0i, fmaf(t0.y, c0r, ec0.y))};
        s1r = (f32x2){c1r, fmaf(t1.x, c1r, fmaf(-t1.y, c1i, ec1.x))}; s1i = (f32x2){c1i, fmaf(t1.x, c1i, fmaf(t1.y, c1r, ec1.y))};
    }
    const int bsel = (j >> 2) & 1, csel = j & 1, tt = ((j & 3) >> 1) + 2 * (j >> 3);
    const size_t urow0 = meta ? (size_t)META_ROW + tt : (size_t)(b0 + bsel) * SEQ + (size_t)(c0 + csel) * CHUNK + tt;
    const bf16* up = U + urow0 * DM + g * 16 + 8 * hi;
    LAS unsigned char* sl = lds + wave * (32 * SP);
    const int nsteps = meta ? 2 : CHUNK / 8;
    const size_t erow = (size_t)b0 * SEQ + (size_t)(c0 + ((lane & 15) >> 3)) * CHUNK + (lane & 7);
    const bf16* ue = U + erow * DM + g * 16 + 4 * (lane >> 4);
    bf16* ze = Z + erow * DM + g * 16 + 4 * (lane >> 4);
    bf16x8 uf = *(const bf16x8*)up;
    u32x2 uu0 = (u32x2){0u, 0u}, uu1 = (u32x2){0u, 0u};
    if (FINAL) { uu0 = *(const u32x2*)ue; uu1 = *(const u32x2*)(ue + (size_t)SEQ * DM); }
    for (int st = 0; st < nsteps; ++st) {
        bf16x8 ufn = uf; u32x2 un0 = uu0, un1 = uu1;
        if (st + 1 < nsteps) { ufn = *(const bf16x8*)(up + (size_t)(st + 1) * 8 * DM);
            if (FINAL) { un0 = *(const u32x2*)(ue + (size_t)(st + 1) * 8 * DM); un1 = *(const u32x2*)(ue + (size_t)(st + 1) * 8 * DM + (size_t)SEQ * DM); } }
        f32x16 X[4];
#pragma unroll
        for (int k = 0; k < 4; ++k) { f32x16 z;
#pragma unroll
            for (int e = 0; e < 16; ++e) z[e] = 0.f;
            X[k] = __builtin_amdgcn_mfma_f32_32x32x16_bf16(uf, bbf[k], z, 0, 0, 0); }
#pragma unroll
        for (int t = 0; t < 8; ++t) {
            const f32x2 x0r = (f32x2){X[0][2 * t], X[0][2 * t + 1]}, x0i = (f32x2){X[1][2 * t], X[1][2 * t + 1]}, x1r = (f32x2){X[2][2 * t], X[2][2 * t + 1]}, x1i = (f32x2){X[3][2 * t], X[3][2 * t + 1]};
            const f32x2 n0r = pk_fma(a0x, s0r, pk_fma(na0y, s0i, x0r)), n0i = pk_fma(a0x, s0i, pk_fma(a0y, s0r, x0i));
            const f32x2 n1r = pk_fma(a1x, s1r, pk_fma(na1y, s1i, x1r)), n1i = pk_fma(a1x, s1i, pk_fma(a1y, s1r, x1i));
            s0r = n0r; s0i = n0i; s1r = n1r; s1i = n1i;
            if (FINAL) {
                LAS unsigned char* r0 = sl + ((hi * 2 + 0) * 8 + t) * SP; LAS unsigned char* r1 = sl + ((hi * 2 + 1) * 8 + t) * SP;
                *(LAS unsigned*)(r0 + j * 4) = cvt_pk(n0r.x, n0i.x); *(LAS unsigned*)(r0 + (32 + j) * 4) = cvt_pk(n1r.x, n1i.x);
                *(LAS unsigned*)(r1 + j * 4) = cvt_pk(n0r.y, n0i.y); *(LAS unsigned*)(r1 + (32 + j) * 4) = cvt_pk(n1r.y, n1i.y); }
        }
        if (FINAL) {
            LDS_WAIT(); asm volatile("" ::: "memory");
#pragma unroll
            for (int bh = 0; bh < 2; ++bh) {
                f32x4 Y = (f32x4){0.f, 0.f, 0.f, 0.f};
#pragma unroll
                for (int k = 0; k < 4; ++k) { const bf16x8 sf = *(const LAS bf16x8*)(sl + (bh * 16 + (lane & 15)) * SP + (32 * k + 8 * (lane >> 4)) * 2);
                    Y = __builtin_amdgcn_mfma_f32_16x16x32_bf16(cmf[k], sf, Y, 0, 0, 0); }
                const u32x2 uu = bh ? uu1 : uu0;
                const float y0 = Y[0] + dsk.x * bf_lo(uu.x), y1 = Y[1] + dsk.y * bf_hi(uu.x), y2 = Y[2] + dsk.z * bf_lo(uu.y), y3 = Y[3] + dsk.w * bf_hi(uu.y);
                u32x2 w; w.x = cvt_pk(gelu_tanh(y0), gelu_tanh(y1)); w.y = cvt_pk(gelu_tanh(y2), gelu_tanh(y3));
                *(u32x2*)(ze + (size_t)st * 8 * DM + (size_t)bh * SEQ * DM) = w;
            }
            LDS_WAIT(); asm volatile("" ::: "memory");
        }
        uf = ufn; uu0 = un0; uu1 = un1;
    }
    if (!FINAL) {
        if (meta) { if (hi == 0) { ((f32x2*)(ws + WS_SMETA))[g * 64 + j] = (f32x2){s0r.x, s0i.x}; ((f32x2*)(ws + WS_SMETA))[g * 64 + 32 + j] = (f32x2){s1r.x, s1i.x}; } }
        else { f32x2* Eb = (f32x2*)E + ((size_t)((b0 + hi) * 64 + g) * NCHUNK + c0) * 64;
            Eb[j] = (f32x2){s0r.x, s0i.x}; Eb[32 + j] = (f32x2){s1r.x, s1i.x}; Eb[64 + j] = (f32x2){s0r.y, s0i.y}; Eb[64 + 32 + j] = (f32x2){s1r.y, s1i.y}; }
    }
}

#define XB_TMO      128
#define XB_XCNT(j)  (256  + 64 * (j))
#define XB_XSUB(j)  (1280 + 64 * (j))
#define XB_XGEN(j)  (2304 + 64 * (j))
#define XB_TOP      3328
#define XB_TOPGEN   3392
#define XCD_BAR_WORDS 3456
#define XB_SPIN_CAP (1u << 18)

__device__ __forceinline__ unsigned xb_ld(unsigned* p)              { return __hip_atomic_load(p, __ATOMIC_RELAXED, __HIP_MEMORY_SCOPE_AGENT); }
__device__ __forceinline__ unsigned xb_add(unsigned* p, unsigned v) { return __hip_atomic_fetch_add(p, v, __ATOMIC_RELAXED, __HIP_MEMORY_SCOPE_AGENT); }
__device__ __forceinline__ unsigned xb_xcc_id() { return (unsigned)__builtin_amdgcn_s_getreg((3 << 11) | 20) & 0xFu; }
#define XB_SPIN(cond, bar) do { unsigned _sp = 0; while (cond) { __builtin_amdgcn_s_sleep(1); \
    if ((++_sp & 255u) == 0u) { if (xb_ld(&(bar)[XB_TMO])) break; if (_sp > XB_SPIN_CAP) { atomicAdd(&(bar)[XB_TMO], 1u); break; } } } } while (0)

struct XcdBarrier {
    unsigned* bar; unsigned x;
    volatile LAS unsigned* st;
};

__device__ __forceinline__ XcdBarrier xcd_barrier_post(unsigned* bar, volatile LAS unsigned* st) {
    XcdBarrier b; b.bar = bar; b.x = xb_xcc_id(); b.st = st;
    if (threadIdx.x == 0) (void)xb_add(&bar[XB_XCNT(b.x)], 1u);
    return b;
}
__device__ __forceinline__ void xcd_barrier_complete(unsigned* bar, unsigned x, unsigned& nloc, unsigned& nx) {
    const unsigned G = gridDim.x * gridDim.y * gridDim.z;
    unsigned sum, cnt, mine, sp = 0u;
    for (;;) {
        sum = 0u; cnt = 0u; mine = 0u;
#pragma unroll
        for (unsigned j = 0; j < 16; ++j) { const unsigned c = xb_ld(&bar[XB_XCNT(j)]); sum += c; cnt += (c > 0u) ? 1u : 0u; mine = (j == x) ? c : mine; }
        if (sum == G) break;
        __builtin_amdgcn_s_sleep(1);
        if ((++sp & 255u) == 0u) { if (xb_ld(&bar[XB_TMO])) break; if (sp > XB_SPIN_CAP) { atomicAdd(&bar[XB_TMO], 1u); break; } }
    }
    nloc = mine > 0u ? mine : 1u; nx = cnt > 0u ? cnt : 1u;
}

__device__ __forceinline__ void xcd_barrier(const XcdBarrier& b) {
    asm volatile("s_waitcnt vmcnt(0)" ::: "memory");
    __syncthreads();
    if (threadIdx.x == 0) {
        unsigned* bar = b.bar;
        __builtin_amdgcn_s_waitcnt(0);
        unsigned nloc = b.st[0], nx = b.st[1];
        if (nloc == 0u) { xcd_barrier_complete(bar, b.x, nloc, nx); b.st[0] = nloc; b.st[1] = nx; }
        const unsigned old = xb_add(&bar[XB_XSUB(b.x)], 1u);
        const unsigned gen = old / nloc;
        if (old + 1u == (gen + 1u) * nloc) {
            __builtin_amdgcn_fence(__ATOMIC_RELEASE, "agent");
            asm volatile("s_waitcnt vmcnt(0)" ::: "memory");
            const unsigned og = xb_add(&bar[XB_TOP], 1u);
            const unsigned tg = og / nx;
            if (og + 1u == (tg + 1u) * nx) xb_add(&bar[XB_TOPGEN], 1u);
            else XB_SPIN(xb_ld(&bar[XB_TOPGEN]) == tg, bar);
            __builtin_amdgcn_fence(__ATOMIC_ACQUIRE, "agent");
            xb_add(&bar[XB_XGEN(b.x)], 1u);
            asm volatile("s_waitcnt vmcnt(0)" ::: "memory");
        } else {
            XB_SPIN(xb_ld(&bar[XB_XGEN(b.x)]) == gen, bar);
            __builtin_amdgcn_fence(__ATOMIC_ACQUIRE, "agent");
            asm volatile("s_waitcnt vmcnt(0)" ::: "memory");
        }
    }
    __syncthreads();
}

__device__ __forceinline__ void meta_proj(const Args& a, int wave, int lane) {
    unsigned char* ws = a.ws;
    const bf16* XB = (const bf16*)(ws + WS_XB); const bf16* W1t = (const bf16*)(ws + WS_W1); const float* rstdx = (const float*)(ws + WS_RSTDX);
    for (int gw = blockIdx.x * NWAVES + wave; gw < 1536; gw += gridDim.x * NWAVES) {
    const int n = 1024 + gw;
    float wf[16];
    { const u32x4 w0 = *(const u32x4*)(W1t + (size_t)n * DM + lane * 8), w1 = *(const u32x4*)(W1t + (size_t)n * DM + 512 + lane * 8);
      const unsigned ww[8] = {w0.x, w0.y, w0.z, w0.w, w1.x, w1.y, w1.z, w1.w};
#pragma unroll
      for (int e = 0; e < 8; ++e) { wf[2 * e] = bf_lo(ww[e]); wf[2 * e + 1] = bf_hi(ww[e]); } }
    float mine = 0.f;
#pragma unroll
    for (int r = 0; r < 16; ++r) {
        const u32x4 x0 = *(const u32x4*)(XB + (size_t)(META_ROW + r) * DM + lane * 8), x1 = *(const u32x4*)(XB + (size_t)(META_ROW + r) * DM + 512 + lane * 8);
        const unsigned xx[8] = {x0.x, x0.y, x0.z, x0.w, x1.x, x1.y, x1.z, x1.w};
        float s = 0.f;
#pragma unroll
        for (int e = 0; e < 8; ++e) s += bf_lo(xx[e]) * wf[2 * e] + bf_hi(xx[e]) * wf[2 * e + 1];
        s = wave_sum(s);
        if (lane == r) mine = s;
    }
    if (lane < 16) {
        const unsigned short o = (unsigned short)(cvt_pk(mine * rstdx[META_ROW + lane], 0.f) & 0xffffu);
        const size_t row = META_ROW + lane;
        if (n < 1280) ((bf16*)(ws + WS_K))[row * KVW + (n - 1024)] = o;
        else if (n < 1536) ((bf16*)(ws + WS_V))[row * KVW + (n - 1280)] = o;
        else ((bf16*)(ws + WS_U))[row * DM + (n - 1536)] = o;
    }
    }
}

constexpr int MISC_OFF = LDS_BYTES - 256;
constexpr size_t WS_BAR = 768 * 1024;
__global__ void __launch_bounds__(NTHREADS, 2) mk_fwd(Args a) {
    extern __shared__ __attribute__((aligned(16))) unsigned char lds_raw[];
    cg::grid_group grid = cg::this_grid();
    LAS unsigned char* lds = (LAS unsigned char*)lds_raw;
    const int tid = threadIdx.x, lane = tid & 63, wave = __builtin_amdgcn_readfirstlane(tid >> 6);
    unsigned char* ws = a.ws;
    const int G = gridDim.x, c = blockIdx.x;
    volatile LAS unsigned* MISC = (volatile LAS unsigned*)(lds + MISC_OFF);
    if (tid < 32) MISC[tid] = 0u;
    __syncthreads();
    unsigned* barw = (unsigned*)(ws + WS_BAR);
    XcdBarrier bar = xcd_barrier_post(barw, MISC + 8);
    if (a.never) grid.sync();

    p0_prologue(a, lds, wave, lane);
    xcd_barrier(bar);
    meta_proj(a, wave, lane);
    { pg8::Gemm g{(const pg8::bf16_t*)(ws + WS_XB), (const pg8::bf16_t*)(ws + WS_W1), NTOK, NQKVU, DM}; pg8::StaticOrder S; S.init(NTOK, NQKVU, G, c);
      EpiProj E{(bf16*)(ws + WS_Q), (bf16*)(ws + WS_K), (bf16*)(ws + WS_V), (bf16*)(ws + WS_U), (const float*)(ws + WS_RSTDX)};
      pg8::gemm_phase<EpiProj, pg8::StaticOrder, true, true>(lds, g, S, E); }
    xcd_barrier(bar);
    for (int it = c; it < 512; it += G) attn_item(a, lds, it, wave, lane);
    for (int it = c; it < 256 + 8; it += G) ssm_item<false>(a, lds, it, wave, lane);
    xcd_barrier(bar);
    for (int it = c; it < 256; it += G) ssm_item<true>(a, lds, it, wave, lane);
    xcd_barrier(bar);
    { pg8::Gemm g{(const pg8::bf16_t*)(ws + WS_Q), (const pg8::bf16_t*)(ws + WS_W2), NTOK, 2048, DM}; pg8::StaticOrder S; S.init(NTOK, 2048, G, c);
      EpiGlu E{(bf16*)(ws + WS_U), DM, (float*)(ws + WS_ROWSB)};
      pg8::gemm_phase<EpiGlu, pg8::StaticOrder, true, true>(lds, g, S, E); }
    xcd_barrier(bar);
    { pg8::Gemm g{(const pg8::bf16_t*)(ws + WS_XB), (const pg8::bf16_t*)(ws + WS_WG), NTOK, 2048, DM}; pg8::StaticOrder S; S.init(NTOK, 2048, G, c);
      EpiMerge E{(const bf16*)(ws + WS_ATT), (const bf16*)(ws + WS_U), (bf16*)(ws + WS_Q), (const float*)(ws + WS_RSTDX), (const float*)(ws + WS_ROWSA), (const float*)(ws + WS_ROWSB), a.in[16], a.in[17]};
      pg8::gemm_phase<EpiMerge, pg8::StaticOrder, true, true>(lds, g, S, E); }
    xcd_barrier(bar);
    { pg8::Gemm g{(const pg8::bf16_t*)(ws + WS_Q), (const pg8::bf16_t*)(ws + WS_W3), NTOK, DM, DM}; pg8::StaticOrder S; S.init(NTOK, DM, G, c);
      EpiResid1 E{(const bf16*)(ws + WS_XB), (bf16*)(ws + WS_ATT), (float*)(ws + WS_ROWSS)};
      pg8::gemm_phase<EpiResid1, pg8::StaticOrder, true, true>(lds, g, S, E); }
    xcd_barrier(bar);
    { pg8::Gemm g{(const pg8::bf16_t*)(ws + WS_ATT), (const pg8::bf16_t*)(ws + WS_W4), NTOK, 2 * DFF, DM}; pg8::StaticOrder S; S.init(NTOK, 2 * DFF, G, c);
      EpiSwiglu E{(bf16*)(ws + WS_ACT), DFF, (const float*)(ws + WS_ROWSS)};
      pg8::gemm_phase<EpiSwiglu, pg8::StaticOrder, true, true, true>(lds, g, S, E); }
    xcd_barrier(bar);
    { pg8::Gemm g{(const pg8::bf16_t*)(ws + WS_ACT), (const pg8::bf16_t*)(ws + WS_W5), NTOK, DM, DFF}; pg8::StaticOrder S; S.init(NTOK, DM, G, c);
      EpiResid2 E{(const bf16*)(ws + WS_ATT), a.out};
      pg8::gemm_phase<EpiResid2, pg8::StaticOrder, true, true>(lds, g, S, E); }
}

extern "C" void kernel_launch(void* const* d_in, const int* in_sizes, int n_in, void* d_out, int out_size, void* d_ws, size_t ws_size, hipStream_t stream) {
    static int grid = 0;
    if (grid == 0) {
        if (n_in != 22 || in_sizes[0] != NTOK * DM || out_size != NTOK * DM || ws_size < WS_END) { fprintf(stderr, "kernel_launch: unexpected shapes (n_in %d, in0 %d, out %d, ws %zu)\n", n_in, n_in > 0 ? in_sizes[0] : -1, out_size, ws_size); grid = -1; return; }
        int dev = 0, cus = 0, per_cu = 0;
        (void)hipGetDevice(&dev); (void)hipDeviceGetAttribute(&cus, hipDeviceAttributeMultiprocessorCount, dev);
        if (hipFuncSetAttribute((const void*)mk_fwd, hipFuncAttributeMaxDynamicSharedMemorySize, LDS_BYTES) != hipSuccess) { fprintf(stderr, "kernel_launch: hipFuncSetAttribute failed\n"); grid = -1; return; }
        if (hipOccupancyMaxActiveBlocksPerMultiprocessor(&per_cu, (const void*)mk_fwd, NTHREADS, LDS_BYTES) != hipSuccess || per_cu < 1) { fprintf(stderr, "kernel_launch: occupancy query says %d; nothing launched\n", per_cu); grid = -1; return; }
        (void)hipGetLastError();
        grid = cus;
    }
    if (grid < 0) return;
    Args a{};
    for (int i = 0; i < 22; ++i) a.in[i] = (const float*)d_in[i];
    a.out = (float*)d_out; a.ws = (unsigned char*)d_ws;
    if (hipMemsetAsync((unsigned char*)d_ws + WS_BAR, 0, XCD_BAR_WORDS * 4, stream) != hipSuccess) { fprintf(stderr, "kernel_launch: memset of the barrier words failed\n"); return; }
    void* args[] = {&a};
    hipError_t e = hipLaunchCooperativeKernel((const void*)mk_fwd, dim3(grid), dim3(NTHREADS), args, LDS_BYTES, stream);
    if (e != hipSuccess) fprintf(stderr, "cooperative launch failed: %s (grid %d)\n", hipGetErrorString(e), grid);
}
```

```cpp
#include <hip/hip_runtime.h>
#include <hip/hip_cooperative_groups.h>
#include <cstdio>
#include <cstdint>
namespace cg = cooperative_groups;
namespace pg8 {
#define PG8_LAS __attribute__((address_space(3)))
typedef unsigned short bf16_t;
typedef short bf16x8 __attribute__((ext_vector_type(8)));
typedef float f32x4 __attribute__((ext_vector_type(4)));
typedef unsigned u32x4 __attribute__((ext_vector_type(4)));
constexpr int BM = 256, BK = 64, HALF = 128, HTB = HALF * BK * 2  , STAGE_BYTES = 8 * HTB, NXCD = 8, WGM = 8;

__host__ __device__ __forceinline__ int lds_byte(int r, int c) { const int st = (r >> 4) * 2 + (c >> 5), rr = r & 15, cc = c & 31, ob = rr * 64 + cc * 2; return st * 1024 + (ob ^ (((ob >> 9) & 1) << 5)); }
__host__ __device__ __forceinline__ void stage_rc(int b, int& R, int& C) { const int st = b / 1024, sb = b % 1024, swz = sb ^ (((sb >> 9) & 1) << 5); R = (st >> 1) * 16 + swz / 64; C = (st & 1) * 32 + (swz % 64) / 2; }
__host__ __device__ __forceinline__ int perm32(int rho) { const int n = rho >> 4, i = rho & 15; return 8 * (i >> 2) + 4 * n + (i & 3); }

struct Unit { int pm, pn; };
struct Gemm { const bf16_t* A; const bf16_t* Bt; int M, N, K; };

struct StaticOrder {
    int nM, nN, nwg, G, c;
    __host__ __device__ void init(int M, int N, int G_, int c_) { nM = M / BM; nN = N / BM; nwg = nM * nN; G = G_; c = c_; }
    __host__ __device__ bool next(int i, Unit& u) const {
        const long L = (long)i * G + c; if (L >= nwg) return false;
        int wgid = (int)L; { const int q = nwg / NXCD, r = nwg % NXCD, xcd = wgid % NXCD, off = wgid / NXCD; wgid = (xcd < r ? xcd * (q + 1) : r * (q + 1) + (xcd - r) * q) + off; }
        const int nig = WGM * nN, gid = wgid / nig, fm = gid * WGM, gsz = (nM - fm) < WGM ? (nM - fm) : WGM;
        u.pm = fm + ((wgid % nig) % gsz); u.pn = (wgid % nig) / gsz; return true;
    }
    __device__ __forceinline__ void a_ready(const Unit&) const {}
    __device__ __forceinline__ void done(const Unit&) const {}
};

__device__ __forceinline__ unsigned cvt_pk_bf16(float lo, float hi) { unsigned r; asm volatile("v_cvt_pk_bf16_f32 %0, %1, %2" : "=v"(r) : "v"(lo), "v"(hi)); return r; }
typedef float f32x2 __attribute__((ext_vector_type(2)));
__device__ __forceinline__ f32x2 gelu_pk(f32x2 v) {
    const f32x2 av = __builtin_elementwise_abs(v), d = av * 0.2316418882f + 1.0f;
    f32x2 t; t.x = __builtin_amdgcn_rcpf(d.x); t.y = __builtin_amdgcn_rcpf(d.y);
    f32x2 q = t * 0.5307027145f + (-0.7265760135f); q = q * t + 0.7107068705f; q = q * t + (-0.142248368f); q = q * t + 0.127414796f; q = q * t;
    const f32x2 s = (v * v) * (-0.72134752044f);
    f32x2 e; e.x = __builtin_amdgcn_exp2f(s.x); e.y = __builtin_amdgcn_exp2f(s.y);
    const f32x2 m = v * (q * e), r = v - m;
    f32x2 o; o.x = v.x < 0.f ? m.x : r.x; o.y = v.y < 0.f ? m.y : r.y; return o;
}

template <int ACT  > struct EpiBf16 {
    static constexpr bool PERM = true, AFTER_DRAIN = false; static_assert(ACT == 0 || ACT == 1, "EpiBf16: ACT is 0 (none) or 1 (gelu_pk)");
    bf16_t* O; int ldc; const float* bias; int split_cols; size_t split_stride; float scale0;
    __device__ __forceinline__ void operator()(const f32x4 (&acc)[2][2][4][2], const Unit& u, int wr, int wc, int fr, int fq) const {
        const int row0 = u.pm * BM + wr * 64 + fr; int colt = u.pn * BM; bf16_t* base = O;
        float sc = 1.f; if (split_cols) { const int t = colt / split_cols; base += (size_t)t * split_stride; colt -= t * split_cols; if (t == 0) sc = scale0; }
        const int col0 = colt + wc * 32 + 8 * fq, bcol0 = u.pn * BM + wc * 32 + 8 * fq;
        f32x4 bv[2][2];
#pragma unroll
        for (int bj = 0; bj < 2; ++bj)
#pragma unroll
            for (int n = 0; n < 2; ++n) bv[bj][n] = bias ? *(const f32x4*)(bias + bcol0 + bj * HALF + 4 * n) : (f32x4){0.f, 0.f, 0.f, 0.f};
#pragma unroll
        for (int ai = 0; ai < 2; ++ai)
#pragma unroll
            for (int m = 0; m < 4; ++m) { bf16_t* rowp = base + (size_t)(row0 + ai * HALF + m * 16) * ldc + col0;
#pragma unroll
                for (int bj = 0; bj < 2; ++bj) { f32x4 v0 = acc[ai][bj][m][0] + bv[bj][0], v1 = acc[ai][bj][m][1] + bv[bj][1];
                    if (ACT == 1) { f32x2 a = gelu_pk((f32x2){v0[0], v0[1]}), b = gelu_pk((f32x2){v0[2], v0[3]}), c = gelu_pk((f32x2){v1[0], v1[1]}), d = gelu_pk((f32x2){v1[2], v1[3]});
                        v0 = (f32x4){a.x, a.y, b.x, b.y}; v1 = (f32x4){c.x, c.y, d.x, d.y}; }
                    v0 = v0 * sc; v1 = v1 * sc; u32x4 w; w.x = cvt_pk_bf16(v0[0], v0[1]); w.y = cvt_pk_bf16(v0[2], v0[3]); w.z = cvt_pk_bf16(v1[0], v1[1]); w.w = cvt_pk_bf16(v1[2], v1[3]);
                    *(u32x4*)(rowp + bj * HALF) = w; } }
    }
};
template <bool F16> __device__ __forceinline__ f32x4 mma16(bf16x8 b, bf16x8 a, f32x4 c) {
    if constexpr (F16) { typedef _Float16 h16x8 __attribute__((ext_vector_type(8))); return __builtin_amdgcn_mfma_f32_16x16x32_f16(__builtin_bit_cast(h16x8, b), __builtin_bit_cast(h16x8, a), c, 0, 0, 0); }
    else return __builtin_amdgcn_mfma_f32_16x16x32_bf16(b, a, c, 0, 0, 0);
}
template <class Epi, class Sched, bool ALIGN_EPI = false, bool SP2 = false, bool F16 = false>
__device__ __forceinline__ void gemm_phase(PG8_LAS unsigned char* lds, const Gemm g, const Sched& S, const Epi& E) {
    const int tid = threadIdx.x, wid = __builtin_amdgcn_readfirstlane(tid >> 6), lane = tid & 63, wr = wid >> 2, wc = wid & 3, fr = lane & 15, fq = lane >> 4;
    const int K = g.K, nt = K / BK;
    unsigned voffA[2], voffB[2];
#pragma unroll
    for (int i = 0; i < 2; ++i) { int R, C; stage_rc(tid * 16 + i * 8192, R, C); const int Rb = Epi::PERM ? ((R & ~31) + perm32(R & 31)) : R;
        voffA[i] = (unsigned)(R * K + C) * 2u; voffB[i] = (unsigned)(Rb * K + C) * 2u; }
    const size_t kstep = (size_t)(BK * 2);
    const size_t hstep = (size_t)HALF * K * 2;
    const size_t tstep = 2 * hstep;
    const unsigned ldsw = (unsigned)wid * 1024u;
    const int aoff = lds_byte(wr * 64 + fr, fq * 8), boff = lds_byte(wc * 32 + fr, fq * 8);
#define PG8_SA(b, h) (((b) * 2 + (h)) * HTB)
#define PG8_SB(b, h) ((4 + (b) * 2 + (h)) * HTB)
#define PG8_STAGE(bufoff, gbase, voff) do { _Pragma("unroll") for (int _i = 0; _i < 2; ++_i) \
        __builtin_amdgcn_global_load_lds((const unsigned*)((const char*)(gbase) + (voff)[_i]), (PG8_LAS unsigned*)(lds + (bufoff) + ldsw + _i * 8192), 16, 0, 0); } while (0)
#define PG8_LDA(dst, b, h) do { _Pragma("unroll") for (int m = 0; m < 4; ++m) _Pragma("unroll") for (int k = 0; k < 2; ++k) dst[m][k] = *(const PG8_LAS bf16x8*)(lds + PG8_SA(b, h) + aoff + m * 2048 + k * 1024); } while (0)
#define PG8_LDB(dst, b, h) do { _Pragma("unroll") for (int n = 0; n < 2; ++n) _Pragma("unroll") for (int k = 0; k < 2; ++k) dst[n][k] = *(const PG8_LAS bf16x8*)(lds + PG8_SB(b, h) + boff + n * 2048 + k * 1024); } while (0)
#define PG8_MMA(ai, bj, At, Bt) do { __builtin_amdgcn_s_setprio(1); _Pragma("unroll") for (int m = 0; m < 4; ++m) _Pragma("unroll") for (int n = 0; n < 2; ++n) _Pragma("unroll") for (int k = 0; k < 2; ++k) \
        acc[ai][bj][m][n] = mma16<F16>(Bt[n][k], At[m][k], acc[ai][bj][m][n]); __builtin_amdgcn_s_setprio(0); } while (0)
#define PG8_WAIT_V(n) asm volatile("s_waitcnt vmcnt(" #n ")" ::: "memory")
#define PG8_WAIT_L(n) asm volatile("s_waitcnt lgkmcnt(" #n ")" ::: "memory")
#define PG8_BAR __builtin_amdgcn_s_barrier()
#define PG8_SCHED __builtin_amdgcn_sched_barrier(0)
    Unit cur, nxt; int ui = 0;
    if (!S.next(0, cur)) return;
    f32x4 acc[2][2][4][2];
#pragma unroll
    for (int a = 0; a < 2; ++a)
#pragma unroll
        for (int b = 0; b < 2; ++b)
#pragma unroll
            for (int m = 0; m < 4; ++m)
#pragma unroll
                for (int n = 0; n < 2; ++n) acc[a][b][m][n] = (f32x4){0.f, 0.f, 0.f, 0.f};
    bf16x8 At[4][2], B0[2][2], B1[2][2];
    const char* cA = (const char*)g.A + (size_t)cur.pm * tstep; const char* cB = (const char*)g.Bt + (size_t)cur.pn * tstep;
    S.a_ready(cur);
    if constexpr (SP2) {
        PG8_STAGE(PG8_SB(0, 0), cB, voffB); PG8_STAGE(PG8_SB(0, 1), cB + hstep, voffB); PG8_STAGE(PG8_SA(0, 0), cA, voffA); PG8_STAGE(PG8_SA(0, 1), cA + hstep, voffA);
        if (wr == 1) PG8_BAR;
        PG8_WAIT_V(2); PG8_BAR;
        PG8_STAGE(PG8_SB(1, 0), cB + kstep, voffB); PG8_STAGE(PG8_SA(1, 0), cA + kstep, voffA); PG8_STAGE(PG8_SB(1, 1), cB + hstep + kstep, voffB);
        PG8_WAIT_V(6); PG8_BAR;
    } else {
        PG8_STAGE(PG8_SB(0, 0), cB, voffB); PG8_STAGE(PG8_SA(0, 0), cA, voffA); PG8_STAGE(PG8_SB(0, 1), cB + hstep, voffB); PG8_STAGE(PG8_SA(0, 1), cA + hstep, voffA);
        if (wr == 1) PG8_BAR;
        PG8_WAIT_V(4); PG8_BAR;
        PG8_STAGE(PG8_SB(1, 0), cB + kstep, voffB); PG8_STAGE(PG8_SA(1, 0), cA + kstep, voffA); PG8_STAGE(PG8_SB(1, 1), cB + hstep + kstep, voffB);
        PG8_WAIT_V(6); PG8_BAR;
    }
    for (;;) {
        const bool has_next = S.next(ui + 1, nxt);
        const char* nA = has_next ? (const char*)g.A + (size_t)nxt.pm * tstep : cA; const char* nB = has_next ? (const char*)g.Bt + (size_t)nxt.pn * tstep : cB;
        for (int t = 0; t < nt; t += 2) {
            const bool last = (t == nt - 2);
            const char* a1 = cA + (size_t)(t + 1) * kstep;
            const char* a2 = last ? nA : cA + (size_t)(t + 2) * kstep; const char* b2 = last ? nB : cB + (size_t)(t + 2) * kstep;
            const char* a3 = a2 + kstep; const char* b3 = b2 + kstep;
            if (last && has_next) S.a_ready(nxt);
            if constexpr (SP2) {
            PG8_LDB(B0, 0, 0); PG8_LDB(B1, 0, 1); PG8_SCHED; PG8_LDA(At, 0, 0); PG8_STAGE(PG8_SA(1, 1), a1 + hstep, voffA);
            PG8_WAIT_V(8); PG8_WAIT_L(0); PG8_BAR; PG8_MMA(0, 0, At, B0); PG8_MMA(0, 1, At, B1); PG8_BAR; PG8_SCHED;
            PG8_LDA(At, 0, 1); PG8_STAGE(PG8_SB(0, 0), b2, voffB); PG8_STAGE(PG8_SB(0, 1), b2 + hstep, voffB); PG8_STAGE(PG8_SA(0, 0), a2, voffA);
            PG8_WAIT_V(8); PG8_WAIT_L(0); PG8_BAR; PG8_MMA(1, 0, At, B0); PG8_MMA(1, 1, At, B1); PG8_BAR; PG8_SCHED;
            PG8_LDB(B0, 1, 0); PG8_LDB(B1, 1, 1); PG8_SCHED; PG8_LDA(At, 1, 0); PG8_STAGE(PG8_SA(0, 1), a2 + hstep, voffA);
            PG8_WAIT_V(8); PG8_WAIT_L(0); PG8_BAR; PG8_MMA(0, 0, At, B0); PG8_MMA(0, 1, At, B1); PG8_BAR; PG8_SCHED;
            PG8_LDA(At, 1, 1); PG8_STAGE(PG8_SB(1, 0), b3, voffB); PG8_STAGE(PG8_SB(1, 1), b3 + hstep, voffB); PG8_STAGE(PG8_SA(1, 0), a3, voffA);
            PG8_WAIT_V(8); PG8_WAIT_L(0); PG8_BAR; PG8_MMA(1, 0, At, B0); PG8_MMA(1, 1, At, B1); PG8_BAR; PG8_SCHED;
            } else {
            PG8_LDB(B0, 0, 0); PG8_SCHED; PG8_LDA(At, 0, 0); PG8_STAGE(PG8_SA(1, 1), a1 + hstep, voffA);
            PG8_WAIT_L(8); PG8_BAR; PG8_WAIT_L(0); PG8_MMA(0, 0, At, B0); PG8_BAR; PG8_SCHED;
            PG8_LDB(B1, 0, 1); PG8_STAGE(PG8_SB(0, 0), b2, voffB);
            PG8_BAR; PG8_WAIT_L(0); PG8_MMA(0, 1, At, B1); PG8_BAR;
            PG8_LDA(At, 0, 1); PG8_STAGE(PG8_SA(0, 0), a2, voffA);
            PG8_BAR; PG8_WAIT_L(0); PG8_MMA(1, 0, At, B0); PG8_BAR; PG8_SCHED;
            PG8_STAGE(PG8_SB(0, 1), b2 + hstep, voffB);
            PG8_WAIT_V(6); PG8_BAR; PG8_MMA(1, 1, At, B1); PG8_BAR;
            PG8_LDB(B0, 1, 0); PG8_SCHED; PG8_LDA(At, 1, 0); PG8_STAGE(PG8_SA(0, 1), a2 + hstep, voffA);
            PG8_WAIT_L(8); PG8_BAR; PG8_WAIT_L(0); PG8_MMA(0, 0, At, B0); PG8_BAR; PG8_SCHED;
            PG8_LDB(B1, 1, 1); PG8_STAGE(PG8_SB(1, 0), b3, voffB);
            PG8_BAR; PG8_WAIT_L(0); PG8_MMA(0, 1, At, B1); PG8_BAR;
            PG8_LDA(At, 1, 1); PG8_STAGE(PG8_SA(1, 0), a3, voffA);
            PG8_BAR; PG8_WAIT_L(0); PG8_MMA(1, 0, At, B0); PG8_BAR; PG8_SCHED;
            PG8_STAGE(PG8_SB(1, 1), b3 + hstep, voffB);
            PG8_WAIT_V(6); PG8_BAR; PG8_MMA(1, 1, At, B1); PG8_BAR;
            }
        }
        if constexpr (ALIGN_EPI) { if (wr == 0) PG8_BAR; }
        if constexpr (!Epi::AFTER_DRAIN) { E(acc, cur, wr, wc, fr, fq); S.done(cur); }
        if (!has_next) break;
#pragma unroll
        for (int a = 0; a < 2; ++a)
#pragma unroll
            for (int b = 0; b < 2; ++b)
#pragma unroll
                for (int m = 0; m < 4; ++m)
#pragma unroll
                    for (int n = 0; n < 2; ++n) acc[a][b][m][n] = (f32x4){0.f, 0.f, 0.f, 0.f};
        cur = nxt; cA = nA; cB = nB; ++ui;
        if constexpr (ALIGN_EPI) { if (wr == 1) PG8_BAR; }
    }
    PG8_WAIT_V(0);
    if constexpr (!ALIGN_EPI) { if (wr == 0) PG8_BAR; }
    PG8_BAR;
    if constexpr (Epi::AFTER_DRAIN) { E.fused(acc, cur, wr, wc, fr, fq, lds, wid, lane); S.done(cur); }
#undef PG8_SA
#undef PG8_SB
#undef PG8_STAGE
#undef PG8_LDA
#undef PG8_LDB
#undef PG8_MMA
#undef PG8_WAIT_V
#undef PG8_WAIT_L
#undef PG8_BAR
#undef PG8_SCHED
}
}

#define LAS __attribute__((address_space(3)))
typedef unsigned short bf16;
typedef float f32x4 __attribute__((ext_vector_type(4)));
typedef float f32x2 __attribute__((ext_vector_type(2)));
typedef float f32x16 __attribute__((ext_vector_type(16)));
typedef short bf16x8 __attribute__((ext_vector_type(8)));
typedef short s16x4 __attribute__((ext_vector_type(4)));
typedef unsigned u32x4 __attribute__((ext_vector_type(4)));
typedef unsigned u32x2 __attribute__((ext_vector_type(2)));

constexpr int NB = 4, SEQ = 8192, DM = 1024, NTOK = NB * SEQ, MROWS = NTOK + 256, META_ROW = NTOK;
constexpr int INC = 4608, DFF = 2816, KVW = 256;
constexpr int NGRP = 64, NST = 64, CHUNK = 256, NCHUNK = SEQ / CHUNK;
constexpr float EPS = 1e-6f;
constexpr int NTHREADS = 512, NWAVES = 8;
constexpr int LDS_BYTES = 147456;

constexpr size_t MiB = 1u << 20;
constexpr size_t WS_RSTDX = 0;
constexpr size_t WS_ROWSS = 256 * 1024;
constexpr size_t WS_ROWSA = 384 * 1024;
constexpr size_t WS_ROWSB = 800 * 1024;
constexpr size_t WS_ATAB = 512 * 1024;
constexpr size_t WS_ATAB2 = 512 * 1024 + 32768;
constexpr size_t WS_SMETA = 512 * 1024 + 65536;
constexpr size_t WS_BB = 1 * MiB;
constexpr size_t WS_CM = 1 * MiB + 262144;
constexpr size_t WS_WG = 7 * MiB;
constexpr int NQKVU = 2560;
constexpr size_t WS_W1 = 2 * MiB, WS_W2 = 11 * MiB, WS_W3 = 15 * MiB, WS_W4 = 17 * MiB, WS_W5 = 28 * MiB;
constexpr size_t WS_E = 34 * MiB;
constexpr size_t ROWBUF = (size_t)MROWS * DM * 2;
constexpr size_t WS_XB = 44 * MiB;
constexpr size_t WS_Q = 110 * MiB;
constexpr size_t WS_K = 175 * MiB, WS_V = 192 * MiB;
constexpr size_t WS_U = 209 * MiB;
constexpr size_t WS_GA = 274 * MiB, WS_GS = 339 * MiB;
constexpr size_t WS_ATT = 404 * MiB;
constexpr size_t WS_ACT = 110 * MiB;
constexpr size_t WS_END = 470 * MiB;
static_assert(WS_XB + ROWBUF <= WS_Q && WS_Q + ROWBUF <= WS_K && WS_U + ROWBUF <= WS_GA && WS_GA + ROWBUF <= WS_GS && WS_GS + ROWBUF <= WS_ATT && WS_ATT + ROWBUF <= WS_END, "ws map");
static_assert(WS_K + (size_t)MROWS * KVW * 2 <= WS_V && WS_V + (size_t)MROWS * KVW * 2 <= WS_U, "ws map kv");
static_assert(WS_ACT + (size_t)NTOK * DFF * 2 <= WS_GS, "act overlay");

__device__ __forceinline__ unsigned cvt_pk(float lo, float hi) { unsigned r; asm volatile("v_cvt_pk_bf16_f32 %0, %1, %2" : "=v"(r) : "v"(lo), "v"(hi)); return r; }
__device__ __forceinline__ float bf_lo(unsigned w) { return __uint_as_float(w << 16); }
__device__ __forceinline__ float bf_hi(unsigned w) { return __uint_as_float(w & 0xffff0000u); }
__device__ __forceinline__ unsigned pk_f16(float lo, float hi) { const _Float16 a = (_Float16)lo, b = (_Float16)hi; return (unsigned)__builtin_bit_cast(unsigned short, a) | ((unsigned)__builtin_bit_cast(unsigned short, b) << 16); }
__device__ __forceinline__ float f16_lo(unsigned w) { return (float)__builtin_bit_cast(_Float16, (unsigned short)(w & 0xffffu)); }
__device__ __forceinline__ float f16_hi(unsigned w) { return (float)__builtin_bit_cast(_Float16, (unsigned short)(w >> 16)); }
__device__ __forceinline__ float fast_sigmoid(float v) { return __builtin_amdgcn_rcpf(1.0f + __builtin_amdgcn_exp2f(-1.4426950408889634f * v)); }
__device__ __forceinline__ float wave_sum(float v) {
#pragma unroll
    for (int o = 1; o < 64; o <<= 1) v += __shfl_xor(v, o);
    return v;
}
#define LDS_WAIT() asm volatile("s_waitcnt lgkmcnt(0)" ::: "memory")

struct EpiProj {
    static constexpr bool PERM = true, AFTER_DRAIN = false;
    bf16 *Q, *K, *V, *U; const float* rstd;
    __device__ __forceinline__ void operator()(const pg8::f32x4 (&acc)[2][2][4][2], const pg8::Unit& u, int wr, int wc, int fr, int fq) const {
        const int pn = u.pn; bf16* base; int ld, ct;
        if (pn < 4) { base = Q; ld = DM; ct = pn; } else if (pn == 4) { base = K; ld = KVW; ct = 0; } else if (pn == 5) { base = V; ld = KVW; ct = 0; } else { base = U; ld = DM; ct = pn - 6; }
        const int row0 = u.pm * 256 + wr * 64 + fr, col0 = ct * 256 + wc * 32 + 8 * fq;
        float rsv[8];
#pragma unroll
        for (int q = 0; q < 8; ++q) rsv[q] = rstd[row0 + (q >> 2) * 128 + (q & 3) * 16];
        asm volatile("" : "+v"(rsv[0]), "+v"(rsv[1]), "+v"(rsv[2]), "+v"(rsv[3]), "+v"(rsv[4]), "+v"(rsv[5]), "+v"(rsv[6]), "+v"(rsv[7]));
#pragma unroll
        for (int ai = 0; ai < 2; ++ai)
#pragma unroll
            for (int m = 0; m < 4; ++m) { const int row = row0 + ai * 128 + m * 16; const float rs = rsv[ai * 4 + m]; bf16* rowp = base + (size_t)row * ld + col0;
#pragma unroll
                for (int bj = 0; bj < 2; ++bj) { pg8::f32x4 v0 = acc[ai][bj][m][0] * rs, v1 = acc[ai][bj][m][1] * rs;
                    u32x4 w; w.x = cvt_pk(v0[0], v0[1]); w.y = cvt_pk(v0[2], v0[3]); w.z = cvt_pk(v1[0], v1[1]); w.w = cvt_pk(v1[2], v1[3]);
                    *(u32x4*)(rowp + bj * 128) = w; } }
    }
};
struct EpiMerge {
    static constexpr bool PERM = true, AFTER_DRAIN = false;
    const bf16* ATT; const bf16* SSM; bf16* MG; const float* rstd; const float* rowsa; const float* rowsb; const float* wa; const float* wsn;
    __device__ __forceinline__ void operator()(const pg8::f32x4 (&acc)[2][2][4][2], const pg8::Unit& u, int wr, int wc, int fr, int fq) const {
        const int row0 = u.pm * 256 + wr * 64 + fr, col0 = u.pn * 128 + wc * 32 + 8 * fq;
        const pg8::f32x4 wa0 = *(const pg8::f32x4*)(wa + col0), wa1 = *(const pg8::f32x4*)(wa + col0 + 4), ws0 = *(const pg8::f32x4*)(wsn + col0), ws1 = *(const pg8::f32x4*)(wsn + col0 + 4);
        float rsv[8], rav[8], rbv[8];
#pragma unroll
        for (int q = 0; q < 8; ++q) { const int row = row0 + (q >> 2) * 128 + (q & 3) * 16; rsv[q] = rstd[row]; rav[q] = rowsa[row]; rbv[q] = rowsb[row]; }
#pragma unroll
        for (int p = 0; p < 4; ++p) {
            u32x4 awv[2], swv[2];
#pragma unroll
            for (int m2 = 0; m2 < 2; ++m2) { const int q = p * 2 + m2; const size_t off = (size_t)(row0 + (q >> 2) * 128 + (q & 3) * 16) * DM + col0; awv[m2] = *(const u32x4*)(ATT + off); swv[m2] = *(const u32x4*)(SSM + off); }
            asm volatile("" : "+v"(awv[0]), "+v"(awv[1]), "+v"(swv[0]), "+v"(swv[1]));
#pragma unroll
            for (int m2 = 0; m2 < 2; ++m2) { const int q = p * 2 + m2, ai = q >> 2, m = q & 3; const int row = row0 + ai * 128 + m * 16; const size_t off = (size_t)row * DM + col0;
                const u32x4 aw = awv[m2], sw = swv[m2];
                const float rs = rsv[q], ra = __builtin_amdgcn_rsqf(rav[q] * (1.0f / DM) + EPS), rb = __builtin_amdgcn_rsqf(rbv[q] * (1.0f / DM) + EPS);
                const float av[8] = {bf_lo(aw.x), bf_hi(aw.x), bf_lo(aw.y), bf_hi(aw.y), bf_lo(aw.z), bf_hi(aw.z), bf_lo(aw.w), bf_hi(aw.w)};
                const float sv[8] = {bf_lo(sw.x), bf_hi(sw.x), bf_lo(sw.y), bf_hi(sw.y), bf_lo(sw.z), bf_hi(sw.z), bf_lo(sw.w), bf_hi(sw.w)};
                float o[8];
#pragma unroll
                for (int n = 0; n < 2; ++n)
#pragma unroll
                    for (int e = 0; e < 4; ++e) { const float wl = n ? wa1[e] : wa0[e], vl = n ? ws1[e] : ws0[e];
                        o[n * 4 + e] = fast_sigmoid(acc[ai][0][m][n][e] * rs) * av[n * 4 + e] * (ra * wl) + fast_sigmoid(acc[ai][1][m][n][e] * rs) * sv[n * 4 + e] * (rb * vl); }
                u32x4 w; w.x = cvt_pk(o[0], o[1]); w.y = cvt_pk(o[2], o[3]); w.z = cvt_pk(o[4], o[5]); w.w = cvt_pk(o[6], o[7]);
                *(u32x4*)(MG + off) = w; }
        }
    }
};
struct EpiGlu {
    static constexpr bool PERM = true, AFTER_DRAIN = false;
    bf16* O; int ldc; float* rowsb;
    __device__ __forceinline__ void operator()(const pg8::f32x4 (&acc)[2][2][4][2], const pg8::Unit& u, int wr, int wc, int fr, int fq) const {
        const int row0 = u.pm * 256 + wr * 64 + fr, col0 = u.pn * 128 + wc * 32 + 8 * fq;
#pragma unroll
        for (int ai = 0; ai < 2; ++ai)
#pragma unroll
            for (int m = 0; m < 4; ++m) { const int row = row0 + ai * 128 + m * 16; float o[8]; float ss = 0.f;
#pragma unroll
                for (int n = 0; n < 2; ++n)
#pragma unroll
                    for (int e = 0; e < 4; ++e) { const float v = acc[ai][0][m][n][e] * fast_sigmoid(acc[ai][1][m][n][e]); o[n * 4 + e] = v; ss += v * v; }
                u32x4 w; w.x = cvt_pk(o[0], o[1]); w.y = cvt_pk(o[2], o[3]); w.z = cvt_pk(o[4], o[5]); w.w = cvt_pk(o[6], o[7]);
                *(u32x4*)(O + (size_t)row * ldc + col0) = w;
                ss += __shfl_xor(ss, 16); ss += __shfl_xor(ss, 32);
                if (fq == 0) atomicAdd(rowsb + row, ss); }
    }
};
struct EpiSwiglu {
    static constexpr bool PERM = true, AFTER_DRAIN = false;
    bf16* O; int ldc; const float* rowss;
    __device__ __forceinline__ void operator()(const pg8::f32x4 (&acc)[2][2][4][2], const pg8::Unit& u, int wr, int wc, int fr, int fq) const {
        const int row0 = u.pm * 256 + wr * 64 + fr, col0 = u.pn * 128 + wc * 32 + 8 * fq;
        float rsv[8];
#pragma unroll
        for (int q = 0; q < 8; ++q) rsv[q] = rowss[row0 + (q >> 2) * 128 + (q & 3) * 16];
        asm volatile("" : "+v"(rsv[0]), "+v"(rsv[1]), "+v"(rsv[2]), "+v"(rsv[3]), "+v"(rsv[4]), "+v"(rsv[5]), "+v"(rsv[6]), "+v"(rsv[7]));
#pragma unroll
        for (int ai = 0; ai < 2; ++ai)
#pragma unroll
            for (int m = 0; m < 4; ++m) { const int row = row0 + ai * 128 + m * 16; const float rs = __builtin_amdgcn_rsqf(rsv[ai * 4 + m] * (1.0f / DM) + EPS); float o[8];
#pragma unroll
                for (int n = 0; n < 2; ++n)
#pragma unroll
                    for (int e = 0; e < 4; ++e) { const float g = acc[ai][0][m][n][e] * rs, up = acc[ai][1][m][n][e] * rs; o[n * 4 + e] = g * fast_sigmoid(g) * up; }
                u32x4 w; w.x = cvt_pk(o[0], o[1]); w.y = cvt_pk(o[2], o[3]); w.z = cvt_pk(o[4], o[5]); w.w = cvt_pk(o[6], o[7]);
                *(u32x4*)(O + (size_t)row * ldc + col0) = w; }
    }
};
struct EpiResid1 {
    static constexpr bool PERM = true, AFTER_DRAIN = false;
    const bf16* XBp; bf16* HF; float* rowss;
    __device__ __forceinline__ void operator()(const pg8::f32x4 (&acc)[2][2][4][2], const pg8::Unit& u, int wr, int wc, int fr, int fq) const {
        const int row0 = u.pm * 256 + wr * 64 + fr, col0 = u.pn * 256 + wc * 32 + 8 * fq;
#pragma unroll
        for (int ai = 0; ai < 2; ++ai) {
            u32x4 xwv[4][2];
#pragma unroll
            for (int m = 0; m < 4; ++m)
#pragma unroll
                for (int bj = 0; bj < 2; ++bj) xwv[m][bj] = *(const u32x4*)(XBp + (size_t)(row0 + ai * 128 + m * 16) * DM + col0 + bj * 128);
            asm volatile("" : "+v"(xwv[0][0]), "+v"(xwv[0][1]), "+v"(xwv[1][0]), "+v"(xwv[1][1]), "+v"(xwv[2][0]), "+v"(xwv[2][1]), "+v"(xwv[3][0]), "+v"(xwv[3][1]));
#pragma unroll
            for (int m = 0; m < 4; ++m) { const int row = row0 + ai * 128 + m * 16; float ss = 0.f;
#pragma unroll
                for (int bj = 0; bj < 2; ++bj) { const size_t off = (size_t)row * DM + col0 + bj * 128;
                    const u32x4 xw = xwv[m][bj];
                    const pg8::f32x4 h0 = (pg8::f32x4){bf_lo(xw.x), bf_hi(xw.x), bf_lo(xw.y), bf_hi(xw.y)} + acc[ai][bj][m][0], h1 = (pg8::f32x4){bf_lo(xw.z), bf_hi(xw.z), bf_lo(xw.w), bf_hi(xw.w)} + acc[ai][bj][m][1];
                    ss += (h0[0] * h0[0] + h0[1] * h0[1]) + (h0[2] * h0[2] + h0[3] * h0[3]) + (h1[0] * h1[0] + h1[1] * h1[1]) + (h1[2] * h1[2] + h1[3] * h1[3]);
                    u32x4 l; l.x = pk_f16(h0[0], h0[1]); l.y = pk_f16(h0[2], h0[3]); l.z = pk_f16(h1[0], h1[1]); l.w = pk_f16(h1[2], h1[3]);
                    *(u32x4*)(HF + off) = l; }
                ss += __shfl_xor(ss, 16); ss += __shfl_xor(ss, 32);
                if (fq == 0) atomicAdd(rowss + row, ss); }
        }
    }
};
struct EpiResid2 {
    static constexpr bool PERM = true, AFTER_DRAIN = false;
    const bf16* HF; float* out;
    __device__ __forceinline__ void operator()(const pg8::f32x4 (&acc)[2][2][4][2], const pg8::Unit& u, int wr, int wc, int fr, int fq) const {
        const int row0 = u.pm * 256 + wr * 64 + fr, col0 = u.pn * 256 + wc * 32 + 8 * fq;
#pragma unroll
        for (int ai = 0; ai < 2; ++ai) {
            u32x4 hv[4][2];
#pragma unroll
            for (int m = 0; m < 4; ++m)
#pragma unroll
                for (int bj = 0; bj < 2; ++bj) hv[m][bj] = *(const u32x4*)(HF + (size_t)(row0 + ai * 128 + m * 16) * DM + col0 + bj * 128);
            asm volatile("" : "+v"(hv[0][0]), "+v"(hv[0][1]), "+v"(hv[1][0]), "+v"(hv[1][1]), "+v"(hv[2][0]), "+v"(hv[2][1]), "+v"(hv[3][0]), "+v"(hv[3][1]));
#pragma unroll
            for (int m = 0; m < 4; ++m) { const int row = row0 + ai * 128 + m * 16;
#pragma unroll
                for (int bj = 0; bj < 2; ++bj) { const size_t off = (size_t)row * DM + col0 + bj * 128; const u32x4 h = hv[m][bj];
                    *(pg8::f32x4*)(out + off) = (pg8::f32x4){f16_lo(h.x), f16_hi(h.x), f16_lo(h.y), f16_hi(h.y)} + acc[ai][bj][m][0];
                    *(pg8::f32x4*)(out + off + 4) = (pg8::f32x4){f16_lo(h.z), f16_hi(h.z), f16_lo(h.w), f16_hi(h.w)} + acc[ai][bj][m][1]; } }
        }
    }
};

constexpr int TP = 65, T_SCR_BYTES = 64 * TP * 4;
__device__ __forceinline__ void transpose_item(const float* W, int ldw, const float* gk, int K, int N, bf16* WT, bool glu, LAS float* scr, int item, int lane, bool f16 = false) {
    const int nblk = N / 64, kb = item / nblk, nb = item % nblk, k0 = 64 * kb, n0 = 64 * nb;
    const int kq = lane >> 4, n4 = (lane & 15) * 4;
    f32x4 v[16];
#pragma unroll
    for (int i = 0; i < 16; ++i) v[i] = *(const f32x4*)(W + (size_t)(k0 + 4 * i + kq) * ldw + n0 + n4);
#pragma unroll
    for (int i = 0; i < 16; ++i) { LAS float* d = scr + (4 * i + kq) * TP + n4; d[0] = v[i].x; d[1] = v[i].y; d[2] = v[i].z; d[3] = v[i].w; }
    LDS_WAIT(); asm volatile("" ::: "memory");
    int d0 = n0; if (glu) { const int half = N / 2, bj = n0 / half, j = n0 % half; d0 = 256 * (j / 128) + 128 * bj + (j % 128); }
    const int c = lane & 7;
    float g[8];
#pragma unroll
    for (int e2 = 0; e2 < 8; ++e2) g[e2] = gk ? gk[k0 + 8 * c + e2] : 1.0f;
#pragma unroll
    for (int j = 0; j < 8; ++j) { const int n = (lane >> 3) + 8 * j; const LAS float* s = scr + (8 * c) * TP + n;
        u32x4 o;
        if (f16) { o.x = pk_f16(s[0 * TP] * g[0], s[1 * TP] * g[1]); o.y = pk_f16(s[2 * TP] * g[2], s[3 * TP] * g[3]); o.z = pk_f16(s[4 * TP] * g[4], s[5 * TP] * g[5]); o.w = pk_f16(s[6 * TP] * g[6], s[7 * TP] * g[7]); }
        else { o.x = cvt_pk(s[0 * TP] * g[0], s[1 * TP] * g[1]); o.y = cvt_pk(s[2 * TP] * g[2], s[3 * TP] * g[3]); o.z = cvt_pk(s[4 * TP] * g[4], s[5 * TP] * g[5]); o.w = cvt_pk(s[6 * TP] * g[6], s[7 * TP] * g[7]); }
        *(u32x4*)(WT + (size_t)(d0 + n) * K + k0 + 8 * c) = o; }
    LDS_WAIT(); asm volatile("" ::: "memory");
}

__device__ __forceinline__ void sincos_small(float x, float& s, float& c) {
    const float n = rintf(x * 0.6366197723675814f);
    float r = fmaf(-n, 1.5703125f, x); r = fmaf(-n, 4.837512969970703125e-4f, r); r = fmaf(-n, 7.54978995489188216e-8f, r);
    const float z = r * r;
    const float sp = r + r * z * (-1.6666654611e-1f + z * (8.3321608736e-3f + z * -1.9515295891e-4f));
    const float cp = 1.0f - 0.5f * z + z * z * (4.166664568298827e-2f + z * (-1.388731625493765e-3f + z * 2.443315711809948e-5f));
    const int q = ((int)n) & 3;
    const float ss = (q & 1) ? cp : sp, cc = (q & 1) ? sp : cp;
    s = (q & 2) ? -ss : ss; c = ((q + 1) & 2) ? -cc : cc;
}

struct Args { const float* in[22]; float* out; unsigned char* ws; long long never; };

__device__ __forceinline__ void p0_prologue(const Args& a, LAS unsigned char* lds, int wave, int lane) {
    unsigned char* ws = a.ws;
    LAS float* scr = (LAS float*)(lds + wave * 16896);
    const int gw = blockIdx.x * NWAVES + wave, NGW = gridDim.x * NWAVES;
    constexpr int I1 = (DM / 64) * (NQKVU / 64), IG = (DM / 64) * (2048 / 64), I2 = (DM / 64) * (2048 / 64), I3 = (DM / 64) * (DM / 64), I4 = (DM / 64) * (2 * DFF / 64), I5 = (DFF / 64) * (DM / 64);
    static_assert(T_SCR_BYTES <= 16896 && 8 * 16896 <= LDS_BYTES - 1024, "transpose scratch");
    constexpr int NITEMS = I1 + IG + I2 + I3 + I4 + I5;
    for (int it = gw; it < NITEMS; it += NGW) {
        int r = it;
        if (r < I1) { transpose_item(a.in[3], INC, a.in[2], DM, NQKVU, (bf16*)(ws + WS_W1), false, scr, r, lane); continue; } r -= I1;
        if (r < IG) { transpose_item(a.in[3] + NQKVU, INC, a.in[2], DM, 2048, (bf16*)(ws + WS_WG), true, scr, r, lane); continue; } r -= IG;
        if (r < I2) { transpose_item(a.in[15], 2048, nullptr, DM, 2048, (bf16*)(ws + WS_W2), true, scr, r, lane); continue; } r -= I2;
        if (r < I3) { transpose_item(a.in[18], DM, nullptr, DM, DM, (bf16*)(ws + WS_W3), false, scr, r, lane); continue; } r -= I3;
        if (r < I4) { transpose_item(a.in[20], 2 * DFF, a.in[19], DM, 2 * DFF, (bf16*)(ws + WS_W4), true, scr, r, lane, true); continue; } r -= I4;
        transpose_item(a.in[21], DM, nullptr, DFF, DM, (bf16*)(ws + WS_W5), false, scr, r, lane);
    }
    bf16* XB = (bf16*)(ws + WS_XB); float* rstdx = (float*)(ws + WS_RSTDX);
    for (int m0 = gw; m0 < NTOK + 16; m0 += 2 * NGW) {
        const int m1 = m0 + NGW; const bool has1 = m1 < NTOK + 16; const int m1c = has1 ? m1 : m0;
        const float* src0 = m0 < NTOK ? a.in[0] + (size_t)m0 * DM : a.in[1] + (size_t)(m0 - NTOK) * DM;
        const float* src1 = m1c < NTOK ? a.in[0] + (size_t)m1c * DM : a.in[1] + (size_t)(m1c - NTOK) * DM;
        f32x4 v0[4], v1[4]; float s0 = 0.f, s1 = 0.f;
#pragma unroll
        for (int j = 0; j < 4; ++j) { v0[j] = __builtin_nontemporal_load((const f32x4*)src0 + lane + 64 * j); v1[j] = __builtin_nontemporal_load((const f32x4*)src1 + lane + 64 * j); }
#pragma unroll
        for (int j = 0; j < 4; ++j) { s0 += (v0[j].x * v0[j].x + v0[j].y * v0[j].y) + (v0[j].z * v0[j].z + v0[j].w * v0[j].w); s1 += (v1[j].x * v1[j].x + v1[j].y * v1[j].y) + (v1[j].z * v1[j].z + v1[j].w * v1[j].w); }
        u32x2* o0 = (u32x2*)(XB + (size_t)m0 * DM) + lane; u32x2* o1 = (u32x2*)(XB + (size_t)m1c * DM) + lane;
#pragma unroll
        for (int j = 0; j < 4; ++j) { u32x2 w; w.x = cvt_pk(v0[j].x, v0[j].y); w.y = cvt_pk(v0[j].z, v0[j].w); o0[64 * j] = w; }
        if (has1) {
#pragma unroll
            for (int j = 0; j < 4; ++j) { u32x2 w; w.x = cvt_pk(v1[j].x, v1[j].y); w.y = cvt_pk(v1[j].z, v1[j].w); o1[64 * j] = w; } }
        s0 = wave_sum(s0); s1 = wave_sum(s1);
        if (lane == 0) { rstdx[m0] = __builtin_amdgcn_rsqf(s0 * (1.0f / DM) + EPS); if (has1) rstdx[m1] = __builtin_amdgcn_rsqf(s1 * (1.0f / DM) + EPS); }
    }
    const int gt = blockIdx.x * NTHREADS + threadIdx.x, NGT = gridDim.x * NTHREADS;
    float* rowss = (float*)(ws + WS_ROWSS);
    float* rowsa = (float*)(ws + WS_ROWSA); float* rowsb = (float*)(ws + WS_ROWSB);
    for (int i = gt; i < NTOK; i += NGT) { rowss[i] = 0.f; rowsa[i] = 0.f; rowsb[i] = 0.f; }
    if (gt < NGRP * NST) {
        const int g = gt >> 6, p = gt & 63;
        const float dt = expf(a.in[9][g]), lr = a.in[7][gt], li = a.in[8][gt];
        const float mag = expf(lr * dt); float sn, cs; sincos_small(li * dt, sn, cs);
        const float ar = mag * cs, ai = mag * sn, den = lr * lr + li * li, nr = ar - 1.0f, ni = ai;
        const float fr = (nr * lr + ni * li) / den, fi = (ni * lr - nr * li) / den;
        ((f32x2*)(ws + WS_ATAB))[gt] = (f32x2){ar, ai};
        float pr = ar, pi = ai;
#pragma unroll
        for (int i = 0; i < 8; ++i) { const float tr = pr * pr - pi * pi, ti = 2.0f * pr * pi; pr = tr; pi = ti; }
        ((f32x2*)(ws + WS_ATAB2))[gt] = (f32x2){pr, pi};
        bf16* BB = (bf16*)(ws + WS_BB); bf16* CM = (bf16*)(ws + WS_CM);
        const int rre = g * 128 + (p >> 5) * 64 + (p & 31), rim = rre + 32;
        const float* bre = a.in[10] + (size_t)gt * 16; const float* bim = a.in[11] + (size_t)gt * 16;
#pragma unroll
        for (int c = 0; c < 16; c += 2) {
            const float br0 = bre[c], bi0 = bim[c], br1 = bre[c + 1], bi1 = bim[c + 1];
            *(unsigned*)(BB + (size_t)rre * 16 + c) = cvt_pk(fr * br0 - fi * bi0, fr * br1 - fi * bi1);
            *(unsigned*)(BB + (size_t)rim * 16 + c) = cvt_pk(fr * bi0 + fi * br0, fr * bi1 + fi * br1);
        }
#pragma unroll
        for (int c = 0; c < 16; ++c) {
            const float cr = a.in[12][((size_t)g * 16 + c) * 64 + p], ci = a.in[13][((size_t)g * 16 + c) * 64 + p];
            *(unsigned*)(CM + ((size_t)g * 16 + c) * 128 + 2 * p) = cvt_pk(cr, -ci);
        }
    }
}

constexpr int KP = 144, VP = 840, NKEY = 416;
constexpr int ATT_K_OFF = 0, ATT_V_OFF = NKEY * KP;
static_assert(ATT_V_OFF + 64 * VP <= 131072, "attention LDS");
__device__ __forceinline__ int crow(int r, int hi) { return (r & 3) + 8 * (r >> 2) + 4 * hi; }

__device__ __forceinline__ void attn_item(const Args& a, LAS unsigned char* lds, int item, int wave, int lane) {
    unsigned char* ws = a.ws;
    const bf16* QB = (const bf16*)(ws + WS_Q); const bf16* KB = (const bf16*)(ws + WS_K); const bf16* VB = (const bf16*)(ws + WS_V); bf16* ATT = (bf16*)(ws + WS_ATT);
    const int blk0 = (item & 31) * 2, kvh = (item >> 5) & 3, b = item >> 7;
    const int tid = threadIdx.x;
    const float* knw = a.in[5];
    for (int idx = tid; idx < NKEY * 8; idx += NTHREADS) {
        const int key = idx >> 3, ck = idx & 7; int row = -1;
        if (key < 16) row = META_ROW + key;
        else if (key < 32) row = -1;
        else if (key < 160) row = blk0 > 0 ? b * SEQ + (blk0 - 1) * 128 + (key - 32) : -1;
        else row = b * SEQ + blk0 * 128 + (key - 160);
        u32x4 kw = (u32x4){0u, 0u, 0u, 0u}, vw = (u32x4){0u, 0u, 0u, 0u};
        if (row >= 0) { kw = *(const u32x4*)(KB + (size_t)row * KVW + kvh * 64 + ck * 8); vw = *(const u32x4*)(VB + (size_t)row * KVW + kvh * 64 + ck * 8); }
        float kf[8] = {bf_lo(kw.x), bf_hi(kw.x), bf_lo(kw.y), bf_hi(kw.y), bf_lo(kw.z), bf_hi(kw.z), bf_lo(kw.w), bf_hi(kw.w)};
        float ss = 0.f;
#pragma unroll
        for (int e = 0; e < 8; ++e) ss += kf[e] * kf[e];
        ss += __shfl_xor(ss, 1); ss += __shfl_xor(ss, 2); ss += __shfl_xor(ss, 4);
        const float rs = __builtin_amdgcn_rsqf(ss * (1.0f / 64.0f) + EPS);
        const f32x4 g0 = *(const f32x4*)(knw + ck * 8), g1 = *(const f32x4*)(knw + ck * 8 + 4);
        u32x4 o; o.x = cvt_pk(kf[0] * rs * g0.x, kf[1] * rs * g0.y); o.y = cvt_pk(kf[2] * rs * g0.z, kf[3] * rs * g0.w);
        o.z = cvt_pk(kf[4] * rs * g1.x, kf[5] * rs * g1.y); o.w = cvt_pk(kf[6] * rs * g1.z, kf[7] * rs * g1.w);
        *(LAS u32x4*)(lds + ATT_K_OFF + key * KP + ck * 16) = o;
        LAS unsigned short* vt = (LAS unsigned short*)(lds + ATT_V_OFF + (ck * 8) * VP + key * 2);
        const unsigned vv[4] = {vw.x, vw.y, vw.z, vw.w};
#pragma unroll
        for (int e = 0; e < 4; ++e) { vt[(2 * e) * (VP / 2)] = (unsigned short)(vv[e] & 0xffffu); vt[(2 * e + 1) * (VP / 2)] = (unsigned short)(vv[e] >> 16); }
    }
    __syncthreads();
    const int r = wave >> 1, qh = wave & 1, hq = kvh * 4 + r, ql = lane & 31, hi = lane >> 5;
    const float sink = a.in[6][hq];
    const float* qnw = a.in[4];
    const float L2E = 1.4426950408889634f;
    for (int q4 = 0; q4 < 4; ++q4) {
        const int bl = q4 >> 1, qb = q4 & 1, blk = blk0 + bl;
        const int qblk = 2 * qh + qb;
        const size_t qrow = (size_t)b * SEQ + blk * 128 + qblk * 32 + ql;
        bf16x8 qf[4];
        {
            u32x4 qw[4]; float ss = 0.f;
#pragma unroll
            for (int ks = 0; ks < 4; ++ks) { qw[ks] = *(const u32x4*)(QB + qrow * DM + hq * 64 + 16 * ks + 8 * hi);
                const unsigned ww[4] = {qw[ks].x, qw[ks].y, qw[ks].z, qw[ks].w};
#pragma unroll
                for (int e = 0; e < 4; ++e) { const float lo = bf_lo(ww[e]), h2 = bf_hi(ww[e]); ss += lo * lo + h2 * h2; } }
            ss += __shfl_xor(ss, 32);
            const float rs = __builtin_amdgcn_rsqf(ss * (1.0f / 64.0f) + EPS) * 0.125f;
#pragma unroll
            for (int ks = 0; ks < 4; ++ks) { const f32x4 g0 = *(const f32x4*)(qnw + 16 * ks + 8 * hi), g1 = *(const f32x4*)(qnw + 16 * ks + 8 * hi + 4);
                u32x4 o; o.x = cvt_pk(bf_lo(qw[ks].x) * rs * g0.x, bf_hi(qw[ks].x) * rs * g0.y); o.y = cvt_pk(bf_lo(qw[ks].y) * rs * g0.z, bf_hi(qw[ks].y) * rs * g0.w);
                o.z = cvt_pk(bf_lo(qw[ks].z) * rs * g1.x, bf_hi(qw[ks].z) * rs * g1.y); o.w = cvt_pk(bf_lo(qw[ks].w) * rs * g1.z, bf_hi(qw[ks].w) * rs * g1.w);
                qf[ks] = __builtin_bit_cast(bf16x8, o); }
        }
        f32x16 S[6];
#pragma unroll
        for (int i = 0; i < 6; ++i) {
            const int kb = (i == 0) ? 0 : 4 * bl + qblk + i;
            f32x16 acc;
#pragma unroll
            for (int e = 0; e < 16; ++e) acc[e] = 0.f;
#pragma unroll
            for (int ks = 0; ks < 4; ++ks) { const bf16x8 kf = *(const LAS bf16x8*)(lds + ATT_K_OFF + (kb * 32 + ql) * KP + (16 * ks + 8 * hi) * 2);
                acc = __builtin_amdgcn_mfma_f32_32x32x16_bf16(kf, qf[ks], acc, 0, 0, 0); }
            S[i] = acc;
        }
        const float NEG = -INFINITY;
#pragma unroll
        for (int e = 0; e < 16; ++e) { const int kr = crow(e, hi);
            if (kr >= 16) S[0][e] = NEG;
            if (!(kr > ql)) S[1][e] = NEG;
            if (!(kr <= ql)) S[5][e] = NEG; }
        if (blk == 0) {
#pragma unroll
            for (int i = 1; i < 6; ++i) if (qblk + i <= 4) {
#pragma unroll
                for (int e = 0; e < 16; ++e) S[i][e] = NEG; }
        }
        float mx = sink;
#pragma unroll
        for (int i = 0; i < 6; ++i)
#pragma unroll
            for (int e = 0; e < 16; ++e) mx = fmaxf(mx, S[i][e]);
        mx = fmaxf(mx, __shfl_xor(mx, 32));
        float den = 0.f; const float mb = mx * L2E;
        bf16x8 pf[6][2];
#pragma unroll
        for (int i = 0; i < 6; ++i) {
            float ev[16];
#pragma unroll
            for (int e = 0; e < 16; ++e) { ev[e] = __builtin_amdgcn_exp2f(S[i][e] * L2E - mb); den += ev[e]; }
#pragma unroll
            for (int h = 0; h < 2; ++h) { u32x4 o; o.x = cvt_pk(ev[8 * h + 0], ev[8 * h + 1]); o.y = cvt_pk(ev[8 * h + 2], ev[8 * h + 3]); o.z = cvt_pk(ev[8 * h + 4], ev[8 * h + 5]); o.w = cvt_pk(ev[8 * h + 6], ev[8 * h + 7]);
                pf[i][h] = __builtin_bit_cast(bf16x8, o); }
        }
        den += __shfl_xor(den, 32);
        den += __builtin_amdgcn_exp2f(sink * L2E - mb);
        const float inv = 1.0f / den; float ssq = 0.f;
#pragma unroll
        for (int db = 0; db < 2; ++db) {
            f32x16 O;
#pragma unroll
            for (int e = 0; e < 16; ++e) O[e] = 0.f;
#pragma unroll
            for (int i = 0; i < 6; ++i) { const int kb = (i == 0) ? 0 : 4 * bl + qblk + i;
#pragma unroll
                for (int h = 0; h < 2; ++h) {
                    const LAS unsigned char* vp = lds + ATT_V_OFF + (db * 32 + ql) * VP + (kb * 32 + 16 * h + 4 * hi) * 2;
                    const u32x2 v0 = *(const LAS u32x2*)vp, v1 = *(const LAS u32x2*)(vp + 16);
                    const u32x4 vv = (u32x4){v0.x, v0.y, v1.x, v1.y};
                    O = __builtin_amdgcn_mfma_f32_32x32x16_bf16(__builtin_bit_cast(bf16x8, vv), pf[i][h], O, 0, 0, 0); } }
#pragma unroll
            for (int g = 0; g < 4; ++g) { const float o0 = O[4 * g] * inv, o1 = O[4 * g + 1] * inv, o2 = O[4 * g + 2] * inv, o3 = O[4 * g + 3] * inv; ssq += (o0 * o0 + o1 * o1) + (o2 * o2 + o3 * o3);
                u32x2 w; w.x = cvt_pk(o0, o1); w.y = cvt_pk(o2, o3);
                *(u32x2*)(ATT + qrow * DM + hq * 64 + db * 32 + 8 * g + 4 * hi) = w; }
        }
        ssq += __shfl_xor(ssq, 32);
        if (hi == 0) atomicAdd((float*)(ws + WS_ROWSA) + qrow, ssq);
    }
    __syncthreads();
}

constexpr int SP = 272;
__device__ __forceinline__ float gelu_tanh(float y) { const float t = y + 0.044715f * y * y * y; return y * __builtin_amdgcn_rcpf(1.0f + __builtin_amdgcn_exp2f(-2.302208198f * t)); }
__device__ __forceinline__ f32x2 pk_fma(f32x2 a, f32x2 b, f32x2 c) { return __builtin_elementwise_fma(a, b, c); }

template <bool FINAL>
__device__ __forceinline__ void ssm_item(const Args& a, LAS unsigned char* lds, int item, int wave, int lane) {
    static_assert(NCHUNK == 32 && CHUNK == 256, "item decode");
    unsigned char* ws = a.ws;
    const bf16* U = (const bf16*)(ws + WS_U); bf16* Z = (bf16*)(ws + WS_Q);
    float* E = (float*)(ws + WS_E);
    const bool meta = (!FINAL) && item >= 256;
    const int oct = item & 7, cp = (item >> 3) & 15, bp = (item >> 7) & 1;
    const int g = oct * 8 + wave, j = lane & 31, hi = lane >> 5;
    const int b0 = bp * 2, c0 = 2 * cp;
    bf16x8 bbf[4];
#pragma unroll
    for (int k = 0; k < 4; ++k) bbf[k] = *(const bf16x8*)((const bf16*)(ws + WS_BB) + ((size_t)g * 128 + k * 32 + j) * 16 + 8 * hi);
    const f32x2 a0 = ((const f32x2*)(ws + WS_ATAB))[g * 64 + j], a1 = ((const f32x2*)(ws + WS_ATAB))[g * 64 + 32 + j];
    const f32x2 a0x = (f32x2){a0.x, a0.x}, a0y = (f32x2){a0.y, a0.y}, na0y = (f32x2){-a0.y, -a0.y}, a1x = (f32x2){a1.x, a1.x}, a1y = (f32x2){a1.y, a1.y}, na1y = (f32x2){-a1.y, -a1.y};
    f32x2 s0r = (f32x2){0.f, 0.f}, s0i = s0r, s1r = s0r, s1i = s0r;
    bf16x8 cmf[4]; f32x4 dsk;
    if (FINAL) {
#pragma unroll
        for (int k = 0; k < 4; ++k) cmf[k] = *(const bf16x8*)((const bf16*)(ws + WS_CM) + ((size_t)g * 16 + (lane & 15)) * 128 + 32 * k + 8 * (lane >> 4));
        dsk = *(const f32x4*)(a.in[14] + g * 16 + 4 * (lane >> 4));
        const f32x2 t0 = ((const f32x2*)(ws + WS_ATAB2))[g * 64 + j], t1 = ((const f32x2*)(ws + WS_ATAB2))[g * 64 + 32 + j];
        const f32x2 m0 = ((const f32x2*)(ws + WS_SMETA))[g * 64 + j], m1 = ((const f32x2*)(ws + WS_SMETA))[g * 64 + 32 + j];
        float c0r = m0.x, c0i = m0.y, c1r = m1.x, c1i = m1.y;
        const f32x2* Eb = (const f32x2*)E + ((size_t)((b0 + hi) * 64 + g) * NCHUNK) * 64;
#pragma unroll
        for (int half = 0; half < 2; ++half) {
            if (half * 16 < c0) {
                f32x2 e0[16], e1[16];
#pragma unroll
                for (int c = 0; c < 16; ++c) { const int cc = half * 16 + c < NCHUNK - 1 ? half * 16 + c : NCHUNK - 2; e0[c] = Eb[cc * 64 + j]; e1[c] = Eb[cc * 64 + 32 + j]; }
#pragma unroll
                for (int c = 0; c < 16; ++c) if (half * 16 + c < c0) {
                    const float n0r = fmaf(t0.x, c0r, fmaf(-t0.y, c0i, e0[c].x)), n0i = fmaf(t0.x, c0i, fmaf(t0.y, c0r, e0[c].y));
                    const float n1r = fmaf(t1.x, c1r, fmaf(-t1.y, c1i, e1[c].x)), n1i = fmaf(t1.x, c1i, fmaf(t1.y, c1r, e1[c].y));
                    c0r = n0r; c0i = n0i; c1r = n1r; c1i = n1i; }
            }
        }
        const f32x2 ec0 = Eb[c0 * 64 + j], ec1 = Eb[c0 * 64 + 32 + j];
        s0r = (f32x2){c0r, fmaf(t0.x, c0r, fmaf(-t0.y, c0i, ec0.x))}; s0i = (f32x2){c0i, fmaf(t0.x, c0i, fmaf(t0.y, c0r, ec0.y))};
        s1r = (f32x2){c1r, fmaf(t1.x, c1r, fmaf(-t1.y, c1i, ec1.x))}; s1i = (f32x2){c1i, fmaf(t1.x, c1i, fmaf(t1.y, c1r, ec1.y))};
    }
    const int bsel = (j >> 2) & 1, csel = j & 1, tt = ((j & 3) >> 1) + 2 * (j >> 3);
    const size_t urow0 = meta ? (size_t)META_ROW + tt : (size_t)(b0 + bsel) * SEQ + (size_t)(c0 + csel) * CHUNK + tt;
    const bf16* up = U + urow0 * DM + g * 16 + 8 * hi;
    LAS unsigned char* sl = lds + wave * (32 * SP);
    const int nsteps = meta ? 2 : CHUNK / 8;
    const size_t erow = (size_t)b0 * SEQ + (size_t)(c0 + ((lane & 15) >> 3)) * CHUNK + (lane & 7);
    const bf16* ue = U + erow * DM + g * 16 + 4 * (lane >> 4);
    bf16* ze = Z + erow * DM + g * 16 + 4 * (lane >> 4);
    bf16x8 uf = *(const bf16x8*)up;
    u32x2 uu0 = (u32x2){0u, 0u}, uu1 = (u32x2){0u, 0u};
    if (FINAL) { uu0 = *(const u32x2*)ue; uu1 = *(const u32x2*)(ue + (size_t)SEQ * DM); }
    for (int st = 0; st < nsteps; ++st) {
        bf16x8 ufn = uf; u32x2 un0 = uu0, un1 = uu1;
        if (st + 1 < nsteps) { ufn = *(const bf16x8*)(up + (size_t)(st + 1) * 8 * DM);
            if (FINAL) { un0 = *(const u32x2*)(ue + (size_t)(st + 1) * 8 * DM); un1 = *(const u32x2*)(ue + (size_t)(st + 1) * 8 * DM + (size_t)SEQ * DM); } }
        f32x16 X[4];
#pragma unroll
        for (int k = 0; k < 4; ++k) { f32x16 z;
#pragma unroll
            for (int e = 0; e < 16; ++e) z[e] = 0.f;
            X[k] = __builtin_amdgcn_mfma_f32_32x32x16_bf16(uf, bbf[k], z, 0, 0, 0); }
#pragma unroll
        for (int t = 0; t < 8; ++t) {
            const f32x2 x0r = (f32x2){X[0][2 * t], X[0][2 * t + 1]}, x0i = (f32x2){X[1][2 * t], X[1][2 * t + 1]}, x1r = (f32x2){X[2][2 * t], X[2][2 * t + 1]}, x1i = (f32x2){X[3][2 * t], X[3][2 * t + 1]};
            const f32x2 n0r = pk_fma(a0x, s0r, pk_fma(na0y, s0i, x0r)), n0i = pk_fma(a0x, s0i, pk_fma(a0y, s0r, x0i));
            const f32x2 n1r = pk_fma(a1x, s1r, pk_fma(na1y, s1i, x1r)), n1i = pk_fma(a1x, s1i, pk_fma(a1y, s1r, x1i));
            s0r = n0r; s0i = n0i; s1r = n1r; s1i = n1i;
            if (FINAL) {
                LAS unsigned char* r0 = sl + ((hi * 2 + 0) * 8 + t) * SP; LAS unsigned char* r1 = sl + ((hi * 2 + 1) * 8 + t) * SP;
                *(LAS unsigned*)(r0 + j * 4) = cvt_pk(n0r.x, n0i.x); *(LAS unsigned*)(r0 + (32 + j) * 4) = cvt_pk(n1r.x, n1i.x);
                *(LAS unsigned*)(r1 + j * 4) = cvt_pk(n0r.y, n0i.y); *(LAS unsigned*)(r1 + (32 + j) * 4) = cvt_pk(n1r.y, n1i.y); }
        }
        if (FINAL) {
            LDS_WAIT(); asm volatile("" ::: "memory");
#pragma unroll
            for (int bh = 0; bh < 2; ++bh) {
                f32x4 Y = (f32x4){0.f, 0.f, 0.f, 0.f};
#pragma unroll
                for (int k = 0; k < 4; ++k) { const bf16x8 sf = *(const LAS bf16x8*)(sl + (bh * 16 + (lane & 15)) * SP + (32 * k + 8 * (lane >> 4)) * 2);
                    Y = __builtin_amdgcn_mfma_f32_16x16x32_bf16(cmf[k], sf, Y, 0, 0, 0); }
                const u32x2 uu = bh ? uu1 : uu0;
                const float y0 = Y[0] + dsk.x * bf_lo(uu.x), y1 = Y[1] + dsk.y * bf_hi(uu.x), y2 = Y[2] + dsk.z * bf_lo(uu.y), y3 = Y[3] + dsk.w * bf_hi(uu.y);
                u32x2 w; w.x = cvt_pk(gelu_tanh(y0), gelu_tanh(y1)); w.y = cvt_pk(gelu_tanh(y2), gelu_tanh(y3));
                *(u32x2*)(ze + (size_t)st * 8 * DM + (size_t)bh * SEQ * DM) = w;
            }
            LDS_WAIT(); asm volatile("" ::: "memory");
        }
        uf = ufn; uu0 = un0; uu1 = un1;
    }
    if (!FINAL) {
        if (meta) { if (hi == 0) { ((f32x2*)(ws + WS_SMETA))[g * 64 + j] = (f32x2){s0r.x, s0i.x}; ((f32x2*)(ws + WS_SMETA))[g * 64 + 32 + j] = (f32x2){s1r.x, s1i.x}; } }
        else { f32x2* Eb = (f32x2*)E + ((size_t)((b0 + hi) * 64 + g) * NCHUNK + c0) * 64;
            Eb[j] = (f32x2){s0r.x, s0i.x}; Eb[32 + j] = (f32x2){s1r.x, s1i.x}; Eb[64 + j] = (f32x2){s0r.y, s0i.y}; Eb[64 + 32 + j] = (f32x2){s1r.y, s1i.y}; }
    }
}

#define XB_TMO      128
#define XB_XCNT(j)  (256  + 64 * (j))
#define XB_XSUB(j)  (1280 + 64 * (j))
#define XB_XGEN(j)  (2304 + 64 * (j))
#define XB_TOP      3328
#define XB_TOPGEN   3392
#define XCD_BAR_WORDS 3456
#define XB_SPIN_CAP (1u << 18)

__device__ __forceinline__ unsigned xb_ld(unsigned* p)              { return __hip_atomic_load(p, __ATOMIC_RELAXED, __HIP_MEMORY_SCOPE_AGENT); }
__device__ __forceinline__ unsigned xb_add(unsigned* p, unsigned v) { return __hip_atomic_fetch_add(p, v, __ATOMIC_RELAXED, __HIP_MEMORY_SCOPE_AGENT); }
__device__ __forceinline__ unsigned xb_xcc_id() { return (unsigned)__builtin_amdgcn_s_getreg((3 << 11) | 20) & 0xFu; }
#define XB_SPIN(cond, bar) do { unsigned _sp = 0; while (cond) { __builtin_amdgcn_s_sleep(1); \
    if ((++_sp & 255u) == 0u) { if (xb_ld(&(bar)[XB_TMO])) break; if (_sp > XB_SPIN_CAP) { atomicAdd(&(bar)[XB_TMO], 1u); break; } } } } while (0)

struct XcdBarrier {
    unsigned* bar; unsigned x;
    volatile LAS unsigned* st;
};

__device__ __forceinline__ XcdBarrier xcd_barrier_post(unsigned* bar, volatile LAS unsigned* st) {
    XcdBarrier b; b.bar = bar; b.x = xb_xcc_id(); b.st = st;
    if (threadIdx.x == 0) (void)xb_add(&bar[XB_XCNT(b.x)], 1u);
    return b;
}
__device__ __forceinline__ void xcd_barrier_complete(unsigned* bar, unsigned x, unsigned& nloc, unsigned& nx) {
    const unsigned G = gridDim.x * gridDim.y * gridDim.z;
    unsigned sum, cnt, mine, sp = 0u;
    for (;;) {
        sum = 0u; cnt = 0u; mine = 0u;
#pragma unroll
        for (unsigned j = 0; j < 16; ++j) { const unsigned c = xb_ld(&bar[XB_XCNT(j)]); sum += c; cnt += (c > 0u) ? 1u : 0u; mine = (j == x) ? c : mine; }
        if (sum == G) break;
        __builtin_amdgcn_s_sleep(1);
        if ((++sp & 255u) == 0u) { if (xb_ld(&bar[XB_TMO])) break; if (sp > XB_SPIN_CAP) { atomicAdd(&bar[XB_TMO], 1u); break; } }
    }
    nloc = mine > 0u ? mine : 1u; nx = cnt > 0u ? cnt : 1u;
}

__device__ __forceinline__ void xcd_barrier(const XcdBarrier& b) {
    asm volatile("s_waitcnt vmcnt(0)" ::: "memory");
    __syncthreads();
    if (threadIdx.x == 0) {
        unsigned* bar = b.bar;
        __builtin_amdgcn_s_waitcnt(0);
        unsigned nloc = b.st[0], nx = b.st[1];
        if (nloc == 0u) { xcd_barrier_complete(bar, b.x, nloc, nx); b.st[0] = nloc; b.st[1] = nx; }
        const unsigned old = xb_add(&bar[XB_XSUB(b.x)], 1u);
        const unsigned gen = old / nloc;
        if (old + 1u == (gen + 1u) * nloc) {
            __builtin_amdgcn_fence(__ATOMIC_RELEASE, "agent");
            asm volatile("s_waitcnt vmcnt(0)" ::: "memory");
            const unsigned og = xb_add(&bar[XB_TOP], 1u);
            const unsigned tg = og / nx;
            if (og + 1u == (tg + 1u) * nx) xb_add(&bar[XB_TOPGEN], 1u);
            else XB_SPIN(xb_ld(&bar[XB_TOPGEN]) == tg, bar);
            __builtin_amdgcn_fence(__ATOMIC_ACQUIRE, "agent");
            xb_add(&bar[XB_XGEN(b.x)], 1u);
            asm volatile("s_waitcnt vmcnt(0)" ::: "memory");
        } else {
            XB_SPIN(xb_ld(&bar[XB_XGEN(b.x)]) == gen, bar);
            __builtin_amdgcn_fence(__ATOMIC_ACQUIRE, "agent");
            asm volatile("s_waitcnt vmcnt(0)" ::: "memory");
        }
    }
    __syncthreads();
}

__device__ __forceinline__ void meta_proj(const Args& a, int wave, int lane) {
    unsigned char* ws = a.ws;
    const bf16* XB = (const bf16*)(ws + WS_XB); const bf16* W1t = (const bf16*)(ws + WS_W1); const float* rstdx = (const float*)(ws + WS_RSTDX);
    for (int gw = blockIdx.x * NWAVES + wave; gw < 1536; gw += gridDim.x * NWAVES) {
    const int n = 1024 + gw;
    float wf[16];
    { const u32x4 w0 = *(const u32x4*)(W1t + (size_t)n * DM + lane * 8), w1 = *(const u32x4*)(W1t + (size_t)n * DM + 512 + lane * 8);
      const unsigned ww[8] = {w0.x, w0.y, w0.z, w0.w, w1.x, w1.y, w1.z, w1.w};
#pragma unroll
      for (int e = 0; e < 8; ++e) { wf[2 * e] = bf_lo(ww[e]); wf[2 * e + 1] = bf_hi(ww[e]); } }
    float mine = 0.f;
#pragma unroll
    for (int r = 0; r < 16; ++r) {
        const u32x4 x0 = *(const u32x4*)(XB + (size_t)(META_ROW + r) * DM + lane * 8), x1 = *(const u32x4*)(XB + (size_t)(META_ROW + r) * DM + 512 + lane * 8);
        const unsigned xx[8] = {x0.x, x0.y, x0.z, x0.w, x1.x, x1.y, x1.z, x1.w};
        float s = 0.f;
#pragma unroll
        for (int e = 0; e < 8; ++e) s += bf_lo(xx[e]) * wf[2 * e] + bf_hi(xx[e]) * wf[2 * e + 1];
        s = wave_sum(s);
        if (lane == r) mine = s;
    }
    if (lane < 16) {
        const unsigned short o = (unsigned short)(cvt_pk(mine * rstdx[META_ROW + lane], 0.f) & 0xffffu);
        const size_t row = META_ROW + lane;
        if (n < 1280) ((bf16*)(ws + WS_K))[row * KVW + (n - 1024)] = o;
        else if (n < 1536) ((bf16*)(ws + WS_V))[row * KVW + (n - 1280)] = o;
        else ((bf16*)(ws + WS_U))[row * DM + (n - 1536)] = o;
    }
    }
}

constexpr int MISC_OFF = LDS_BYTES - 256;
constexpr size_t WS_BAR = 768 * 1024;
__global__ void __launch_bounds__(NTHREADS, 2) mk_fwd(Args a) {
    extern __shared__ __attribute__((aligned(16))) unsigned char lds_raw[];
    cg::grid_group grid = cg::this_grid();
    LAS unsigned char* lds = (LAS unsigned char*)lds_raw;
    const int tid = threadIdx.x, lane = tid & 63, wave = __builtin_amdgcn_readfirstlane(tid >> 6);
    unsigned char* ws = a.ws;
    const int G = gridDim.x, c = blockIdx.x;
    volatile LAS unsigned* MISC = (volatile LAS unsigned*)(lds + MISC_OFF);
    if (tid < 32) MISC[tid] = 0u;
    __syncthreads();
    unsigned* barw = (unsigned*)(ws + WS_BAR);
    XcdBarrier bar = xcd_barrier_post(barw, MISC + 8);
    if (a.never) grid.sync();

    p0_prologue(a, lds, wave, lane);
    xcd_barrier(bar);
    meta_proj(a, wave, lane);
    { pg8::Gemm g{(const pg8::bf16_t*)(ws + WS_XB), (const pg8::bf16_t*)(ws + WS_W1), NTOK, NQKVU, DM}; pg8::StaticOrder S; S.init(NTOK, NQKVU, G, c);
      EpiProj E{(bf16*)(ws + WS_Q), (bf16*)(ws + WS_K), (bf16*)(ws + WS_V), (bf16*)(ws + WS_U), (const float*)(ws + WS_RSTDX)};
      pg8::gemm_phase<EpiProj, pg8::StaticOrder, true, true>(lds, g, S, E); }
    xcd_barrier(bar);
    for (int it = c; it < 512; it += G) attn_item(a, lds, it, wave, lane);
    for (int it = c; it < 256 + 8; it += G) ssm_item<false>(a, lds, it, wave, lane);
    xcd_barrier(bar);
    for (int it = c; it < 256; it += G) ssm_item<true>(a, lds, it, wave, lane);
    xcd_barrier(bar);
    { pg8::Gemm g{(const pg8::bf16_t*)(ws + WS_Q), (const pg8::bf16_t*)(ws + WS_W2), NTOK, 2048, DM}; pg8::StaticOrder S; S.init(NTOK, 2048, G, c);
      EpiGlu E{(bf16*)(ws + WS_U), DM, (float*)(ws + WS_ROWSB)};
      pg8::gemm_phase<EpiGlu, pg8::StaticOrder, true, true>(lds, g, S, E); }
    xcd_barrier(bar);
    { pg8::Gemm g{(const pg8::bf16_t*)(ws + WS_XB), (const pg8::bf16_t*)(ws + WS_WG), NTOK, 2048, DM}; pg8::StaticOrder S; S.init(NTOK, 2048, G, c);
      EpiMerge E{(const bf16*)(ws + WS_ATT), (const bf16*)(ws + WS_U), (bf16*)(ws + WS_Q), (const float*)(ws + WS_RSTDX), (const float*)(ws + WS_ROWSA), (const float*)(ws + WS_ROWSB), a.in[16], a.in[17]};
      pg8::gemm_phase<EpiMerge, pg8::StaticOrder, true, true>(lds, g, S, E); }
    xcd_barrier(bar);
    { pg8::Gemm g{(const pg8::bf16_t*)(ws + WS_Q), (const pg8::bf16_t*)(ws + WS_W3), NTOK, DM, DM}; pg8::StaticOrder S; S.init(NTOK, DM, G, c);
      EpiResid1 E{(const bf16*)(ws + WS_XB), (bf16*)(ws + WS_ATT), (float*)(ws + WS_ROWSS)};
      pg8::gemm_phase<EpiResid1, pg8::StaticOrder, true, true>(lds, g, S, E); }
    xcd_barrier(bar);
    { pg8::Gemm g{(const pg8::bf16_t*)(ws + WS_ATT), (const pg8::bf16_t*)(ws + WS_W4), NTOK, 2 * DFF, DM}; pg8::StaticOrder S; S.init(NTOK, 2 * DFF, G, c);
      EpiSwiglu E{(bf16*)(ws + WS_ACT), DFF, (const float*)(ws + WS_ROWSS)};
      pg8::gemm_phase<EpiSwiglu, pg8::StaticOrder, true, true, true>(lds, g, S, E); }
    xcd_barrier(bar);
    { pg8::Gemm g{(const pg8::bf16_t*)(ws + WS_ACT), (const pg8::bf16_t*)(ws + WS_W5), NTOK, DM, DFF}; pg8::StaticOrder S; S.init(NTOK, DM, G, c);
      EpiResid2 E{(const bf16*)(ws + WS_ATT), a.out};
      pg8::gemm_phase<EpiResid2, pg8::StaticOrder, true, true>(lds, g, S, E); }
}

extern "C" void kernel_launch(void* const* d_in, const int* in_sizes, int n_in, void* d_out, int out_size, void* d_ws, size_t ws_size, hipStream_t stream) {
    static int grid = 0;
    if (grid == 0) {
        if (n_in != 22 || in_sizes[0] != NTOK * DM || out_size != NTOK * DM || ws_size < WS_END) { fprintf(stderr, "kernel_launch: unexpected shapes (n_in %d, in0 %d, out %d, ws %zu)\n", n_in, n_in > 0 ? in_sizes[0] : -1, out_size, ws_size); grid = -1; return; }
        int dev = 0, cus = 0, per_cu = 0;
        (void)hipGetDevice(&dev); (void)hipDeviceGetAttribute(&cus, hipDeviceAttributeMultiprocessorCount, dev);
        if (hipFuncSetAttribute((const void*)mk_fwd, hipFuncAttributeMaxDynamicSharedMemorySize, LDS_BYTES) != hipSuccess) { fprintf(stderr, "kernel_launch: hipFuncSetAttribute failed\n"); grid = -1; return; }
        if (hipOccupancyMaxActiveBlocksPerMultiprocessor(&per_cu, (const void*)mk_fwd, NTHREADS, LDS_BYTES) != hipSuccess || per_cu < 1) { fprintf(stderr, "kernel_launch: occupancy query says %d; nothing launched\n", per_cu); grid = -1; return; }
        (void)hipGetLastError();
        grid = cus;
    }
    if (grid < 0) return;
    Args a{};
    for (int i = 0; i < 22; ++i) a.in[i] = (const float*)d_in[i];
    a.out = (float*)d_out; a.ws = (unsigned char*)d_ws;
    if (hipMemsetAsync((unsigned char*)d_ws + WS_BAR, 0, XCD_BAR_WORDS * 4, stream) != hipSuccess) { fprintf(stderr, "kernel_launch: memset of the barrier words failed\n"); return; }
    void* args[] = {&a};
    hipError_t e = hipLaunchCooperativeKernel((const void*)mk_fwd, dim3(grid), dim3(NTHREADS), args, LDS_BYTES, stream);
    if (e != hipSuccess) fprintf(stderr, "cooperative launch failed: %s (grid %d)\n", hipGetErrorString(e), grid);
}
```

```cpp
#include <hip/hip_runtime.h>
#include <hip/hip_cooperative_groups.h>
#include <cstdio>
#include <cstdint>
namespace cg = cooperative_groups;
namespace pg8 {
#define PG8_LAS __attribute__((address_space(3)))
typedef unsigned short bf16_t;
typedef short bf16x8 __attribute__((ext_vector_type(8)));
typedef float f32x4 __attribute__((ext_vector_type(4)));
typedef unsigned u32x4 __attribute__((ext_vector_type(4)));
constexpr int BM = 256, BK = 64, HALF = 128, HTB = HALF * BK * 2  , STAGE_BYTES = 8 * HTB, NXCD = 8, WGM = 8;

__host__ __device__ __forceinline__ int lds_byte(int r, int c) { const int st = (r >> 4) * 2 + (c >> 5), rr = r & 15, cc = c & 31, ob = rr * 64 + cc * 2; return st * 1024 + (ob ^ (((ob >> 9) & 1) << 5)); }
__host__ __device__ __forceinline__ void stage_rc(int b, int& R, int& C) { const int st = b / 1024, sb = b % 1024, swz = sb ^ (((sb >> 9) & 1) << 5); R = (st >> 1) * 16 + swz / 64; C = (st & 1) * 32 + (swz % 64) / 2; }
__host__ __device__ __forceinline__ int perm32(int rho) { const int n = rho >> 4, i = rho & 15; return 8 * (i >> 2) + 4 * n + (i & 3); }

struct Unit { int pm, pn; };
struct Gemm { const bf16_t* A; const bf16_t* Bt; int M, N, K; };

struct StaticOrder {
    int nM, nN, nwg, G, c;
    __host__ __device__ void init(int M, int N, int G_, int c_) { nM = M / BM; nN = N / BM; nwg = nM * nN; G = G_; c = c_; }
    __host__ __device__ bool next(int i, Unit& u) const {
        const long L = (long)i * G + c; if (L >= nwg) return false;
        int wgid = (int)L; { const int q = nwg / NXCD, r = nwg % NXCD, xcd = wgid % NXCD, off = wgid / NXCD; wgid = (xcd < r ? xcd * (q + 1) : r * (q + 1) + (xcd - r) * q) + off; }
        const int nig = WGM * nN, gid = wgid / nig, fm = gid * WGM, gsz = (nM - fm) < WGM ? (nM - fm) : WGM;
        u.pm = fm + ((wgid % nig) % gsz); u.pn = (wgid % nig) / gsz; return true;
    }
    __device__ __forceinline__ void a_ready(const Unit&) const {}
    __device__ __forceinline__ void done(const Unit&) const {}
};

__device__ __forceinline__ unsigned cvt_pk_bf16(float lo, float hi) { unsigned r; asm volatile("v_cvt_pk_bf16_f32 %0, %1, %2" : "=v"(r) : "v"(lo), "v"(hi)); return r; }
typedef float f32x2 __attribute__((ext_vector_type(2)));
__device__ __forceinline__ f32x2 gelu_pk(f32x2 v) {
    const f32x2 av = __builtin_elementwise_abs(v), d = av * 0.2316418882f + 1.0f;
    f32x2 t; t.x = __builtin_amdgcn_rcpf(d.x); t.y = __builtin_amdgcn_rcpf(d.y);
    f32x2 q = t * 0.5307027145f + (-0.7265760135f); q = q * t + 0.7107068705f; q = q * t + (-0.142248368f); q = q * t + 0.127414796f; q = q * t;
    const f32x2 s = (v * v) * (-0.72134752044f);
    f32x2 e; e.x = __builtin_amdgcn_exp2f(s.x); e.y = __builtin_amdgcn_exp2f(s.y);
    const f32x2 m = v * (q * e), r = v - m;
    f32x2 o; o.x = v.x < 0.f ? m.x : r.x; o.y = v.y < 0.f ? m.y : r.y; return o;
}

template <int ACT  > struct EpiBf16 {
    static constexpr bool PERM = true, AFTER_DRAIN = false; static_assert(ACT == 0 || ACT == 1, "EpiBf16: ACT is 0 (none) or 1 (gelu_pk)");
    bf16_t* O; int ldc; const float* bias; int split_cols; size_t split_stride; float scale0;
    __device__ __forceinline__ void operator()(const f32x4 (&acc)[2][2][4][2], const Unit& u, int wr, int wc, int fr, int fq) const {
        const int row0 = u.pm * BM + wr * 64 + fr; int colt = u.pn * BM; bf16_t* base = O;
        float sc = 1.f; if (split_cols) { const int t = colt / split_cols; base += (size_t)t * split_stride; colt -= t * split_cols; if (t == 0) sc = scale0; }
        const int col0 = colt + wc * 32 + 8 * fq, bcol0 = u.pn * BM + wc * 32 + 8 * fq;
        f32x4 bv[2][2];
#pragma unroll
        for (int bj = 0; bj < 2; ++bj)
#pragma unroll
            for (int n = 0; n < 2; ++n) bv[bj][n] = bias ? *(const f32x4*)(bias + bcol0 + bj * HALF + 4 * n) : (f32x4){0.f, 0.f, 0.f, 0.f};
#pragma unroll
        for (int ai = 0; ai < 2; ++ai)
#pragma unroll
            for (int m = 0; m < 4; ++m) { bf16_t* rowp = base + (size_t)(row0 + ai * HALF + m * 16) * ldc + col0;
#pragma unroll
                for (int bj = 0; bj < 2; ++bj) { f32x4 v0 = acc[ai][bj][m][0] + bv[bj][0], v1 = acc[ai][bj][m][1] + bv[bj][1];
                    if (ACT == 1) { f32x2 a = gelu_pk((f32x2){v0[0], v0[1]}), b = gelu_pk((f32x2){v0[2], v0[3]}), c = gelu_pk((f32x2){v1[0], v1[1]}), d = gelu_pk((f32x2){v1[2], v1[3]});
                        v0 = (f32x4){a.x, a.y, b.x, b.y}; v1 = (f32x4){c.x, c.y, d.x, d.y}; }
                    v0 = v0 * sc; v1 = v1 * sc; u32x4 w; w.x = cvt_pk_bf16(v0[0], v0[1]); w.y = cvt_pk_bf16(v0[2], v0[3]); w.z = cvt_pk_bf16(v1[0], v1[1]); w.w = cvt_pk_bf16(v1[2], v1[3]);
                    *(u32x4*)(rowp + bj * HALF) = w; } }
    }
};
template <bool F16> __device__ __forceinline__ f32x4 mma16(bf16x8 b, bf16x8 a, f32x4 c) {
    if constexpr (F16) { typedef _Float16 h16x8 __attribute__((ext_vector_type(8))); return __builtin_amdgcn_mfma_f32_16x16x32_f16(__builtin_bit_cast(h16x8, b), __builtin_bit_cast(h16x8, a), c, 0, 0, 0); }
    else return __builtin_amdgcn_mfma_f32_16x16x32_bf16(b, a, c, 0, 0, 0);
}
template <class Epi, class Sched, bool ALIGN_EPI = false, bool SP2 = false, bool F16 = false>
__device__ __forceinline__ void gemm_phase(PG8_LAS unsigned char* lds, const Gemm g, const Sched& S, const Epi& E) {
    const int tid = threadIdx.x, wid = __builtin_amdgcn_readfirstlane(tid >> 6), lane = tid & 63, wr = wid >> 2, wc = wid & 3, fr = lane & 15, fq = lane >> 4;
    const int K = g.K, nt = K / BK;
    unsigned voffA[2], voffB[2];
#pragma unroll
    for (int i = 0; i < 2; ++i) { int R, C; stage_rc(tid * 16 + i * 8192, R, C); const int Rb = Epi::PERM ? ((R & ~31) + perm32(R & 31)) : R;
        voffA[i] = (unsigned)(R * K + C) * 2u; voffB[i] = (unsigned)(Rb * K + C) * 2u; }
    const size_t kstep = (size_t)(BK * 2);
    const size_t hstep = (size_t)HALF * K * 2;
    const size_t tstep = 2 * hstep;
    const unsigned ldsw = (unsigned)wid * 1024u;
    const int aoff = lds_byte(wr * 64 + fr, fq * 8), boff = lds_byte(wc * 32 + fr, fq * 8);
#define PG8_SA(b, h) (((b) * 2 + (h)) * HTB)
#define PG8_SB(b, h) ((4 + (b) * 2 + (h)) * HTB)
#define PG8_STAGE(bufoff, gbase, voff) do { _Pragma("unroll") for (int _i = 0; _i < 2; ++_i) \
        __builtin_amdgcn_global_load_lds((const unsigned*)((const char*)(gbase) + (voff)[_i]), (PG8_LAS unsigned*)(lds + (bufoff) + ldsw + _i * 8192), 16, 0, 0); } while (0)
#define PG8_LDA(dst, b, h) do { _Pragma("unroll") for (int m = 0; m < 4; ++m) _Pragma("unroll") for (int k = 0; k < 2; ++k) dst[m][k] = *(const PG8_LAS bf16x8*)(lds + PG8_SA(b, h) + aoff + m * 2048 + k * 1024); } while (0)
#define PG8_LDB(dst, b, h) do { _Pragma("unroll") for (int n = 0; n < 2; ++n) _Pragma("unroll") for (int k = 0; k < 2; ++k) dst[n][k] = *(const PG8_LAS bf16x8*)(lds + PG8_SB(b, h) + boff + n * 2048 + k * 1024); } while (0)
#define PG8_MMA(ai, bj, At, Bt) do { __builtin_amdgcn_s_setprio(1); _Pragma("unroll") for (int m = 0; m < 4; ++m) _Pragma("unroll") for (int n = 0; n < 2; ++n) _Pragma("unroll") for (int k = 0; k < 2; ++k) \
        acc[ai][bj][m][n] = mma16<F16>(Bt[n][k], At[m][k], acc[ai][bj][m][n]); __builtin_amdgcn_s_setprio(0); } while (0)
#define PG8_WAIT_V(n) asm volatile("s_waitcnt vmcnt(" #n ")" ::: "memory")
#define PG8_WAIT_L(n) asm volatile("s_waitcnt lgkmcnt(" #n ")" ::: "memory")
#define PG8_BAR __builtin_amdgcn_s_barrier()
#define PG8_SCHED __builtin_amdgcn_sched_barrier(0)
    Unit cur, nxt; int ui = 0;
    if (!S.next(0, cur)) return;
    f32x4 acc[2][2][4][2];
#pragma unroll
    for (int a = 0; a < 2; ++a)
#pragma unroll
        for (int b = 0; b < 2; ++b)
#pragma unroll
            for (int m = 0; m < 4; ++m)
#pragma unroll
                for (int n = 0; n < 2; ++n) acc[a][b][m][n] = (f32x4){0.f, 0.f, 0.f, 0.f};
    bf16x8 At[4][2], B0[2][2], B1[2][2];
    const char* cA = (const char*)g.A + (size_t)cur.pm * tstep; const char* cB = (const char*)g.Bt + (size_t)cur.pn * tstep;
    S.a_ready(cur);
    if constexpr (SP2) {
        PG8_STAGE(PG8_SB(0, 0), cB, voffB); PG8_STAGE(PG8_SB(0, 1), cB + hstep, voffB); PG8_STAGE(PG8_SA(0, 0), cA, voffA); PG8_STAGE(PG8_SA(0, 1), cA + hstep, voffA);
        if (wr == 1) PG8_BAR;
        PG8_WAIT_V(2); PG8_BAR;
        PG8_STAGE(PG8_SB(1, 0), cB + kstep, voffB); PG8_STAGE(PG8_SA(1, 0), cA + kstep, voffA); PG8_STAGE(PG8_SB(1, 1), cB + hstep + kstep, voffB);
        PG8_WAIT_V(6); PG8_BAR;
    } else {
        PG8_STAGE(PG8_SB(0, 0), cB, voffB); PG8_STAGE(PG8_SA(0, 0), cA, voffA); PG8_STAGE(PG8_SB(0, 1), cB + hstep, voffB); PG8_STAGE(PG8_SA(0, 1), cA + hstep, voffA);
        if (wr == 1) PG8_BAR;
        PG8_WAIT_V(4); PG8_BAR;
        PG8_STAGE(PG8_SB(1, 0), cB + kstep, voffB); PG8_STAGE(PG8_SA(1, 0), cA + kstep, voffA); PG8_STAGE(PG8_SB(1, 1), cB + hstep + kstep, voffB);
        PG8_WAIT_V(6); PG8_BAR;
    }
    for (;;) {
        const bool has_next = S.next(ui + 1, nxt);
        const char* nA = has_next ? (const char*)g.A + (size_t)nxt.pm * tstep : cA; const char* nB = has_next ? (const char*)g.Bt + (size_t)nxt.pn * tstep : cB;
        for (int t = 0; t < nt; t += 2) {
            const bool last = (t == nt - 2);
            const char* a1 = cA + (size_t)(t + 1) * kstep;
            const char* a2 = last ? nA : cA + (size_t)(t + 2) * kstep; const char* b2 = last ? nB : cB + (size_t)(t + 2) * kstep;
            const char* a3 = a2 + kstep; const char* b3 = b2 + kstep;
            if (last && has_next) S.a_ready(nxt);
            if constexpr (SP2) {
            PG8_LDB(B0, 0, 0); PG8_LDB(B1, 0, 1); PG8_SCHED; PG8_LDA(At, 0, 0); PG8_STAGE(PG8_SA(1, 1), a1 + hstep, voffA);
            PG8_WAIT_V(8); PG8_WAIT_L(0); PG8_BAR; PG8_MMA(0, 0, At, B0); PG8_MMA(0, 1, At, B1); PG8_BAR; PG8_SCHED;
            PG8_LDA(At, 0, 1); PG8_STAGE(PG8_SB(0, 0), b2, voffB); PG8_STAGE(PG8_SB(0, 1), b2 + hstep, voffB); PG8_STAGE(PG8_SA(0, 0), a2, voffA);
            PG8_WAIT_V(8); PG8_WAIT_L(0); PG8_BAR; PG8_MMA(1, 0, At, B0); PG8_MMA(1, 1, At, B1); PG8_BAR; PG8_SCHED;
            PG8_LDB(B0, 1, 0); PG8_LDB(B1, 1, 1); PG8_SCHED; PG8_LDA(At, 1, 0); PG8_STAGE(PG8_SA(0, 1), a2 + hstep, voffA);
            PG8_WAIT_V(8); PG8_WAIT_L(0); PG8_BAR; PG8_MMA(0, 0, At, B0); PG8_MMA(0, 1, At, B1); PG8_BAR; PG8_SCHED;
            PG8_LDA(At, 1, 1); PG8_STAGE(PG8_SB(1, 0), b3, voffB); PG8_STAGE(PG8_SB(1, 1), b3 + hstep, voffB); PG8_STAGE(PG8_SA(1, 0), a3, voffA);
            PG8_WAIT_V(8); PG8_WAIT_L(0); PG8_BAR; PG8_MMA(1, 0, At, B0); PG8_MMA(1, 1, At, B1); PG8_BAR; PG8_SCHED;
            } else {
            PG8_LDB(B0, 0, 0); PG8_SCHED; PG8_LDA(At, 0, 0); PG8_STAGE(PG8_SA(1, 1), a1 + hstep, voffA);
            PG8_WAIT_L(8); PG8_BAR; PG8_WAIT_L(0); PG8_MMA(0, 0, At, B0); PG8_BAR; PG8_SCHED;
            PG8_LDB(B1, 0, 1); PG8_STAGE(PG8_SB(0, 0), b2, voffB);
            PG8_BAR; PG8_WAIT_L(0); PG8_MMA(0, 1, At, B1); PG8_BAR;
            PG8_LDA(At, 0, 1); PG8_STAGE(PG8_SA(0, 0), a2, voffA);
            PG8_BAR; PG8_WAIT_L(0); PG8_MMA(1, 0, At, B0); PG8_BAR; PG8_SCHED;
            PG8_STAGE(PG8_SB(0, 1), b2 + hstep, voffB);
            PG8_WAIT_V(6); PG8_BAR; PG8_MMA(1, 1, At, B1); PG8_BAR;
            PG8_LDB(B0, 1, 0); PG8_SCHED; PG8_LDA(At, 1, 0); PG8_STAGE(PG8_SA(0, 1), a2 + hstep, voffA);
            PG8_WAIT_L(8); PG8_BAR; PG8_WAIT_L(0); PG8_MMA(0, 0, At, B0); PG8_BAR; PG8_SCHED;
            PG8_LDB(B1, 1, 1); PG8_STAGE(PG8_SB(1, 0), b3, voffB);
            PG8_BAR; PG8_WAIT_L(0); PG8_MMA(0, 1, At, B1); PG8_BAR;
            PG8_LDA(At, 1, 1); PG8_STAGE(PG8_SA(1, 0), a3, voffA);
            PG8_BAR; PG8_WAIT_L(0); PG8_MMA(1, 0, At, B0); PG8_BAR; PG8_SCHED;
            PG8_STAGE(PG8_SB(1, 1), b3 + hstep, voffB);
            PG8_WAIT_V(6); PG8_BAR; PG8_MMA(1, 1, At, B1); PG8_BAR;
            }
        }
        if constexpr (ALIGN_EPI) { if (wr == 0) PG8_BAR; }
        if constexpr (!Epi::AFTER_DRAIN) { E(acc, cur, wr, wc, fr, fq); S.done(cur); }
        if (!has_next) break;
#pragma unroll
        for (int a = 0; a < 2; ++a)
#pragma unroll
            for (int b = 0; b < 2; ++b)
#pragma unroll
                for (int m = 0; m < 4; ++m)
#pragma unroll
                    for (int n = 0; n < 2; ++n) acc[a][b][m][n] = (f32x4){0.f, 0.f, 0.f, 0.f};
        cur = nxt; cA = nA; cB = nB; ++ui;
        if constexpr (ALIGN_EPI) { if (wr == 1) PG8_BAR; }
    }
    PG8_WAIT_V(0);
    if constexpr (!ALIGN_EPI) { if (wr == 0) PG8_BAR; }
    PG8_BAR;
    if constexpr (Epi::AFTER_DRAIN) { E.fused(acc, cur, wr, wc, fr, fq, lds, wid, lane); S.done(cur); }
#undef PG8_SA
#undef PG8_SB
#undef PG8_STAGE
#undef PG8_LDA
#undef PG8_LDB
#undef PG8_MMA
#undef PG8_WAIT_V
#undef PG8_WAIT_L
#undef PG8_BAR
#undef PG8_SCHED
}
}

#define LAS __attribute__((address_space(3)))
typedef unsigned short bf16;
typedef float f32x4 __attribute__((ext_vector_type(4)));
typedef float f32x2 __attribute__((ext_vector_type(2)));
typedef float f32x16 __attribute__((ext_vector_type(16)));
typedef short bf16x8 __attribute__((ext_vector_type(8)));
typedef short s16x4 __attribute__((ext_vector_type(4)));
typedef unsigned u32x4 __attribute__((ext_vector_type(4)));
typedef unsigned u32x2 __attribute__((ext_vector_type(2)));

constexpr int NB = 4, SEQ = 8192, DM = 1024, NTOK = NB * SEQ, MROWS = NTOK + 256, META_ROW = NTOK;
constexpr int INC = 4608, DFF = 2816, KVW = 256;
constexpr int NGRP = 64, NST = 64, CHUNK = 256, NCHUNK = SEQ / CHUNK;
constexpr float EPS = 1e-6f;
constexpr int NTHREADS = 512, NWAVES = 8;
constexpr int LDS_BYTES = 147456;

constexpr size_t MiB = 1u << 20;
constexpr size_t WS_RSTDX = 0;
constexpr size_t WS_ROWSS = 256 * 1024;
constexpr size_t WS_ROWSA = 384 * 1024;
constexpr size_t WS_ROWSB = 800 * 1024;
constexpr size_t WS_ATAB = 512 * 1024;
constexpr size_t WS_ATAB2 = 512 * 1024 + 32768;
constexpr size_t WS_SMETA = 512 * 1024 + 65536;
constexpr size_t WS_BB = 1 * MiB;
constexpr size_t WS_CM = 1 * MiB + 262144;
constexpr size_t WS_WG = 7 * MiB;
constexpr int NQKVU = 2560;
constexpr size_t WS_W1 = 2 * MiB, WS_W2 = 11 * MiB, WS_W3 = 15 * MiB, WS_W4 = 17 * MiB, WS_W5 = 28 * MiB;
constexpr size_t WS_E = 34 * MiB;
constexpr size_t ROWBUF = (size_t)MROWS * DM * 2;
constexpr size_t WS_XB = 44 * MiB;
constexpr size_t WS_Q = 110 * MiB;
constexpr size_t WS_K = 175 * MiB, WS_V = 192 * MiB;
constexpr size_t WS_U = 209 * MiB;
constexpr size_t WS_GA = 274 * MiB, WS_GS = 339 * MiB;
constexpr size_t WS_ATT = 404 * MiB;
constexpr size_t WS_ACT = 110 * MiB;
constexpr size_t WS_END = 470 * MiB;
static_assert(WS_XB + ROWBUF <= WS_Q && WS_Q + ROWBUF <= WS_K && WS_U + ROWBUF <= WS_GA && WS_GA + ROWBUF <= WS_GS && WS_GS + ROWBUF <= WS_ATT && WS_ATT + ROWBUF <= WS_END, "ws map");
static_assert(WS_K + (size_t)MROWS * KVW * 2 <= WS_V && WS_V + (size_t)MROWS * KVW * 2 <= WS_U, "ws map kv");
static_assert(WS_ACT + (size_t)NTOK * DFF * 2 <= WS_GS, "act overlay");

__device__ __forceinline__ unsigned cvt_pk(float lo, float hi) { unsigned r; asm volatile("v_cvt_pk_bf16_f32 %0, %1, %2" : "=v"(r) : "v"(lo), "v"(hi)); return r; }
__device__ __forceinline__ float bf_lo(unsigned w) { return __uint_as_float(w << 16); }
__device__ __forceinline__ float bf_hi(unsigned w) { return __uint_as_float(w & 0xffff0000u); }
__device__ __forceinline__ unsigned pk_f16(float lo, float hi) { const _Float16 a = (_Float16)lo, b = (_Float16)hi; return (unsigned)__builtin_bit_cast(unsigned short, a) | ((unsigned)__builtin_bit_cast(unsigned short, b) << 16); }
__device__ __forceinline__ float f16_lo(unsigned w) { return (float)__builtin_bit_cast(_Float16, (unsigned short)(w & 0xffffu)); }
__device__ __forceinline__ float f16_hi(unsigned w) { return (float)__builtin_bit_cast(_Float16, (unsigned short)(w >> 16)); }
__device__ __forceinline__ float fast_sigmoid(float v) { return __builtin_amdgcn_rcpf(1.0f + __builtin_amdgcn_exp2f(-1.4426950408889634f * v)); }
__device__ __forceinline__ float wave_sum(float v) {
#pragma unroll
    for (int o = 1; o < 64; o <<= 1) v += __shfl_xor(v, o);
    return v;
}
#define LDS_WAIT() asm volatile("s_waitcnt lgkmcnt(0)" ::: "memory")

struct EpiProj {
    static constexpr bool PERM = true, AFTER_DRAIN = false;
    bf16 *Q, *K, *V, *U; const float* rstd;
    __device__ __forceinline__ void operator()(const pg8::f32x4 (&acc)[2][2][4][2], const pg8::Unit& u, int wr, int wc, int fr, int fq) const {
        const int pn = u.pn; bf16* base; int ld, ct;
        if (pn < 4) { base = Q; ld = DM; ct = pn; } else if (pn == 4) { base = K; ld = KVW; ct = 0; } else if (pn == 5) { base = V; ld = KVW; ct = 0; } else { base = U; ld = DM; ct = pn - 6; }
        const int row0 = u.pm * 256 + wr * 64 + fr, col0 = ct * 256 + wc * 32 + 8 * fq;
        float rsv[8];
#pragma unroll
        for (int q = 0; q < 8; ++q) rsv[q] = rstd[row0 + (q >> 2) * 128 + (q & 3) * 16];
        asm volatile("" : "+v"(rsv[0]), "+v"(rsv[1]), "+v"(rsv[2]), "+v"(rsv[3]), "+v"(rsv[4]), "+v"(rsv[5]), "+v"(rsv[6]), "+v"(rsv[7]));
#pragma unroll
        for (int ai = 0; ai < 2; ++ai)
#pragma unroll
            for (int m = 0; m < 4; ++m) { const int row = row0 + ai * 128 + m * 16; const float rs = rsv[ai * 4 + m]; bf16* rowp = base + (size_t)row * ld + col0;
#pragma unroll
                for (int bj = 0; bj < 2; ++bj) { pg8::f32x4 v0 = acc[ai][bj][m][0] * rs, v1 = acc[ai][bj][m][1] * rs;
                    u32x4 w; w.x = cvt_pk(v0[0], v0[1]); w.y = cvt_pk(v0[2], v0[3]); w.z = cvt_pk(v1[0], v1[1]); w.w = cvt_pk(v1[2], v1[3]);
                    *(u32x4*)(rowp + bj * 128) = w; } }
    }
};
struct EpiMerge {
    static constexpr bool PERM = true, AFTER_DRAIN = false;
    const bf16* ATT; const bf16* SSM; bf16* MG; const float* rstd; const float* rowsa; const float* rowsb; const float* wa; const float* wsn;
    __device__ __forceinline__ void operator()(const pg8::f32x4 (&acc)[2][2][4][2], const pg8::Unit& u, int wr, int wc, int fr, int fq) const {
        const int row0 = u.pm * 256 + wr * 64 + fr, col0 = u.pn * 128 + wc * 32 + 8 * fq;
        const pg8::f32x4 wa0 = *(const pg8::f32x4*)(wa + col0), wa1 = *(const pg8::f32x4*)(wa + col0 + 4), ws0 = *(const pg8::f32x4*)(wsn + col0), ws1 = *(const pg8::f32x4*)(wsn + col0 + 4);
        float rsv[8], rav[8], rbv[8];
#pragma unroll
        for (int q = 0; q < 8; ++q) { const int row = row0 + (q >> 2) * 128 + (q & 3) * 16; rsv[q] = rstd[row]; rav[q] = rowsa[row]; rbv[q] = rowsb[row]; }
#pragma unroll
        for (int p = 0; p < 4; ++p) {
            u32x4 awv[2], swv[2];
#pragma unroll
            for (int m2 = 0; m2 < 2; ++m2) { const int q = p * 2 + m2; const size_t off = (size_t)(row0 + (q >> 2) * 128 + (q & 3) * 16) * DM + col0; awv[m2] = *(const u32x4*)(ATT + off); swv[m2] = *(const u32x4*)(SSM + off); }
            asm volatile("" : "+v"(awv[0]), "+v"(awv[1]), "+v"(swv[0]), "+v"(swv[1]));
#pragma unroll
            for (int m2 = 0; m2 < 2; ++m2) { const int q = p * 2 + m2, ai = q >> 2, m = q & 3; const int row = row0 + ai * 128 + m * 16; const size_t off = (size_t)row * DM + col0;
                const u32x4 aw = awv[m2], sw = swv[m2];
                const float rs = rsv[q], ra = __builtin_amdgcn_rsqf(rav[q] * (1.0f / DM) + EPS), rb = __builtin_amdgcn_rsqf(rbv[q] * (1.0f / DM) + EPS);
                const float av[8] = {bf_lo(aw.x), bf_hi(aw.x), bf_lo(aw.y), bf_hi(aw.y), bf_lo(aw.z), bf_hi(aw.z), bf_lo(aw.w), bf_hi(aw.w)};
                const float sv[8] = {bf_lo(sw.x), bf_hi(sw.x), bf_lo(sw.y), bf_hi(sw.y), bf_lo(sw.z), bf_hi(sw.z), bf_lo(sw.w), bf_hi(sw.w)};
                float o[8];
#pragma unroll
                for (int n = 0; n < 2; ++n)
#pragma unroll
                    for (int e = 0; e < 4; ++e) { const float wl = n ? wa1[e] : wa0[e], vl = n ? ws1[e] : ws0[e];
                        o[n * 4 + e] = fast_sigmoid(acc[ai][0][m][n][e] * rs) * av[n * 4 + e] * (ra * wl) + fast_sigmoid(acc[ai][1][m][n][e] * rs) * sv[n * 4 + e] * (rb * vl); }
                u32x4 w; w.x = cvt_pk(o[0], o[1]); w.y = cvt_pk(o[2], o[3]); w.z = cvt_pk(o[4], o[5]); w.w = cvt_pk(o[6], o[7]);
                *(u32x4*)(MG + off) = w; }
        }
    }
};
struct EpiGlu {
    static constexpr bool PERM = true, AFTER_DRAIN = false;
    bf16* O; int ldc; float* rowsb;
    __device__ __forceinline__ void operator()(const pg8::f32x4 (&acc)[2][2][4][2], const pg8::Unit& u, int wr, int wc, int fr, int fq) const {
        const int row0 = u.pm * 256 + wr * 64 + fr, col0 = u.pn * 128 + wc * 32 + 8 * fq;
#pragma unroll
        for (int ai = 0; ai < 2; ++ai)
#pragma unroll
            for (int m = 0; m < 4; ++m) { const int row = row0 + ai * 128 + m * 16; float o[8]; float ss = 0.f;
#pragma unroll
                for (int n = 0; n < 2; ++n)
#pragma unroll
                    for (int e = 0; e < 4; ++e) { const float v = acc[ai][0][m][n][e] * fast_sigmoid(acc[ai][1][m][n][e]); o[n * 4 + e] = v; ss += v * v; }
                u32x4 w; w.x = cvt_pk(o[0], o[1]); w.y = cvt_pk(o[2], o[3]); w.z = cvt_pk(o[4], o[5]); w.w = cvt_pk(o[6], o[7]);
                *(u32x4*)(O + (size_t)row * ldc + col0) = w;
                ss += __shfl_xor(ss, 16); ss += __shfl_xor(ss, 32);
                if (fq == 0) atomicAdd(rowsb + row, ss); }
    }
};
struct EpiSwiglu {
    static constexpr bool PERM = true, AFTER_DRAIN = false;
    bf16* O; int ldc; const float* rowss;
    __device__ __forceinline__ void operator()(const pg8::f32x4 (&acc)[2][2][4][2], const pg8::Unit& u, int wr, int wc, int fr, int fq) const {
        const int row0 = u.pm * 256 + wr * 64 + fr, col0 = u.pn * 128 + wc * 32 + 8 * fq;
        float rsv[8];
#pragma unroll
        for (int q = 0; q < 8; ++q) rsv[q] = rowss[row0 + (q >> 2) * 128 + (q & 3) * 16];
        asm volatile("" : "+v"(rsv[0]), "+v"(rsv[1]), "+v"(rsv[2]), "+v"(rsv[3]), "+v"(rsv[4]), "+v"(rsv[5]), "+v"(rsv[6]), "+v"(rsv[7]));
#pragma unroll
        for (int ai = 0; ai < 2; ++ai)
#pragma unroll
            for (int m = 0; m < 4; ++m) { const int row = row0 + ai * 128 + m * 16; const float rs = __builtin_amdgcn_rsqf(rsv[ai * 4 + m] * (1.0f / DM) + EPS); float o[8];
#pragma unroll
                for (int n = 0; n < 2; ++n)
#pragma unroll
                    for (int e = 0; e < 4; ++e) { const float g = acc[ai][0][m][n][e] * rs, up = acc[ai][1][m][n][e] * rs; o[n * 4 + e] = g * fast_sigmoid(g) * up; }
                u32x4 w; w.x = cvt_pk(o[0], o[1]); w.y = cvt_pk(o[2], o[3]); w.z = cvt_pk(o[4], o[5]); w.w = cvt_pk(o[6], o[7]);
                *(u32x4*)(O + (size_t)row * ldc + col0) = w; }
    }
};
struct EpiResid1 {
    static constexpr bool PERM = true, AFTER_DRAIN = false;
    const bf16* XBp; bf16* HF; float* rowss;
    __device__ __forceinline__ void operator()(const pg8::f32x4 (&acc)[2][2][4][2], const pg8::Unit& u, int wr, int wc, int fr, int fq) const {
        const int row0 = u.pm * 256 + wr * 64 + fr, col0 = u.pn * 256 + wc * 32 + 8 * fq;
#pragma unroll
        for (int ai = 0; ai < 2; ++ai) {
            u32x4 xwv[4][2];
#pragma unroll
            for (int m = 0; m < 4; ++m)
#pragma unroll
                for (int bj = 0; bj < 2; ++bj) xwv[m][bj] = *(const u32x4*)(XBp + (size_t)(row0 + ai * 128 + m * 16) * DM + col0 + bj * 128);
            asm volatile("" : "+v"(xwv[0][0]), "+v"(xwv[0][1]), "+v"(xwv[1][0]), "+v"(xwv[1][1]), "+v"(xwv[2][0]), "+v"(xwv[2][1]), "+v"(xwv[3][0]), "+v"(xwv[3][1]));
#pragma unroll
            for (int m = 0; m < 4; ++m) { const int row = row0 + ai * 128 + m * 16; float ss = 0.f;
#pragma unroll
                for (int bj = 0; bj < 2; ++bj) { const size_t off = (size_t)row * DM + col0 + bj * 128;
                    const u32x4 xw = xwv[m][bj];
                    const pg8::f32x4 h0 = (pg8::f32x4){bf_lo(xw.x), bf_hi(xw.x), bf_lo(xw.y), bf_hi(xw.y)} + acc[ai][bj][m][0], h1 = (pg8::f32x4){bf_lo(xw.z), bf_hi(xw.z), bf_lo(xw.w), bf_hi(xw.w)} + acc[ai][bj][m][1];
                    ss += (h0[0] * h0[0] + h0[1] * h0[1]) + (h0[2] * h0[2] + h0[3] * h0[3]) + (h1[0] * h1[0] + h1[1] * h1[1]) + (h1[2] * h1[2] + h1[3] * h1[3]);
                    u32x4 l; l.x = pk_f16(h0[0], h0[1]); l.y = pk_f16(h0[2], h0[3]); l.z = pk_f16(h1[0], h1[1]); l.w = pk_f16(h1[2], h1[3]);
                    *(u32x4*)(HF + off) = l; }
                ss += __shfl_xor(ss, 16); ss += __shfl_xor(ss, 32);
                if (fq == 0) atomicAdd(rowss + row, ss); }
        }
    }
};
struct EpiResid2 {
    static constexpr bool PERM = true, AFTER_DRAIN = false;
    const bf16* HF; float* out;
    __device__ __forceinline__ void operator()(const pg8::f32x4 (&acc)[2][2][4][2], const pg8::Unit& u, int wr, int wc, int fr, int fq) const {
        const int row0 = u.pm * 256 + wr * 64 + fr, col0 = u.pn * 256 + wc * 32 + 8 * fq;
#pragma unroll
        for (int ai = 0; ai < 2; ++ai) {
            u32x4 hv[4][2];
#pragma unroll
            for (int m = 0; m < 4; ++m)
#pragma unroll
                for (int bj = 0; bj < 2; ++bj) hv[m][bj] = *(const u32x4*)(HF + (size_t)(row0 + ai * 128 + m * 16) * DM + col0 + bj * 128);
            asm volatile("" : "+v"(hv[0][0]), "+v"(hv[0][1]), "+v"(hv[1][0]), "+v"(hv[1][1]), "+v"(hv[2][0]), "+v"(hv[2][1]), "+v"(hv[3][0]), "+v"(hv[3][1]));
#pragma unroll
            for (int m = 0; m < 4; ++m) { const int row = row0 + ai * 128 + m * 16;
#pragma unroll
                for (int bj = 0; bj < 2; ++bj) { const size_t off = (size_t)row * DM + col0 + bj * 128; const u32x4 h = hv[m][bj];
                    *(pg8::f32x4*)(out + off) = (pg8::f32x4){f16_lo(h.x), f16_hi(h.x), f16_lo(h.y), f16_hi(h.y)} + acc[ai][bj][m][0];
                    *(pg8::f32x4*)(out + off + 4) = (pg8::f32x4){f16_lo(h.z), f16_hi(h.z), f16_lo(h.w), f16_hi(h.w)} + acc[ai][bj][m][1]; } }
        }
    }
};

constexpr int TP = 65, T_SCR_BYTES = 64 * TP * 4;
__device__ __forceinline__ void transpose_item(const float* W, int ldw, const float* gk, int K, int N, bf16* WT, bool glu, LAS float* scr, int item, int lane, bool f16 = false) {
    const int nblk = N / 64, kb = item / nblk, nb = item % nblk, k0 = 64 * kb, n0 = 64 * nb;
    const int kq = lane >> 4, n4 = (lane & 15) * 4;
    f32x4 v[16];
#pragma unroll
    for (int i = 0; i < 16; ++i) v[i] = __builtin_nontemporal_load((const f32x4*)(W + (size_t)(k0 + 4 * i + kq) * ldw + n0 + n4));
#pragma unroll
    for (int i = 0; i < 16; ++i) { LAS float* d = scr + (4 * i + kq) * TP + n4; d[0] = v[i].x; d[1] = v[i].y; d[2] = v[i].z; d[3] = v[i].w; }
    LDS_WAIT(); asm volatile("" ::: "memory");
    int d0 = n0; if (glu) { const int half = N / 2, bj = n0 / half, j = n0 % half; d0 = 256 * (j / 128) + 128 * bj + (j % 128); }
    const int c = lane & 7;
    float g[8];
#pragma unroll
    for (int e2 = 0; e2 < 8; ++e2) g[e2] = gk ? gk[k0 + 8 * c + e2] : 1.0f;
#pragma unroll
    for (int j = 0; j < 8; ++j) { const int n = (lane >> 3) + 8 * j; const LAS float* s = scr + (8 * c) * TP + n;
        u32x4 o;
        if (f16) { o.x = pk_f16(s[0 * TP] * g[0], s[1 * TP] * g[1]); o.y = pk_f16(s[2 * TP] * g[2], s[3 * TP] * g[3]); o.z = pk_f16(s[4 * TP] * g[4], s[5 * TP] * g[5]); o.w = pk_f16(s[6 * TP] * g[6], s[7 * TP] * g[7]); }
        else { o.x = cvt_pk(s[0 * TP] * g[0], s[1 * TP] * g[1]); o.y = cvt_pk(s[2 * TP] * g[2], s[3 * TP] * g[3]); o.z = cvt_pk(s[4 * TP] * g[4], s[5 * TP] * g[5]); o.w = cvt_pk(s[6 * TP] * g[6], s[7 * TP] * g[7]); }
        *(u32x4*)(WT + (size_t)(d0 + n) * K + k0 + 8 * c) = o; }
    LDS_WAIT(); asm volatile("" ::: "memory");
}

__device__ __forceinline__ void sincos_small(float x, float& s, float& c) {
    const float n = rintf(x * 0.6366197723675814f);
    float r = fmaf(-n, 1.5703125f, x); r = fmaf(-n, 4.837512969970703125e-4f, r); r = fmaf(-n, 7.54978995489188216e-8f, r);
    const float z = r * r;
    const float sp = r + r * z * (-1.6666654611e-1f + z * (8.3321608736e-3f + z * -1.9515295891e-4f));
    const float cp = 1.0f - 0.5f * z + z * z * (4.166664568298827e-2f + z * (-1.388731625493765e-3f + z * 2.443315711809948e-5f));
    const int q = ((int)n) & 3;
    const float ss = (q & 1) ? cp : sp, cc = (q & 1) ? sp : cp;
    s = (q & 2) ? -ss : ss; c = ((q + 1) & 2) ? -cc : cc;
}

struct Args { const float* in[22]; float* out; unsigned char* ws; long long never; };

__device__ __forceinline__ void p0_prologue(const Args& a, LAS unsigned char* lds, int wave, int lane) {
    unsigned char* ws = a.ws;
    LAS float* scr = (LAS float*)(lds + wave * 16896);
    const int gw = blockIdx.x * NWAVES + wave, NGW = gridDim.x * NWAVES;
    constexpr int I1 = (DM / 64) * (NQKVU / 64), IG = (DM / 64) * (2048 / 64), I2 = (DM / 64) * (2048 / 64), I3 = (DM / 64) * (DM / 64), I4 = (DM / 64) * (2 * DFF / 64), I5 = (DFF / 64) * (DM / 64);
    static_assert(T_SCR_BYTES <= 16896 && 8 * 16896 <= LDS_BYTES - 1024, "transpose scratch");
    constexpr int NITEMS = I1 + IG + I2 + I3 + I4 + I5;
    for (int it = gw; it < NITEMS; it += NGW) {
        int r = it;
        if (r < I1) { transpose_item(a.in[3], INC, a.in[2], DM, NQKVU, (bf16*)(ws + WS_W1), false, scr, r, lane); continue; } r -= I1;
        if (r < IG) { transpose_item(a.in[3] + NQKVU, INC, a.in[2], DM, 2048, (bf16*)(ws + WS_WG), true, scr, r, lane); continue; } r -= IG;
        if (r < I2) { transpose_item(a.in[15], 2048, nullptr, DM, 2048, (bf16*)(ws + WS_W2), true, scr, r, lane); continue; } r -= I2;
        if (r < I3) { transpose_item(a.in[18], DM, nullptr, DM, DM, (bf16*)(ws + WS_W3), false, scr, r, lane); continue; } r -= I3;
        if (r < I4) { transpose_item(a.in[20], 2 * DFF, a.in[19], DM, 2 * DFF, (bf16*)(ws + WS_W4), true, scr, r, lane, true); continue; } r -= I4;
        transpose_item(a.in[21], DM, nullptr, DFF, DM, (bf16*)(ws + WS_W5), false, scr, r, lane);
    }
    bf16* XB = (bf16*)(ws + WS_XB); float* rstdx = (float*)(ws + WS_RSTDX);
    for (int m0 = gw; m0 < NTOK + 16; m0 += 2 * NGW) {
        const int m1 = m0 + NGW; const bool has1 = m1 < NTOK + 16; const int m1c = has1 ? m1 : m0;
        const float* src0 = m0 < NTOK ? a.in[0] + (size_t)m0 * DM : a.in[1] + (size_t)(m0 - NTOK) * DM;
        const float* src1 = m1c < NTOK ? a.in[0] + (size_t)m1c * DM : a.in[1] + (size_t)(m1c - NTOK) * DM;
        f32x4 v0[4], v1[4]; float s0 = 0.f, s1 = 0.f;
#pragma unroll
        for (int j = 0; j < 4; ++j) { v0[j] = __builtin_nontemporal_load((const f32x4*)src0 + lane + 64 * j); v1[j] = __builtin_nontemporal_load((const f32x4*)src1 + lane + 64 * j); }
#pragma unroll
        for (int j = 0; j < 4; ++j) { s0 += (v0[j].x * v0[j].x + v0[j].y * v0[j].y) + (v0[j].z * v0[j].z + v0[j].w * v0[j].w); s1 += (v1[j].x * v1[j].x + v1[j].y * v1[j].y) + (v1[j].z * v1[j].z + v1[j].w * v1[j].w); }
        u32x2* o0 = (u32x2*)(XB + (size_t)m0 * DM) + lane; u32x2* o1 = (u32x2*)(XB + (size_t)m1c * DM) + lane;
#pragma unroll
        for (int j = 0; j < 4; ++j) { u32x2 w; w.x = cvt_pk(v0[j].x, v0[j].y); w.y = cvt_pk(v0[j].z, v0[j].w); o0[64 * j] = w; }
        if (has1) {
#pragma unroll
            for (int j = 0; j < 4; ++j) { u32x2 w; w.x = cvt_pk(v1[j].x, v1[j].y); w.y = cvt_pk(v1[j].z, v1[j].w); o1[64 * j] = w; } }
        s0 = wave_sum(s0); s1 = wave_sum(s1);
        if (lane == 0) { rstdx[m0] = __builtin_amdgcn_rsqf(s0 * (1.0f / DM) + EPS); if (has1) rstdx[m1] = __builtin_amdgcn_rsqf(s1 * (1.0f / DM) + EPS); }
    }
    const int gt = blockIdx.x * NTHREADS + threadIdx.x, NGT = gridDim.x * NTHREADS;
    float* rowss = (float*)(ws + WS_ROWSS);
    float* rowsa = (float*)(ws + WS_ROWSA); float* rowsb = (float*)(ws + WS_ROWSB);
    for (int i = gt; i < NTOK; i += NGT) { rowss[i] = 0.f; rowsa[i] = 0.f; rowsb[i] = 0.f; }
    if (gt < NGRP * NST) {
        const int g = gt >> 6, p = gt & 63;
        const float dt = expf(a.in[9][g]), lr = a.in[7][gt], li = a.in[8][gt];
        const float mag = expf(lr * dt); float sn, cs; sincos_small(li * dt, sn, cs);
        const float ar = mag * cs, ai = mag * sn, den = lr * lr + li * li, nr = ar - 1.0f, ni = ai;
        const float fr = (nr * lr + ni * li) / den, fi = (ni * lr - nr * li) / den;
        ((f32x2*)(ws + WS_ATAB))[gt] = (f32x2){ar, ai};
        float pr = ar, pi = ai;
#pragma unroll
        for (int i = 0; i < 8; ++i) { const float tr = pr * pr - pi * pi, ti = 2.0f * pr * pi; pr = tr; pi = ti; }
        ((f32x2*)(ws + WS_ATAB2))[gt] = (f32x2){pr, pi};
        bf16* BB = (bf16*)(ws + WS_BB); bf16* CM = (bf16*)(ws + WS_CM);
        const int rre = g * 128 + (p >> 5) * 64 + (p & 31), rim = rre + 32;
        const float* bre = a.in[10] + (size_t)gt * 16; const float* bim = a.in[11] + (size_t)gt * 16;
#pragma unroll
        for (int c = 0; c < 16; c += 2) {
            const float br0 = bre[c], bi0 = bim[c], br1 = bre[c + 1], bi1 = bim[c + 1];
            *(unsigned*)(BB + (size_t)rre * 16 + c) = cvt_pk(fr * br0 - fi * bi0, fr * br1 - fi * bi1);
            *(unsigned*)(BB + (size_t)rim * 16 + c) = cvt_pk(fr * bi0 + fi * br0, fr * bi1 + fi * br1);
        }
#pragma unroll
        for (int c = 0; c < 16; ++c) {
            const float cr = a.in[12][((size_t)g * 16 + c) * 64 + p], ci = a.in[13][((size_t)g * 16 + c) * 64 + p];
            *(unsigned*)(CM + ((size_t)g * 16 + c) * 128 + 2 * p) = cvt_pk(cr, -ci);
        }
    }
}

constexpr int KP = 144, VP = 840, NKEY = 416;
constexpr int ATT_K_OFF = 0, ATT_V_OFF = NKEY * KP;
static_assert(ATT_V_OFF + 64 * VP <= 131072, "attention LDS");
__device__ __forceinline__ int crow(int r, int hi) { return (r & 3) + 8 * (r >> 2) + 4 * hi; }

__device__ __forceinline__ void attn_item(const Args& a, LAS unsigned char* lds, int item, int wave, int lane) {
    unsigned char* ws = a.ws;
    const bf16* QB = (const bf16*)(ws + WS_Q); const bf16* KB = (const bf16*)(ws + WS_K); const bf16* VB = (const bf16*)(ws + WS_V); bf16* ATT = (bf16*)(ws + WS_ATT);
    const int blk0 = (item & 31) * 2, kvh = (item >> 5) & 3, b = item >> 7;
    const int tid = threadIdx.x;
    const float* knw = a.in[5];
    for (int idx = tid; idx < NKEY * 8; idx += NTHREADS) {
        const int key = idx >> 3, ck = idx & 7; int row = -1;
        if (key < 16) row = META_ROW + key;
        else if (key < 32) row = -1;
        else if (key < 160) row = blk0 > 0 ? b * SEQ + (blk0 - 1) * 128 + (key - 32) : -1;
        else row = b * SEQ + blk0 * 128 + (key - 160);
        u32x4 kw = (u32x4){0u, 0u, 0u, 0u}, vw = (u32x4){0u, 0u, 0u, 0u};
        if (row >= 0) { kw = *(const u32x4*)(KB + (size_t)row * KVW + kvh * 64 + ck * 8); vw = *(const u32x4*)(VB + (size_t)row * KVW + kvh * 64 + ck * 8); }
        float kf[8] = {bf_lo(kw.x), bf_hi(kw.x), bf_lo(kw.y), bf_hi(kw.y), bf_lo(kw.z), bf_hi(kw.z), bf_lo(kw.w), bf_hi(kw.w)};
        float ss = 0.f;
#pragma unroll
        for (int e = 0; e < 8; ++e) ss += kf[e] * kf[e];
        ss += __shfl_xor(ss, 1); ss += __shfl_xor(ss, 2); ss += __shfl_xor(ss, 4);
        const float rs = __builtin_amdgcn_rsqf(ss * (1.0f / 64.0f) + EPS);
        const f32x4 g0 = *(const f32x4*)(knw + ck * 8), g1 = *(const f32x4*)(knw + ck * 8 + 4);
        u32x4 o; o.x = cvt_pk(kf[0] * rs * g0.x, kf[1] * rs * g0.y); o.y = cvt_pk(kf[2] * rs * g0.z, kf[3] * rs * g0.w);
        o.z = cvt_pk(kf[4] * rs * g1.x, kf[5] * rs * g1.y); o.w = cvt_pk(kf[6] * rs * g1.z, kf[7] * rs * g1.w);
        *(LAS u32x4*)(lds + ATT_K_OFF + key * KP + ck * 16) = o;
        LAS unsigned short* vt = (LAS unsigned short*)(lds + ATT_V_OFF + (ck * 8) * VP + key * 2);
        const unsigned vv[4] = {vw.x, vw.y, vw.z, vw.w};
#pragma unroll
        for (int e = 0; e < 4; ++e) { vt[(2 * e) * (VP / 2)] = (unsigned short)(vv[e] & 0xffffu); vt[(2 * e + 1) * (VP / 2)] = (unsigned short)(vv[e] >> 16); }
    }
    __syncthreads();
    const int r = wave >> 1, qh = wave & 1, hq = kvh * 4 + r, ql = lane & 31, hi = lane >> 5;
    const float sink = a.in[6][hq];
    const float* qnw = a.in[4];
    const float L2E = 1.4426950408889634f;
    for (int q4 = 0; q4 < 4; ++q4) {
        const int bl = q4 >> 1, qb = q4 & 1, blk = blk0 + bl;
        const int qblk = 2 * qh + qb;
        const size_t qrow = (size_t)b * SEQ + blk * 128 + qblk * 32 + ql;
        bf16x8 qf[4];
        {
            u32x4 qw[4]; float ss = 0.f;
#pragma unroll
            for (int ks = 0; ks < 4; ++ks) { qw[ks] = *(const u32x4*)(QB + qrow * DM + hq * 64 + 16 * ks + 8 * hi);
                const unsigned ww[4] = {qw[ks].x, qw[ks].y, qw[ks].z, qw[ks].w};
#pragma unroll
                for (int e = 0; e < 4; ++e) { const float lo = bf_lo(ww[e]), h2 = bf_hi(ww[e]); ss += lo * lo + h2 * h2; } }
            ss += __shfl_xor(ss, 32);
            const float rs = __builtin_amdgcn_rsqf(ss * (1.0f / 64.0f) + EPS) * 0.125f;
#pragma unroll
            for (int ks = 0; ks < 4; ++ks) { const f32x4 g0 = *(const f32x4*)(qnw + 16 * ks + 8 * hi), g1 = *(const f32x4*)(qnw + 16 * ks + 8 * hi + 4);
                u32x4 o; o.x = cvt_pk(bf_lo(qw[ks].x) * rs * g0.x, bf_hi(qw[ks].x) * rs * g0.y); o.y = cvt_pk(bf_lo(qw[ks].y) * rs * g0.z, bf_hi(qw[ks].y) * rs * g0.w);
                o.z = cvt_pk(bf_lo(qw[ks].z) * rs * g1.x, bf_hi(qw[ks].z) * rs * g1.y); o.w = cvt_pk(bf_lo(qw[ks].w) * rs * g1.z, bf_hi(qw[ks].w) * rs * g1.w);
                qf[ks] = __builtin_bit_cast(bf16x8, o); }
        }
        f32x16 S[6];
#pragma unroll
        for (int i = 0; i < 6; ++i) {
            const int kb = (i == 0) ? 0 : 4 * bl + qblk + i;
            f32x16 acc;
#pragma unroll
            for (int e = 0; e < 16; ++e) acc[e] = 0.f;
#pragma unroll
            for (int ks = 0; ks < 4; ++ks) { const bf16x8 kf = *(const LAS bf16x8*)(lds + ATT_K_OFF + (kb * 32 + ql) * KP + (16 * ks + 8 * hi) * 2);
                acc = __builtin_amdgcn_mfma_f32_32x32x16_bf16(kf, qf[ks], acc, 0, 0, 0); }
            S[i] = acc;
        }
        const float NEG = -INFINITY;
#pragma unroll
        for (int e = 0; e < 16; ++e) { const int kr = crow(e, hi);
            if (kr >= 16) S[0][e] = NEG;
            if (!(kr > ql)) S[1][e] = NEG;
            if (!(kr <= ql)) S[5][e] = NEG; }
        if (blk == 0) {
#pragma unroll
            for (int i = 1; i < 6; ++i) if (qblk + i <= 4) {
#pragma unroll
                for (int e = 0; e < 16; ++e) S[i][e] = NEG; }
        }
        float mx = sink;
#pragma unroll
        for (int i = 0; i < 6; ++i)
#pragma unroll
            for (int e = 0; e < 16; ++e) mx = fmaxf(mx, S[i][e]);
        mx = fmaxf(mx, __shfl_xor(mx, 32));
        float den = 0.f; const float mb = mx * L2E;
        bf16x8 pf[6][2];
#pragma unroll
        for (int i = 0; i < 6; ++i) {
            float ev[16];
#pragma unroll
            for (int e = 0; e < 16; ++e) { ev[e] = __builtin_amdgcn_exp2f(S[i][e] * L2E - mb); den += ev[e]; }
#pragma unroll
            for (int h = 0; h < 2; ++h) { u32x4 o; o.x = cvt_pk(ev[8 * h + 0], ev[8 * h + 1]); o.y = cvt_pk(ev[8 * h + 2], ev[8 * h + 3]); o.z = cvt_pk(ev[8 * h + 4], ev[8 * h + 5]); o.w = cvt_pk(ev[8 * h + 6], ev[8 * h + 7]);
                pf[i][h] = __builtin_bit_cast(bf16x8, o); }
        }
        den += __shfl_xor(den, 32);
        den += __builtin_amdgcn_exp2f(sink * L2E - mb);
        const float inv = 1.0f / den; float ssq = 0.f;
#pragma unroll
        for (int db = 0; db < 2; ++db) {
            f32x16 O;
#pragma unroll
            for (int e = 0; e < 16; ++e) O[e] = 0.f;
#pragma unroll
            for (int i = 0; i < 6; ++i) { const int kb = (i == 0) ? 0 : 4 * bl + qblk + i;
#pragma unroll
                for (int h = 0; h < 2; ++h) {
                    const LAS unsigned char* vp = lds + ATT_V_OFF + (db * 32 + ql) * VP + (kb * 32 + 16 * h + 4 * hi) * 2;
                    const u32x2 v0 = *(const LAS u32x2*)vp, v1 = *(const LAS u32x2*)(vp + 16);
                    const u32x4 vv = (u32x4){v0.x, v0.y, v1.x, v1.y};
                    O = __builtin_amdgcn_mfma_f32_32x32x16_bf16(__builtin_bit_cast(bf16x8, vv), pf[i][h], O, 0, 0, 0); } }
#pragma unroll
            for (int g = 0; g < 4; ++g) { const float o0 = O[4 * g] * inv, o1 = O[4 * g + 1] * inv, o2 = O[4 * g + 2] * inv, o3 = O[4 * g + 3] * inv; ssq += (o0 * o0 + o1 * o1) + (o2 * o2 + o3 * o3);
                u32x2 w; w.x = cvt_pk(o0, o1); w.y = cvt_pk(o2, o3);
                *(u32x2*)(ATT + qrow * DM + hq * 64 + db * 32 + 8 * g + 4 * hi) = w; }
        }
        ssq += __shfl_xor(ssq, 32);
        if (hi == 0) atomicAdd((float*)(ws + WS_ROWSA) + qrow, ssq);
    }
    __syncthreads();
}

constexpr int SP = 272;
__device__ __forceinline__ float gelu_tanh(float y) { const float t = y + 0.044715f * y * y * y; return y * __builtin_amdgcn_rcpf(1.0f + __builtin_amdgcn_exp2f(-2.302208198f * t)); }
__device__ __forceinline__ f32x2 pk_fma(f32x2 a, f32x2 b, f32x2 c) { return __builtin_elementwise_fma(a, b, c); }

template <bool FINAL>
__device__ __forceinline__ void ssm_item(const Args& a, LAS unsigned char* lds, int item, int wave, int lane) {
    static_assert(NCHUNK == 32 && CHUNK == 256, "item decode");
    unsigned char* ws = a.ws;
    const bf16* U = (const bf16*)(ws + WS_U); bf16* Z = (bf16*)(ws + WS_Q);
    float* E = (float*)(ws + WS_E);
    const bool meta = (!FINAL) && item >= 256;
    const int oct = item & 7, cp = (item >> 3) & 15, bp = (item >> 7) & 1;
    const int g = oct * 8 + wave, j = lane & 31, hi = lane >> 5;
    const int b0 = bp * 2, c0 = 2 * cp;
    bf16x8 bbf[4];
#pragma unroll
    for (int k = 0; k < 4; ++k) bbf[k] = *(const bf16x8*)((const bf16*)(ws + WS_BB) + ((size_t)g * 128 + k * 32 + j) * 16 + 8 * hi);
    const f32x2 a0 = ((const f32x2*)(ws + WS_ATAB))[g * 64 + j], a1 = ((const f32x2*)(ws + WS_ATAB))[g * 64 + 32 + j];
    const f32x2 a0x = (f32x2){a0.x, a0.x}, a0y = (f32x2){a0.y, a0.y}, na0y = (f32x2){-a0.y, -a0.y}, a1x = (f32x2){a1.x, a1.x}, a1y = (f32x2){a1.y, a1.y}, na1y = (f32x2){-a1.y, -a1.y};
    f32x2 s0r = (f32x2){0.f, 0.f}, s0i = s0r, s1r = s0r, s1i = s0r;
    bf16x8 cmf[4]; f32x4 dsk;
    if (FINAL) {
#pragma unroll
        for (int k = 0; k < 4; ++k) cmf[k] = *(const bf16x8*)((const bf16*)(ws + WS_CM) + ((size_t)g * 16 + (lane & 15)) * 128 + 32 * k + 8 * (lane >> 4));
        dsk = *(const f32x4*)(a.in[14] + g * 16 + 4 * (lane >> 4));
        const f32x2 t0 = ((const f32x2*)(ws + WS_ATAB2))[g * 64 + j], t1 = ((const f32x2*)(ws + WS_ATAB2))[g * 64 + 32 + j];
        const f32x2 m0 = ((const f32x2*)(ws + WS_SMETA))[g * 64 + j], m1 = ((const f32x2*)(ws + WS_SMETA))[g * 64 + 32 + j];
        float c0r = m0.x, c0i = m0.y, c1r = m1.x, c1i = m1.y;
        const f32x2* Eb = (const f32x2*)E + ((size_t)((b0 + hi) * 64 + g) * NCHUNK) * 64;
#pragma unroll
        for (int half = 0; half < 2; ++half) {
            if (half * 16 < c0) {
                f32x2 e0[16], e1[16];
#pragma unroll
                for (int c = 0; c < 16; ++c) { const int cc = half * 16 + c < NCHUNK - 1 ? half * 16 + c : NCHUNK - 2; e0[c] = Eb[cc * 64 + j]; e1[c] = Eb[cc * 64 + 32 + j]; }
#pragma unroll
                for (int c = 0; c < 16; ++c) if (half * 16 + c < c0) {
                    const float n0r = fmaf(t0.x, c0r, fmaf(-t0.y, c0i, e0[c].x)), n0i = fmaf(t0.x, c0i, fmaf(t0.y, c0r, e0[c].y));
                    const float n1r = fmaf(t1.x, c1r, fmaf(-t1.y, c1i, e1[c].x)), n1i = fmaf(t1.x, c1i, fmaf(t1.y, c1r, e1[c].y));
                    c0r = n0r; c0i = n0i; c1r = n1r; c1i = n1i; }
            }
        }
        const f32x2 ec0 = Eb[c0 * 64 + j], ec1 = Eb[c0 * 64 + 32 + j];
        s0r = (f32x2){c0r, fmaf(t0.x, c0r, fmaf(-t0.y, c0i, ec0.x))}; s0i = (f32x2){c0i, fmaf(t0.x, c0i, fmaf(t0.y, c0r, ec0.y))};
        s1r = (f32x2){c1r, fmaf(t1.x, c1r, fmaf(-t1.y, c1i, ec1.x))}; s1i = (f32x2){c1i, fmaf(t1.x, c1i, fmaf(t1.y, c1r, ec1.y))};
    }
    const int bsel = (j >> 2) & 1, csel = j & 1, tt = ((j & 3) >> 1) + 2 * (j >> 3);
    const size_t urow0 = meta ? (size_t)META_ROW + tt : (size_t)(b0 + bsel) * SEQ + (size_t)(c0 + csel) * CHUNK + tt;
    const bf16* up = U + urow0 * DM + g * 16 + 8 * hi;
    LAS unsigned char* sl = lds + wave * (32 * SP);
    const int nsteps = meta ? 2 : CHUNK / 8;
    const size_t erow = (size_t)b0 * SEQ + (size_t)(c0 + ((lane & 15) >> 3)) * CHUNK + (lane & 7);
    const bf16* ue = U + erow * DM + g * 16 + 4 * (lane >> 4);
    bf16* ze = Z + erow * DM + g * 16 + 4 * (lane >> 4);
    bf16x8 uf = *(const bf16x8*)up;
    u32x2 uu0 = (u32x2){0u, 0u}, uu1 = (u32x2){0u, 0u};
    if (FINAL) { uu0 = *(const u32x2*)ue; uu1 = *(const u32x2*)(ue + (size_t)SEQ * DM); }
    for (int st = 0; st < nsteps; ++st) {
        bf16x8 ufn = uf; u32x2 un0 = uu0, un1 = uu1;
        if (st + 1 < nsteps) { ufn = *(const bf16x8*)(up + (size_t)(st + 1) * 8 * DM);
            if (FINAL) { un0 = *(const u32x2*)(ue + (size_t)(st + 1) * 8 * DM); un1 = *(const u32x2*)(ue + (size_t)(st + 1) * 8 * DM + (size_t)SEQ * DM); } }
        f32x16 X[4];
#pragma unroll
        for (int k = 0; k < 4; ++k) { f32x16 z;
#pragma unroll
            for (int e = 0; e < 16; ++e) z[e] = 0.f;
            X[k] = __builtin_amdgcn_mfma_f32_32x32x16_bf16(uf, bbf[k], z, 0, 0, 0); }
#pragma unroll
        for (int t = 0; t < 8; ++t) {
            const f32x2 x0r = (f32x2){X[0][2 * t], X[0][2 * t + 1]}, x0i = (f32x2){X[1][2 * t], X[1][2 * t + 1]}, x1r = (f32x2){X[2][2 * t], X[2][2 * t + 1]}, x1i = (f32x2){X[3][2 * t], X[3][2 * t + 1]};
            const f32x2 n0r = pk_fma(a0x, s0r, pk_fma(na0y, s0i, x0r)), n0i = pk_fma(a0x, s0i, pk_fma(a0y, s0r, x0i));
            const f32x2 n1r = pk_fma(a1x, s1r, pk_fma(na1y, s1i, x1r)), n1i = pk_fma(a1x, s1i, pk_fma(a1y, s1r, x1i));
            s0r = n0r; s0i = n0i; s1r = n1r; s1i = n1i;
            if (FINAL) {
                LAS unsigned char* r0 = sl + ((hi * 2 + 0) * 8 + t) * SP; LAS unsigned char* r1 = sl + ((hi * 2 + 1) * 8 + t) * SP;
                *(LAS unsigned*)(r0 + j * 4) = cvt_pk(n0r.x, n0i.x); *(LAS unsigned*)(r0 + (32 + j) * 4) = cvt_pk(n1r.x, n1i.x);
                *(LAS unsigned*)(r1 + j * 4) = cvt_pk(n0r.y, n0i.y); *(LAS unsigned*)(r1 + (32 + j) * 4) = cvt_pk(n1r.y, n1i.y); }
        }
        if (FINAL) {
            LDS_WAIT(); asm volatile("" ::: "memory");
#pragma unroll
            for (int bh = 0; bh < 2; ++bh) {
                f32x4 Y = (f32x4){0.f, 0.f, 0.f, 0.f};
#pragma unroll
                for (int k = 0; k < 4; ++k) { const bf16x8 sf = *(const LAS bf16x8*)(sl + (bh * 16 + (lane & 15)) * SP + (32 * k + 8 * (lane >> 4)) * 2);
                    Y = __builtin_amdgcn_mfma_f32_16x16x32_bf16(cmf[k], sf, Y, 0, 0, 0); }
                const u32x2 uu = bh ? uu1 : uu0;
                const float y0 = Y[0] + dsk.x * bf_lo(uu.x), y1 = Y[1] + dsk.y * bf_hi(uu.x), y2 = Y[2] + dsk.z * bf_lo(uu.y), y3 = Y[3] + dsk.w * bf_hi(uu.y);
                u32x2 w; w.x = cvt_pk(gelu_tanh(y0), gelu_tanh(y1)); w.y = cvt_pk(gelu_tanh(y2), gelu_tanh(y3));
                *(u32x2*)(ze + (size_t)st * 8 * DM + (size_t)bh * SEQ * DM) = w;
            }
            LDS_WAIT(); asm volatile("" ::: "memory");
        }
        uf = ufn; uu0 = un0; uu1 = un1;
    }
    if (!FINAL) {
        if (meta) { if (hi == 0) { ((f32x2*)(ws + WS_SMETA))[g * 64 + j] = (f32x2){s0r.x, s0i.x}; ((f32x2*)(ws + WS_SMETA))[g * 64 + 32 + j] = (f32x2){s1r.x, s1i.x}; } }
        else { f32x2* Eb = (f32x2*)E + ((size_t)((b0 + hi) * 64 + g) * NCHUNK + c0) * 64;
            Eb[j] = (f32x2){s0r.x, s0i.x}; Eb[32 + j] = (f32x2){s1r.x, s1i.x}; Eb[64 + j] = (f32x2){s0r.y, s0i.y}; Eb[64 + 32 + j] = (f32x2){s1r.y, s1i.y}; }
    }
}

#define XB_TMO      128
#define XB_XCNT(j)  (256  + 64 * (j))
#define XB_XSUB(j)  (1280 + 64 * (j))
#define XB_XGEN(j)  (2304 + 64 * (j))
#define XB_TOP      3328
#define XB_TOPGEN   3392
#define XCD_BAR_WORDS 3456
#define XB_SPIN_CAP (1u << 18)

__device__ __forceinline__ unsigned xb_ld(unsigned* p)              { return __hip_atomic_load(p, __ATOMIC_RELAXED, __HIP_MEMORY_SCOPE_AGENT); }
__device__ __forceinline__ unsigned xb_add(unsigned* p, unsigned v) { return __hip_atomic_fetch_add(p, v, __ATOMIC_RELAXED, __HIP_MEMORY_SCOPE_AGENT); }
__device__ __forceinline__ unsigned xb_xcc_id() { return (unsigned)__builtin_amdgcn_s_getreg((3 << 11) | 20) & 0xFu; }
#define XB_SPIN(cond, bar) do { unsigned _sp = 0; while (cond) { __builtin_amdgcn_s_sleep(1); \
    if ((++_sp & 255u) == 0u) { if (xb_ld(&(bar)[XB_TMO])) break; if (_sp > XB_SPIN_CAP) { atomicAdd(&(bar)[XB_TMO], 1u); break; } } } } while (0)

struct XcdBarrier {
    unsigned* bar; unsigned x;
    volatile LAS unsigned* st;
};

__device__ __forceinline__ XcdBarrier xcd_barrier_post(unsigned* bar, volatile LAS unsigned* st) {
    XcdBarrier b; b.bar = bar; b.x = xb_xcc_id(); b.st = st;
    if (threadIdx.x == 0) (void)xb_add(&bar[XB_XCNT(b.x)], 1u);
    return b;
}
__device__ __forceinline__ void xcd_barrier_complete(unsigned* bar, unsigned x, unsigned& nloc, unsigned& nx) {
    const unsigned G = gridDim.x * gridDim.y * gridDim.z;
    unsigned sum, cnt, mine, sp = 0u;
    for (;;) {
        sum = 0u; cnt = 0u; mine = 0u;
#pragma unroll
        for (unsigned j = 0; j < 16; ++j) { const unsigned c = xb_ld(&bar[XB_XCNT(j)]); sum += c; cnt += (c > 0u) ? 1u : 0u; mine = (j == x) ? c : mine; }
        if (sum == G) break;
        __builtin_amdgcn_s_sleep(1);
        if ((++sp & 255u) == 0u) { if (xb_ld(&bar[XB_TMO])) break; if (sp > XB_SPIN_CAP) { atomicAdd(&bar[XB_TMO], 1u); break; } }
    }
    nloc = mine > 0u ? mine : 1u; nx = cnt > 0u ? cnt : 1u;
}

__device__ __forceinline__ void xcd_barrier(const XcdBarrier& b) {
    asm volatile("s_waitcnt vmcnt(0)" ::: "memory");
    __syncthreads();
    if (threadIdx.x == 0) {
        unsigned* bar = b.bar;
        __builtin_amdgcn_s_waitcnt(0);
        unsigned nloc = b.st[0], nx = b.st[1];
        if (nloc == 0u) { xcd_barrier_complete(bar, b.x, nloc, nx); b.st[0] = nloc; b.st[1] = nx; }
        const unsigned old = xb_add(&bar[XB_XSUB(b.x)], 1u);
        const unsigned gen = old / nloc;
        if (old + 1u == (gen + 1u) * nloc) {
            __builtin_amdgcn_fence(__ATOMIC_RELEASE, "agent");
            asm volatile("s_waitcnt vmcnt(0)" ::: "memory");
            const unsigned og = xb_add(&bar[XB_TOP], 1u);
            const unsigned tg = og / nx;
            if (og + 1u == (tg + 1u) * nx) xb_add(&bar[XB_TOPGEN], 1u);
            else XB_SPIN(xb_ld(&bar[XB_TOPGEN]) == tg, bar);
            __builtin_amdgcn_fence(__ATOMIC_ACQUIRE, "agent");
            xb_add(&bar[XB_XGEN(b.x)], 1u);
            asm volatile("s_waitcnt vmcnt(0)" ::: "memory");
        } else {
            XB_SPIN(xb_ld(&bar[XB_XGEN(b.x)]) == gen, bar);
            __builtin_amdgcn_fence(__ATOMIC_ACQUIRE, "agent");
            asm volatile("s_waitcnt vmcnt(0)" ::: "memory");
        }
    }
    __syncthreads();
}

__device__ __forceinline__ void meta_proj(const Args& a, int wave, int lane) {
    unsigned char* ws = a.ws;
    const bf16* XB = (const bf16*)(ws + WS_XB); const bf16* W1t = (const bf16*)(ws + WS_W1); const float* rstdx = (const float*)(ws + WS_RSTDX);
    for (int gw = blockIdx.x * NWAVES + wave; gw < 1536; gw += gridDim.x * NWAVES) {
    const int n = 1024 + gw;
    float wf[16];
    { const u32x4 w0 = *(const u32x4*)(W1t + (size_t)n * DM + lane * 8), w1 = *(const u32x4*)(W1t + (size_t)n * DM + 512 + lane * 8);
      const unsigned ww[8] = {w0.x, w0.y, w0.z, w0.w, w1.x, w1.y, w1.z, w1.w};
#pragma unroll
      for (int e = 0; e < 8; ++e) { wf[2 * e] = bf_lo(ww[e]); wf[2 * e + 1] = bf_hi(ww[e]); } }
    float mine = 0.f;
#pragma unroll
    for (int r = 0; r < 16; ++r) {
        const u32x4 x0 = *(const u32x4*)(XB + (size_t)(META_ROW + r) * DM + lane * 8), x1 = *(const u32x4*)(XB + (size_t)(META_ROW + r) * DM + 512 + lane * 8);
        const unsigned xx[8] = {x0.x, x0.y, x0.z, x0.w, x1.x, x1.y, x1.z, x1.w};
        float s = 0.f;
#pragma unroll
        for (int e = 0; e < 8; ++e) s += bf_lo(xx[e]) * wf[2 * e] + bf_hi(xx[e]) * wf[2 * e + 1];
        s = wave_sum(s);
        if (lane == r) mine = s;
    }
    if (lane < 16) {
        const unsigned short o = (unsigned short)(cvt_pk(mine * rstdx[META_ROW + lane], 0.f) & 0xffffu);
        const size_t row = META_ROW + lane;
        if (n < 1280) ((bf16*)(ws + WS_K))[row * KVW + (n - 1024)] = o;
        else if (n < 1536) ((bf16*)(ws + WS_V))[row * KVW + (n - 1280)] = o;
        else ((bf16*)(ws + WS_U))[row * DM + (n - 1536)] = o;
    }
    }
}

constexpr int MISC_OFF = LDS_BYTES - 256;
constexpr size_t WS_BAR = 768 * 1024;
__global__ void __launch_bounds__(NTHREADS, 2) mk_fwd(Args a) {
    extern __shared__ __attribute__((aligned(16))) unsigned char lds_raw[];
    cg::grid_group grid = cg::this_grid();
    LAS unsigned char* lds = (LAS unsigned char*)lds_raw;
    const int tid = threadIdx.x, lane = tid & 63, wave = __builtin_amdgcn_readfirstlane(tid >> 6);
    unsigned char* ws = a.ws;
    const int G = gridDim.x, c = blockIdx.x;
    volatile LAS unsigned* MISC = (volatile LAS unsigned*)(lds + MISC_OFF);
    if (tid < 32) MISC[tid] = 0u;
    __syncthreads();
    unsigned* barw = (unsigned*)(ws + WS_BAR);
    XcdBarrier bar = xcd_barrier_post(barw, MISC + 8);
    if (a.never) grid.sync();

    p0_prologue(a, lds, wave, lane);
    xcd_barrier(bar);
    meta_proj(a, wave, lane);
    { pg8::Gemm g{(const pg8::bf16_t*)(ws + WS_XB), (const pg8::bf16_t*)(ws + WS_W1), NTOK, NQKVU, DM}; pg8::StaticOrder S; S.init(NTOK, NQKVU, G, c);
      EpiProj E{(bf16*)(ws + WS_Q), (bf16*)(ws + WS_K), (bf16*)(ws + WS_V), (bf16*)(ws + WS_U), (const float*)(ws + WS_RSTDX)};
      pg8::gemm_phase<EpiProj, pg8::StaticOrder, true, true>(lds, g, S, E); }
    xcd_barrier(bar);
    for (int it = c; it < 512; it += G) attn_item(a, lds, it, wave, lane);
    for (int it = c; it < 256 + 8; it += G) ssm_item<false>(a, lds, it, wave, lane);
    xcd_barrier(bar);
    for (int it = c; it < 256; it += G) ssm_item<true>(a, lds, it, wave, lane);
    xcd_barrier(bar);
    { pg8::Gemm g{(const pg8::bf16_t*)(ws + WS_Q), (const pg8::bf16_t*)(ws + WS_W2), NTOK, 2048, DM}; pg8::StaticOrder S; S.init(NTOK, 2048, G, c);
      EpiGlu E{(bf16*)(ws + WS_U), DM, (float*)(ws + WS_ROWSB)};
      pg8::gemm_phase<EpiGlu, pg8::StaticOrder, true, true>(lds, g, S, E); }
    xcd_barrier(bar);
    { pg8::Gemm g{(const pg8::bf16_t*)(ws + WS_XB), (const pg8::bf16_t*)(ws + WS_WG), NTOK, 2048, DM}; pg8::StaticOrder S; S.init(NTOK, 2048, G, c);
      EpiMerge E{(const bf16*)(ws + WS_ATT), (const bf16*)(ws + WS_U), (bf16*)(ws + WS_Q), (const float*)(ws + WS_RSTDX), (const float*)(ws + WS_ROWSA), (const float*)(ws + WS_ROWSB), a.in[16], a.in[17]};
      pg8::gemm_phase<EpiMerge, pg8::StaticOrder, true, true>(lds, g, S, E); }
    xcd_barrier(bar);
    { pg8::Gemm g{(const pg8::bf16_t*)(ws + WS_Q), (const pg8::bf16_t*)(ws + WS_W3), NTOK, DM, DM}; pg8::StaticOrder S; S.init(NTOK, DM, G, c);
      EpiResid1 E{(const bf16*)(ws + WS_XB), (bf16*)(ws + WS_ATT), (float*)(ws + WS_ROWSS)};
      pg8::gemm_phase<EpiResid1, pg8::StaticOrder, true, true>(lds, g, S, E); }
    xcd_barrier(bar);
    { pg8::Gemm g{(const pg8::bf16_t*)(ws + WS_ATT), (const pg8::bf16_t*)(ws + WS_W4), NTOK, 2 * DFF, DM}; pg8::StaticOrder S; S.init(NTOK, 2 * DFF, G, c);
      EpiSwiglu E{(bf16*)(ws + WS_ACT), DFF, (const float*)(ws + WS_ROWSS)};
      pg8::gemm_phase<EpiSwiglu, pg8::StaticOrder, true, true, true>(lds, g, S, E); }
    xcd_barrier(bar);
    { pg8::Gemm g{(const pg8::bf16_t*)(ws + WS_ACT), (const pg8::bf16_t*)(ws + WS_W5), NTOK, DM, DFF}; pg8::StaticOrder S; S.init(NTOK, DM, G, c);
      EpiResid2 E{(const bf16*)(ws + WS_ATT), a.out};
      pg8::gemm_phase<EpiResid2, pg8::StaticOrder, true, true>(lds, g, S, E); }
}

extern "C" void kernel_launch(void* const* d_in, const int* in_sizes, int n_in, void* d_out, int out_size, void* d_ws, size_t ws_size, hipStream_t stream) {
    static int grid = 0;
    if (grid == 0) {
        if (n_in != 22 || in_sizes[0] != NTOK * DM || out_size != NTOK * DM || ws_size < WS_END) { fprintf(stderr, "kernel_launch: unexpected shapes (n_in %d, in0 %d, out %d, ws %zu)\n", n_in, n_in > 0 ? in_sizes[0] : -1, out_size, ws_size); grid = -1; return; }
        int dev = 0, cus = 0, per_cu = 0;
        (void)hipGetDevice(&dev); (void)hipDeviceGetAttribute(&cus, hipDeviceAttributeMultiprocessorCount, dev);
        if (hipFuncSetAttribute((const void*)mk_fwd, hipFuncAttributeMaxDynamicSharedMemorySize, LDS_BYTES) != hipSuccess) { fprintf(stderr, "kernel_launch: hipFuncSetAttribute failed\n"); grid = -1; return; }
        if (hipOccupancyMaxActiveBlocksPerMultiprocessor(&per_cu, (const void*)mk_fwd, NTHREADS, LDS_BYTES) != hipSuccess || per_cu < 1) { fprintf(stderr, "kernel_launch: occupancy query says %d; nothing launched\n", per_cu); grid = -1; return; }
        (void)hipGetLastError();
        grid = cus;
    }
    if (grid < 0) return;
    Args a{};
    for (int i = 0; i < 22; ++i) a.in[i] = (const float*)d_in[i];
    a.out = (float*)d_out; a.ws = (unsigned char*)d_ws;
    if (hipMemsetAsync((unsigned char*)d_ws + WS_BAR, 0, XCD_BAR_WORDS * 4, stream) != hipSuccess) { fprintf(stderr, "kernel_launch: memset of the barrier words failed\n"); return; }
    void* args[] = {&a};
    hipError_t e = hipLaunchCooperativeKernel((const void*)mk_fwd, dim3(grid), dim3(NTHREADS), args, LDS_BYTES, stream);
    if (e != hipSuccess) fprintf(stderr, "cooperative launch failed: %s (grid %d)\n", hipGetErrorString(e), grid);
}
```

```cpp
#include <hip/hip_runtime.h>
#include <hip/hip_cooperative_groups.h>
#include <cstdio>
#include <cstdint>
namespace cg = cooperative_groups;
namespace pg8 {
#define PG8_LAS __attribute__((address_space(3)))
typedef unsigned short bf16_t;
typedef short bf16x8 __attribute__((ext_vector_type(8)));
typedef float f32x4 __attribute__((ext_vector_type(4)));
typedef unsigned u32x4 __attribute__((ext_vector_type(4)));
constexpr int BM = 256, BK = 64, HALF = 128, HTB = HALF * BK * 2  , STAGE_BYTES = 8 * HTB, NXCD = 8, WGM = 8;

__host__ __device__ __forceinline__ int lds_byte(int r, int c) { const int st = (r >> 4) * 2 + (c >> 5), rr = r & 15, cc = c & 31, ob = rr * 64 + cc * 2; return st * 1024 + (ob ^ (((ob >> 9) & 1) << 5)); }
__host__ __device__ __forceinline__ void stage_rc(int b, int& R, int& C) { const int st = b / 1024, sb = b % 1024, swz = sb ^ (((sb >> 9) & 1) << 5); R = (st >> 1) * 16 + swz / 64; C = (st & 1) * 32 + (swz % 64) / 2; }
__host__ __device__ __forceinline__ int perm32(int rho) { const int n = rho >> 4, i = rho & 15; return 8 * (i >> 2) + 4 * n + (i & 3); }

struct Unit { int pm, pn; };
struct Gemm { const bf16_t* A; const bf16_t* Bt; int M, N, K; };

struct StaticOrder {
    int nM, nN, nwg, G, c;
    __host__ __device__ void init(int M, int N, int G_, int c_) { nM = M / BM; nN = N / BM; nwg = nM * nN; G = G_; c = c_; }
    __host__ __device__ bool next(int i, Unit& u) const {
        const long L = (long)i * G + c; if (L >= nwg) return false;
        int wgid = (int)L; { const int q = nwg / NXCD, r = nwg % NXCD, xcd = wgid % NXCD, off = wgid / NXCD; wgid = (xcd < r ? xcd * (q + 1) : r * (q + 1) + (xcd - r) * q) + off; }
        const int nig = WGM * nN, gid = wgid / nig, fm = gid * WGM, gsz = (nM - fm) < WGM ? (nM - fm) : WGM;
        u.pm = fm + ((wgid % nig) % gsz); u.pn = (wgid % nig) / gsz; return true;
    }
    __device__ __forceinline__ void a_ready(const Unit&) const {}
    __device__ __forceinline__ void done(const Unit&) const {}
};

__device__ __forceinline__ unsigned cvt_pk_bf16(float lo, float hi) { unsigned r; asm volatile("v_cvt_pk_bf16_f32 %0, %1, %2" : "=v"(r) : "v"(lo), "v"(hi)); return r; }
typedef float f32x2 __attribute__((ext_vector_type(2)));
__device__ __forceinline__ f32x2 gelu_pk(f32x2 v) {
    const f32x2 av = __builtin_elementwise_abs(v), d = av * 0.2316418882f + 1.0f;
    f32x2 t; t.x = __builtin_amdgcn_rcpf(d.x); t.y = __builtin_amdgcn_rcpf(d.y);
    f32x2 q = t * 0.5307027145f + (-0.7265760135f); q = q * t + 0.7107068705f; q = q * t + (-0.142248368f); q = q * t + 0.127414796f; q = q * t;
    const f32x2 s = (v * v) * (-0.72134752044f);
    f32x2 e; e.x = __builtin_amdgcn_exp2f(s.x); e.y = __builtin_amdgcn_exp2f(s.y);
    const f32x2 m = v * (q * e), r = v - m;
    f32x2 o; o.x = v.x < 0.f ? m.x : r.x; o.y = v.y < 0.f ? m.y : r.y; return o;
}

template <int ACT  > struct EpiBf16 {
    static constexpr bool PERM = true, AFTER_DRAIN = false; static_assert(ACT == 0 || ACT == 1, "EpiBf16: ACT is 0 (none) or 1 (gelu_pk)");
    bf16_t* O; int ldc; const float* bias; int split_cols; size_t split_stride; float scale0;
    __device__ __forceinline__ void operator()(const f32x4 (&acc)[2][2][4][2], const Unit& u, int wr, int wc, int fr, int fq) const {
        const int row0 = u.pm * BM + wr * 64 + fr; int colt = u.pn * BM; bf16_t* base = O;
        float sc = 1.f; if (split_cols) { const int t = colt / split_cols; base += (size_t)t * split_stride; colt -= t * split_cols; if (t == 0) sc = scale0; }
        const int col0 = colt + wc * 32 + 8 * fq, bcol0 = u.pn * BM + wc * 32 + 8 * fq;
        f32x4 bv[2][2];
#pragma unroll
        for (int bj = 0; bj < 2; ++bj)
#pragma unroll
            for (int n = 0; n < 2; ++n) bv[bj][n] = bias ? *(const f32x4*)(bias + bcol0 + bj * HALF + 4 * n) : (f32x4){0.f, 0.f, 0.f, 0.f};
#pragma unroll
        for (int ai = 0; ai < 2; ++ai)
#pragma unroll
            for (int m = 0; m < 4; ++m) { bf16_t* rowp = base + (size_t)(row0 + ai * HALF + m * 16) * ldc + col0;
#pragma unroll
                for (int bj = 0; bj < 2; ++bj) { f32x4 v0 = acc[ai][bj][m][0] + bv[bj][0], v1 = acc[ai][bj][m][1] + bv[bj][1];
                    if (ACT == 1) { f32x2 a = gelu_pk((f32x2){v0[0], v0[1]}), b = gelu_pk((f32x2){v0[2], v0[3]}), c = gelu_pk((f32x2){v1[0], v1[1]}), d = gelu_pk((f32x2){v1[2], v1[3]});
                        v0 = (f32x4){a.x, a.y, b.x, b.y}; v1 = (f32x4){c.x, c.y, d.x, d.y}; }
                    v0 = v0 * sc; v1 = v1 * sc; u32x4 w; w.x = cvt_pk_bf16(v0[0], v0[1]); w.y = cvt_pk_bf16(v0[2], v0[3]); w.z = cvt_pk_bf16(v1[0], v1[1]); w.w = cvt_pk_bf16(v1[2], v1[3]);
                    *(u32x4*)(rowp + bj * HALF) = w; } }
    }
};
template <bool F16> __device__ __forceinline__ f32x4 mma16(bf16x8 b, bf16x8 a, f32x4 c) {
    if constexpr (F16) { typedef _Float16 h16x8 __attribute__((ext_vector_type(8))); return __builtin_amdgcn_mfma_f32_16x16x32_f16(__builtin_bit_cast(h16x8, b), __builtin_bit_cast(h16x8, a), c, 0, 0, 0); }
    else return __builtin_amdgcn_mfma_f32_16x16x32_bf16(b, a, c, 0, 0, 0);
}
template <class Epi, class Sched, bool ALIGN_EPI = false, bool SP2 = false, bool F16 = false>
__device__ __forceinline__ void gemm_phase(PG8_LAS unsigned char* lds, const Gemm g, const Sched& S, const Epi& E) {
    const int tid = threadIdx.x, wid = __builtin_amdgcn_readfirstlane(tid >> 6), lane = tid & 63, wr = wid >> 2, wc = wid & 3, fr = lane & 15, fq = lane >> 4;
    const int K = g.K, nt = K / BK;
    unsigned voffA[2], voffB[2];
#pragma unroll
    for (int i = 0; i < 2; ++i) { int R, C; stage_rc(tid * 16 + i * 8192, R, C); const int Rb = Epi::PERM ? ((R & ~31) + perm32(R & 31)) : R;
        voffA[i] = (unsigned)(R * K + C) * 2u; voffB[i] = (unsigned)(Rb * K + C) * 2u; }
    const size_t kstep = (size_t)(BK * 2);
    const size_t hstep = (size_t)HALF * K * 2;
    const size_t tstep = 2 * hstep;
    const unsigned ldsw = (unsigned)wid * 1024u;
    const int aoff = lds_byte(wr * 64 + fr, fq * 8), boff = lds_byte(wc * 32 + fr, fq * 8);
#define PG8_SA(b, h) (((b) * 2 + (h)) * HTB)
#define PG8_SB(b, h) ((4 + (b) * 2 + (h)) * HTB)
#define PG8_STAGE(bufoff, gbase, voff) do { _Pragma("unroll") for (int _i = 0; _i < 2; ++_i) \
        __builtin_amdgcn_global_load_lds((const unsigned*)((const char*)(gbase) + (voff)[_i]), (PG8_LAS unsigned*)(lds + (bufoff) + ldsw + _i * 8192), 16, 0, 0); } while (0)
#define PG8_LDA(dst, b, h) do { _Pragma("unroll") for (int m = 0; m < 4; ++m) _Pragma("unroll") for (int k = 0; k < 2; ++k) dst[m][k] = *(const PG8_LAS bf16x8*)(lds + PG8_SA(b, h) + aoff + m * 2048 + k * 1024); } while (0)
#define PG8_LDB(dst, b, h) do { _Pragma("unroll") for (int n = 0; n < 2; ++n) _Pragma("unroll") for (int k = 0; k < 2; ++k) dst[n][k] = *(const PG8_LAS bf16x8*)(lds + PG8_SB(b, h) + boff + n * 2048 + k * 1024); } while (0)
#define PG8_MMA(ai, bj, At, Bt) do { __builtin_amdgcn_s_setprio(1); _Pragma("unroll") for (int m = 0; m < 4; ++m) _Pragma("unroll") for (int n = 0; n < 2; ++n) _Pragma("unroll") for (int k = 0; k < 2; ++k) \
        acc[ai][bj][m][n] = mma16<F16>(Bt[n][k], At[m][k], acc[ai][bj][m][n]); __builtin_amdgcn_s_setprio(0); } while (0)
#define PG8_WAIT_V(n) asm volatile("s_waitcnt vmcnt(" #n ")" ::: "memory")
#define PG8_WAIT_L(n) asm volatile("s_waitcnt lgkmcnt(" #n ")" ::: "memory")
#define PG8_BAR __builtin_amdgcn_s_barrier()
#define PG8_SCHED __builtin_amdgcn_sched_barrier(0)
    Unit cur, nxt; int ui = 0;
    if (!S.next(0, cur)) return;
    f32x4 acc[2][2][4][2];
#pragma unroll
    for (int a = 0; a < 2; ++a)
#pragma unroll
        for (int b = 0; b < 2; ++b)
#pragma unroll
            for (int m = 0; m < 4; ++m)
#pragma unroll
                for (int n = 0; n < 2; ++n) acc[a][b][m][n] = (f32x4){0.f, 0.f, 0.f, 0.f};
    bf16x8 At[4][2], B0[2][2], B1[2][2];
    const char* cA = (const char*)g.A + (size_t)cur.pm * tstep; const char* cB = (const char*)g.Bt + (size_t)cur.pn * tstep;
    S.a_ready(cur);
    if constexpr (SP2) {
        PG8_STAGE(PG8_SB(0, 0), cB, voffB); PG8_STAGE(PG8_SB(0, 1), cB + hstep, voffB); PG8_STAGE(PG8_SA(0, 0), cA, voffA); PG8_STAGE(PG8_SA(0, 1), cA + hstep, voffA);
        if (wr == 1) PG8_BAR;
        PG8_WAIT_V(2); PG8_BAR;
        PG8_STAGE(PG8_SB(1, 0), cB + kstep, voffB); PG8_STAGE(PG8_SA(1, 0), cA + kstep, voffA); PG8_STAGE(PG8_SB(1, 1), cB + hstep + kstep, voffB);
        PG8_WAIT_V(6); PG8_BAR;
    } else {
        PG8_STAGE(PG8_SB(0, 0), cB, voffB); PG8_STAGE(PG8_SA(0, 0), cA, voffA); PG8_STAGE(PG8_SB(0, 1), cB + hstep, voffB); PG8_STAGE(PG8_SA(0, 1), cA + hstep, voffA);
        if (wr == 1) PG8_BAR;
        PG8_WAIT_V(4); PG8_BAR;
        PG8_STAGE(PG8_SB(1, 0), cB + kstep, voffB); PG8_STAGE(PG8_SA(1, 0), cA + kstep, voffA); PG8_STAGE(PG8_SB(1, 1), cB + hstep + kstep, voffB);
        PG8_WAIT_V(6); PG8_BAR;
    }
    for (;;) {
        const bool has_next = S.next(ui + 1, nxt);
        const char* nA = has_next ? (const char*)g.A + (size_t)nxt.pm * tstep : cA; const char* nB = has_next ? (const char*)g.Bt + (size_t)nxt.pn * tstep : cB;
        for (int t = 0; t < nt; t += 2) {
            const bool last = (t == nt - 2);
            const char* a1 = cA + (size_t)(t + 1) * kstep;
            const char* a2 = last ? nA : cA + (size_t)(t + 2) * kstep; const char* b2 = last ? nB : cB + (size_t)(t + 2) * kstep;
            const char* a3 = a2 + kstep; const char* b3 = b2 + kstep;
            if (last && has_next) S.a_ready(nxt);
            if constexpr (SP2) {
            PG8_LDB(B0, 0, 0); PG8_LDB(B1, 0, 1); PG8_SCHED; PG8_LDA(At, 0, 0); PG8_STAGE(PG8_SA(1, 1), a1 + hstep, voffA);
            PG8_WAIT_V(8); PG8_WAIT_L(0); PG8_BAR; PG8_MMA(0, 0, At, B0); PG8_MMA(0, 1, At, B1); PG8_BAR; PG8_SCHED;
            PG8_LDA(At, 0, 1); PG8_STAGE(PG8_SB(0, 0), b2, voffB); PG8_STAGE(PG8_SB(0, 1), b2 + hstep, voffB); PG8_STAGE(PG8_SA(0, 0), a2, voffA);
            PG8_WAIT_V(8); PG8_WAIT_L(0); PG8_BAR; PG8_MMA(1, 0, At, B0); PG8_MMA(1, 1, At, B1); PG8_BAR; PG8_SCHED;
            PG8_LDB(B0, 1, 0); PG8_LDB(B1, 1, 1); PG8_SCHED; PG8_LDA(At, 1, 0); PG8_STAGE(PG8_SA(0, 1), a2 + hstep, voffA);
            PG8_WAIT_V(8); PG8_WAIT_L(0); PG8_BAR; PG8_MMA(0, 0, At, B0); PG8_MMA(0, 1, At, B1); PG8_BAR; PG8_SCHED;
            PG8_LDA(At, 1, 1); PG8_STAGE(PG8_SB(1, 0), b3, voffB); PG8_STAGE(PG8_SB(1, 1), b3 + hstep, voffB); PG8_STAGE(PG8_SA(1, 0), a3, voffA);
            PG8_WAIT_V(8); PG8_WAIT_L(0); PG8_BAR; PG8_MMA(1, 0, At, B0); PG8_MMA(1, 1, At, B1); PG8_BAR; PG8_SCHED;
            } else {
            PG8_LDB(B0, 0, 0); PG8_SCHED; PG8_LDA(At, 0, 0); PG8_STAGE(PG8_SA(1, 1), a1 + hstep, voffA);
            PG8_WAIT_L(8); PG8_BAR; PG8_WAIT_L(0); PG8_MMA(0, 0, At, B0); PG8_BAR; PG8_SCHED;
            PG8_LDB(B1, 0, 1); PG8_STAGE(PG8_SB(0, 0), b2, voffB);
            PG8_BAR; PG8_WAIT_L(0); PG8_MMA(0, 1, At, B1); PG8_BAR;
            PG8_LDA(At, 0, 1); PG8_STAGE(PG8_SA(0, 0), a2, voffA);
            PG8_BAR; PG8_WAIT_L(0); PG8_MMA(1, 0, At, B0); PG8_BAR; PG8_SCHED;
            PG8_STAGE(PG8_SB(0, 1), b2 + hstep, voffB);
            PG8_WAIT_V(6); PG8_BAR; PG8_MMA(1, 1, At, B1); PG8_BAR;
            PG8_LDB(B0, 1, 0); PG8_SCHED; PG8_LDA(At, 1, 0); PG8_STAGE(PG8_SA(0, 1), a2 + hstep, voffA);
            PG8_WAIT_L(8); PG8_BAR; PG8_WAIT_L(0); PG8_MMA(0, 0, At, B0); PG8_BAR; PG8_SCHED;
            PG8_LDB(B1, 1, 1); PG8_STAGE(PG8_SB(1, 0), b3, voffB);
            PG8_BAR; PG8_WAIT_L(0); PG8_MMA(0, 1, At, B1); PG8_BAR;
            PG8_LDA(At, 1, 1); PG8_STAGE(PG8_SA(1, 0), a3, voffA);
            PG8_BAR; PG8_WAIT_L(0); PG8_MMA(1, 0, At, B0); PG8_BAR; PG8_SCHED;
            PG8_STAGE(PG8_SB(1, 1), b3 + hstep, voffB);
            PG8_WAIT_V(6); PG8_BAR; PG8_MMA(1, 1, At, B1); PG8_BAR;
            }
        }
        if constexpr (ALIGN_EPI) { if (wr == 0) PG8_BAR; }
        if constexpr (!Epi::AFTER_DRAIN) { E(acc, cur, wr, wc, fr, fq); S.done(cur); }
        if (!has_next) break;
#pragma unroll
        for (int a = 0; a < 2; ++a)
#pragma unroll
            for (int b = 0; b < 2; ++b)
#pragma unroll
                for (int m = 0; m < 4; ++m)
#pragma unroll
                    for (int n = 0; n < 2; ++n) acc[a][b][m][n] = (f32x4){0.f, 0.f, 0.f, 0.f};
        cur = nxt; cA = nA; cB = nB; ++ui;
        if constexpr (ALIGN_EPI) { if (wr == 1) PG8_BAR; }
    }
    PG8_WAIT_V(0);
    if constexpr (!ALIGN_EPI) { if (wr == 0) PG8_BAR; }
    PG8_BAR;
    if constexpr (Epi::AFTER_DRAIN) { E.fused(acc, cur, wr, wc, fr, fq, lds, wid, lane); S.done(cur); }
#undef PG8_SA
#undef PG8_SB
#undef PG8_STAGE
#undef PG8_LDA
#undef PG8_LDB
#undef PG8_MMA
#undef PG8_WAIT_V
#undef PG8_WAIT_L
#undef PG8_BAR
#undef PG8_SCHED
}
}

#define LAS __attribute__((address_space(3)))
typedef unsigned short bf16;
typedef float f32x4 __attribute__((ext_vector_type(4)));
typedef float f32x2 __attribute__((ext_vector_type(2)));
typedef float f32x16 __attribute__((ext_vector_type(16)));
typedef short bf16x8 __attribute__((ext_vector_type(8)));
typedef short s16x4 __attribute__((ext_vector_type(4)));
typedef unsigned u32x4 __attribute__((ext_vector_type(4)));
typedef unsigned u32x2 __attribute__((ext_vector_type(2)));

constexpr int NB = 4, SEQ = 8192, DM = 1024, NTOK = NB * SEQ, MROWS = NTOK + 256, META_ROW = NTOK;
constexpr int INC = 4608, DFF = 2816, KVW = 256;
constexpr int NGRP = 64, NST = 64, CHUNK = 256, NCHUNK = SEQ / CHUNK;
constexpr float EPS = 1e-6f;
constexpr int NTHREADS = 512, NWAVES = 8;
constexpr int LDS_BYTES = 147456;

constexpr size_t MiB = 1u << 20;
constexpr size_t WS_RSTDX = 0;
constexpr size_t WS_ROWSS = 256 * 1024;
constexpr size_t WS_ROWSA = 384 * 1024;
constexpr size_t WS_ROWSB = 800 * 1024;
constexpr size_t WS_ATAB = 512 * 1024;
constexpr size_t WS_ATAB2 = 512 * 1024 + 32768;
constexpr size_t WS_SMETA = 512 * 1024 + 65536;
constexpr size_t WS_BB = 1 * MiB;
constexpr size_t WS_CM = 1 * MiB + 262144;
constexpr size_t WS_WG = 7 * MiB;
constexpr int NQKVU = 2560;
constexpr size_t WS_W1 = 2 * MiB, WS_W2 = 11 * MiB, WS_W3 = 15 * MiB, WS_W4 = 17 * MiB, WS_W5 = 28 * MiB;
constexpr size_t WS_E = 34 * MiB;
constexpr size_t ROWBUF = (size_t)MROWS * DM * 2;
constexpr size_t WS_XB = 44 * MiB;
constexpr size_t WS_Q = 110 * MiB;
constexpr size_t WS_K = 175 * MiB, WS_V = 192 * MiB;
constexpr size_t WS_U = 209 * MiB;
constexpr size_t WS_GA = 274 * MiB, WS_GS = 339 * MiB;
constexpr size_t WS_ATT = 404 * MiB;
constexpr size_t WS_ACT = 110 * MiB;
constexpr size_t WS_END = 470 * MiB;
static_assert(WS_XB + ROWBUF <= WS_Q && WS_Q + ROWBUF <= WS_K && WS_U + ROWBUF <= WS_GA && WS_GA + ROWBUF <= WS_GS && WS_GS + ROWBUF <= WS_ATT && WS_ATT + ROWBUF <= WS_END, "ws map");
static_assert(WS_K + (size_t)MROWS * KVW * 2 <= WS_V && WS_V + (size_t)MROWS * KVW * 2 <= WS_U, "ws map kv");
static_assert(WS_ACT + (size_t)NTOK * DFF * 2 <= WS_GS, "act overlay");

__device__ __forceinline__ unsigned cvt_pk(float lo, float hi) { unsigned r; asm volatile("v_cvt_pk_bf16_f32 %0, %1, %2" : "=v"(r) : "v"(lo), "v"(hi)); return r; }
__device__ __forceinline__ float bf_lo(unsigned w) { return __uint_as_float(w << 16); }
__device__ __forceinline__ float bf_hi(unsigned w) { return __uint_as_float(w & 0xffff0000u); }
__device__ __forceinline__ unsigned pk_f16(float lo, float hi) { const _Float16 a = (_Float16)lo, b = (_Float16)hi; return (unsigned)__builtin_bit_cast(unsigned short, a) | ((unsigned)__builtin_bit_cast(unsigned short, b) << 16); }
__device__ __forceinline__ float f16_lo(unsigned w) { return (float)__builtin_bit_cast(_Float16, (unsigned short)(w & 0xffffu)); }
__device__ __forceinline__ float f16_hi(unsigned w) { return (float)__builtin_bit_cast(_Float16, (unsigned short)(w >> 16)); }
__device__ __forceinline__ float fast_sigmoid(float v) { return __builtin_amdgcn_rcpf(1.0f + __builtin_amdgcn_exp2f(-1.4426950408889634f * v)); }
__device__ __forceinline__ float wave_sum(float v) {
#pragma unroll
    for (int o = 1; o < 64; o <<= 1) v += __shfl_xor(v, o);
    return v;
}
#define LDS_WAIT() asm volatile("s_waitcnt lgkmcnt(0)" ::: "memory")

struct EpiProj {
    static constexpr bool PERM = true, AFTER_DRAIN = false;
    bf16 *Q, *K, *V, *U; const float* rstd;
    __device__ __forceinline__ void operator()(const pg8::f32x4 (&acc)[2][2][4][2], const pg8::Unit& u, int wr, int wc, int fr, int fq) const {
        const int pn = u.pn; bf16* base; int ld, ct;
        if (pn < 4) { base = Q; ld = DM; ct = pn; } else if (pn == 4) { base = K; ld = KVW; ct = 0; } else if (pn == 5) { base = V; ld = KVW; ct = 0; } else { base = U; ld = DM; ct = pn - 6; }
        const int row0 = u.pm * 256 + wr * 64 + fr, col0 = ct * 256 + wc * 32 + 8 * fq;
        float rsv[8];
#pragma unroll
        for (int q = 0; q < 8; ++q) rsv[q] = rstd[row0 + (q >> 2) * 128 + (q & 3) * 16];
        asm volatile("" : "+v"(rsv[0]), "+v"(rsv[1]), "+v"(rsv[2]), "+v"(rsv[3]), "+v"(rsv[4]), "+v"(rsv[5]), "+v"(rsv[6]), "+v"(rsv[7]));
#pragma unroll
        for (int ai = 0; ai < 2; ++ai)
#pragma unroll
            for (int m = 0; m < 4; ++m) { const int row = row0 + ai * 128 + m * 16; const float rs = rsv[ai * 4 + m]; bf16* rowp = base + (size_t)row * ld + col0;
#pragma unroll
                for (int bj = 0; bj < 2; ++bj) { pg8::f32x4 v0 = acc[ai][bj][m][0] * rs, v1 = acc[ai][bj][m][1] * rs;
                    u32x4 w; w.x = cvt_pk(v0[0], v0[1]); w.y = cvt_pk(v0[2], v0[3]); w.z = cvt_pk(v1[0], v1[1]); w.w = cvt_pk(v1[2], v1[3]);
                    *(u32x4*)(rowp + bj * 128) = w; } }
    }
};
struct EpiMerge {
    static constexpr bool PERM = true, AFTER_DRAIN = false;
    const bf16* ATT; const bf16* SSM; bf16* MG; const float* rstd; const float* rowsa; const float* rowsb; const float* wa; const float* wsn;
    __device__ __forceinline__ void operator()(const pg8::f32x4 (&acc)[2][2][4][2], const pg8::Unit& u, int wr, int wc, int fr, int fq) const {
        const int row0 = u.pm * 256 + wr * 64 + fr, col0 = u.pn * 128 + wc * 32 + 8 * fq;
        const pg8::f32x4 wa0 = *(const pg8::f32x4*)(wa + col0), wa1 = *(const pg8::f32x4*)(wa + col0 + 4), ws0 = *(const pg8::f32x4*)(wsn + col0), ws1 = *(const pg8::f32x4*)(wsn + col0 + 4);
        float rsv[8], rav[8], rbv[8];
#pragma unroll
        for (int q = 0; q < 8; ++q) { const int row = row0 + (q >> 2) * 128 + (q & 3) * 16; rsv[q] = rstd[row]; rav[q] = rowsa[row]; rbv[q] = rowsb[row]; }
#pragma unroll
        for (int p = 0; p < 4; ++p) {
            u32x4 awv[2], swv[2];
#pragma unroll
            for (int m2 = 0; m2 < 2; ++m2) { const int q = p * 2 + m2; const size_t off = (size_t)(row0 + (q >> 2) * 128 + (q & 3) * 16) * DM + col0; awv[m2] = *(const u32x4*)(ATT + off); swv[m2] = *(const u32x4*)(SSM + off); }
            asm volatile("" : "+v"(awv[0]), "+v"(awv[1]), "+v"(swv[0]), "+v"(swv[1]));
#pragma unroll
            for (int m2 = 0; m2 < 2; ++m2) { const int q = p * 2 + m2, ai = q >> 2, m = q & 3; const int row = row0 + ai * 128 + m * 16; const size_t off = (size_t)row * DM + col0;
                const u32x4 aw = awv[m2], sw = swv[m2];
                const float rs = rsv[q], ra = __builtin_amdgcn_rsqf(rav[q] * (1.0f / DM) + EPS), rb = __builtin_amdgcn_rsqf(rbv[q] * (1.0f / DM) + EPS);
                const float av[8] = {bf_lo(aw.x), bf_hi(aw.x), bf_lo(aw.y), bf_hi(aw.y), bf_lo(aw.z), bf_hi(aw.z), bf_lo(aw.w), bf_hi(aw.w)};
                const float sv[8] = {bf_lo(sw.x), bf_hi(sw.x), bf_lo(sw.y), bf_hi(sw.y), bf_lo(sw.z), bf_hi(sw.z), bf_lo(sw.w), bf_hi(sw.w)};
                float o[8];
#pragma unroll
                for (int n = 0; n < 2; ++n)
#pragma unroll
                    for (int e = 0; e < 4; ++e) { const float wl = n ? wa1[e] : wa0[e], vl = n ? ws1[e] : ws0[e];
                        o[n * 4 + e] = fast_sigmoid(acc[ai][0][m][n][e] * rs) * av[n * 4 + e] * (ra * wl) + fast_sigmoid(acc[ai][1][m][n][e] * rs) * sv[n * 4 + e] * (rb * vl); }
                u32x4 w; w.x = cvt_pk(o[0], o[1]); w.y = cvt_pk(o[2], o[3]); w.z = cvt_pk(o[4], o[5]); w.w = cvt_pk(o[6], o[7]);
                *(u32x4*)(MG + off) = w; }
        }
    }
};
struct EpiGlu {
    static constexpr bool PERM = true, AFTER_DRAIN = false;
    bf16* O; int ldc; float* rowsb;
    __device__ __forceinline__ void operator()(const pg8::f32x4 (&acc)[2][2][4][2], const pg8::Unit& u, int wr, int wc, int fr, int fq) const {
        const int row0 = u.pm * 256 + wr * 64 + fr, col0 = u.pn * 128 + wc * 32 + 8 * fq;
#pragma unroll
        for (int ai = 0; ai < 2; ++ai)
#pragma unroll
            for (int m = 0; m < 4; ++m) { const int row = row0 + ai * 128 + m * 16; float o[8]; float ss = 0.f;
#pragma unroll
                for (int n = 0; n < 2; ++n)
#pragma unroll
                    for (int e = 0; e < 4; ++e) { const float v = acc[ai][0][m][n][e] * fast_sigmoid(acc[ai][1][m][n][e]); o[n * 4 + e] = v; ss += v * v; }
                u32x4 w; w.x = cvt_pk(o[0], o[1]); w.y = cvt_pk(o[2], o[3]); w.z = cvt_pk(o[4], o[5]); w.w = cvt_pk(o[6], o[7]);
                *(u32x4*)(O + (size_t)row * ldc + col0) = w;
                ss += __shfl_xor(ss, 16); ss += __shfl_xor(ss, 32);
                if (fq == 0) atomicAdd(rowsb + row, ss); }
    }
};
struct EpiSwiglu {
    static constexpr bool PERM = true, AFTER_DRAIN = false;
    bf16* O; int ldc; const float* rowss;
    __device__ __forceinline__ void operator()(const pg8::f32x4 (&acc)[2][2][4][2], const pg8::Unit& u, int wr, int wc, int fr, int fq) const {
        const int row0 = u.pm * 256 + wr * 64 + fr, col0 = u.pn * 128 + wc * 32 + 8 * fq;
        float rsv[8];
#pragma unroll
        for (int q = 0; q < 8; ++q) rsv[q] = rowss[row0 + (q >> 2) * 128 + (q & 3) * 16];
        asm volatile("" : "+v"(rsv[0]), "+v"(rsv[1]), "+v"(rsv[2]), "+v"(rsv[3]), "+v"(rsv[4]), "+v"(rsv[5]), "+v"(rsv[6]), "+v"(rsv[7]));
#pragma unroll
        for (int ai = 0; ai < 2; ++ai)
#pragma unroll
            for (int m = 0; m < 4; ++m) { const int row = row0 + ai * 128 + m * 16; const float rs = __builtin_amdgcn_rsqf(rsv[ai * 4 + m] * (1.0f / DM) + EPS); float o[8];
#pragma unroll
                for (int n = 0; n < 2; ++n)
#pragma unroll
                    for (int e = 0; e < 4; ++e) { const float g = acc[ai][0][m][n][e] * rs, up = acc[ai][1][m][n][e] * rs; o[n * 4 + e] = g * fast_sigmoid(g) * up; }
                u32x4 w; w.x = cvt_pk(o[0], o[1]); w.y = cvt_pk(o[2], o[3]); w.z = cvt_pk(o[4], o[5]); w.w = cvt_pk(o[6], o[7]);
                *(u32x4*)(O + (size_t)row * ldc + col0) = w; }
    }
};
struct EpiResid1 {
    static constexpr bool PERM = true, AFTER_DRAIN = false;
    const bf16* XBp; bf16* HF; float* rowss;
    __device__ __forceinline__ void operator()(const pg8::f32x4 (&acc)[2][2][4][2], const pg8::Unit& u, int wr, int wc, int fr, int fq) const {
        const int row0 = u.pm * 256 + wr * 64 + fr, col0 = u.pn * 256 + wc * 32 + 8 * fq;
#pragma unroll
        for (int ai = 0; ai < 2; ++ai) {
            u32x4 xwv[4][2];
#pragma unroll
            for (int m = 0; m < 4; ++m)
#pragma unroll
                for (int bj = 0; bj < 2; ++bj) xwv[m][bj] = *(const u32x4*)(XBp + (size_t)(row0 + ai * 128 + m * 16) * DM + col0 + bj * 128);
            asm volatile("" : "+v"(xwv[0][0]), "+v"(xwv[0][1]), "+v"(xwv[1][0]), "+v"(xwv[1][1]), "+v"(xwv[2][0]), "+v"(xwv[2][1]), "+v"(xwv[3][0]), "+v"(xwv[3][1]));
#pragma unroll
            for (int m = 0; m < 4; ++m) { const int row = row0 + ai * 128 + m * 16; float ss = 0.f;
#pragma unroll
                for (int bj = 0; bj < 2; ++bj) { const size_t off = (size_t)row * DM + col0 + bj * 128;
                    const u32x4 xw = xwv[m][bj];
                    const pg8::f32x4 h0 = (pg8::f32x4){bf_lo(xw.x), bf_hi(xw.x), bf_lo(xw.y), bf_hi(xw.y)} + acc[ai][bj][m][0], h1 = (pg8::f32x4){bf_lo(xw.z), bf_hi(xw.z), bf_lo(xw.w), bf_hi(xw.w)} + acc[ai][bj][m][1];
                    ss += (h0[0] * h0[0] + h0[1] * h0[1]) + (h0[2] * h0[2] + h0[3] * h0[3]) + (h1[0] * h1[0] + h1[1] * h1[1]) + (h1[2] * h1[2] + h1[3] * h1[3]);
                    u32x4 l; l.x = pk_f16(h0[0], h0[1]); l.y = pk_f16(h0[2], h0[3]); l.z = pk_f16(h1[0], h1[1]); l.w = pk_f16(h1[2], h1[3]);
                    *(u32x4*)(HF + off) = l; }
                ss += __shfl_xor(ss, 16); ss += __shfl_xor(ss, 32);
                if (fq == 0) atomicAdd(rowss + row, ss); }
        }
    }
};
struct EpiResid2 {
    static constexpr bool PERM = true, AFTER_DRAIN = false;
    const bf16* HF; float* out;
    __device__ __forceinline__ void operator()(const pg8::f32x4 (&acc)[2][2][4][2], const pg8::Unit& u, int wr, int wc, int fr, int fq) const {
        const int row0 = u.pm * 256 + wr * 64 + fr, col0 = u.pn * 256 + wc * 32 + 8 * fq;
#pragma unroll
        for (int ai = 0; ai < 2; ++ai) {
            u32x4 hv[4][2];
#pragma unroll
            for (int m = 0; m < 4; ++m)
#pragma unroll
                for (int bj = 0; bj < 2; ++bj) hv[m][bj] = *(const u32x4*)(HF + (size_t)(row0 + ai * 128 + m * 16) * DM + col0 + bj * 128);
            asm volatile("" : "+v"(hv[0][0]), "+v"(hv[0][1]), "+v"(hv[1][0]), "+v"(hv[1][1]), "+v"(hv[2][0]), "+v"(hv[2][1]), "+v"(hv[3][0]), "+v"(hv[3][1]));
#pragma unroll
            for (int m = 0; m < 4; ++m) { const int row = row0 + ai * 128 + m * 16;
#pragma unroll
                for (int bj = 0; bj < 2; ++bj) { const size_t off = (size_t)row * DM + col0 + bj * 128; const u32x4 h = hv[m][bj];
                    *(pg8::f32x4*)(out + off) = (pg8::f32x4){f16_lo(h.x), f16_hi(h.x), f16_lo(h.y), f16_hi(h.y)} + acc[ai][bj][m][0];
                    *(pg8::f32x4*)(out + off + 4) = (pg8::f32x4){f16_lo(h.z), f16_hi(h.z), f16_lo(h.w), f16_hi(h.w)} + acc[ai][bj][m][1]; } }
        }
    }
};

constexpr int TP = 65, T_SCR_BYTES = 64 * TP * 4;
__device__ __forceinline__ void transpose_item(const float* W, int ldw, const float* gk, int K, int N, bf16* WT, bool glu, LAS float* scr, int item, int lane, bool f16 = false) {
    const int nblk = N / 64, kb = item / nblk, nb = item % nblk, k0 = 64 * kb, n0 = 64 * nb;
    const int kq = lane >> 4, n4 = (lane & 15) * 4;
    f32x4 v[16];
#pragma unroll
    for (int i = 0; i < 16; ++i) v[i] = __builtin_nontemporal_load((const f32x4*)(W + (size_t)(k0 + 4 * i + kq) * ldw + n0 + n4));
#pragma unroll
    for (int i = 0; i < 16; ++i) { LAS float* d = scr + (4 * i + kq) * TP + n4; d[0] = v[i].x; d[1] = v[i].y; d[2] = v[i].z; d[3] = v[i].w; }
    LDS_WAIT(); asm volatile("" ::: "memory");
    int d0 = n0; if (glu) { const int half = N / 2, bj = n0 / half, j = n0 % half; d0 = 256 * (j / 128) + 128 * bj + (j % 128); }
    const int c = lane & 7;
    float g[8];
#pragma unroll
    for (int e2 = 0; e2 < 8; ++e2) g[e2] = gk ? gk[k0 + 8 * c + e2] : 1.0f;
#pragma unroll
    for (int j = 0; j < 8; ++j) { const int n = (lane >> 3) + 8 * j; const LAS float* s = scr + (8 * c) * TP + n;
        u32x4 o;
        if (f16) { o.x = pk_f16(s[0 * TP] * g[0], s[1 * TP] * g[1]); o.y = pk_f16(s[2 * TP] * g[2], s[3 * TP] * g[3]); o.z = pk_f16(s[4 * TP] * g[4], s[5 * TP] * g[5]); o.w = pk_f16(s[6 * TP] * g[6], s[7 * TP] * g[7]); }
        else { o.x = cvt_pk(s[0 * TP] * g[0], s[1 * TP] * g[1]); o.y = cvt_pk(s[2 * TP] * g[2], s[3 * TP] * g[3]); o.z = cvt_pk(s[4 * TP] * g[4], s[5 * TP] * g[5]); o.w = cvt_pk(s[6 * TP] * g[6], s[7 * TP] * g[7]); }
        *(u32x4*)(WT + (size_t)(d0 + n) * K + k0 + 8 * c) = o; }
    LDS_WAIT(); asm volatile("" ::: "memory");
}

__device__ __forceinline__ void sincos_small(float x, float& s, float& c) {
    const float n = rintf(x * 0.6366197723675814f);
    float r = fmaf(-n, 1.5703125f, x); r = fmaf(-n, 4.837512969970703125e-4f, r); r = fmaf(-n, 7.54978995489188216e-8f, r);
    const float z = r * r;
    const float sp = r + r * z * (-1.6666654611e-1f + z * (8.3321608736e-3f + z * -1.9515295891e-4f));
    const float cp = 1.0f - 0.5f * z + z * z * (4.166664568298827e-2f + z * (-1.388731625493765e-3f + z * 2.443315711809948e-5f));
    const int q = ((int)n) & 3;
    const float ss = (q & 1) ? cp : sp, cc = (q & 1) ? sp : cp;
    s = (q & 2) ? -ss : ss; c = ((q + 1) & 2) ? -cc : cc;
}

struct Args { const float* in[22]; float* out; unsigned char* ws; long long never; };

__device__ __forceinline__ void p0_prologue(const Args& a, LAS unsigned char* lds, int wave, int lane) {
    unsigned char* ws = a.ws;
    LAS float* scr = (LAS float*)(lds + wave * 16896);
    const int gw = blockIdx.x * NWAVES + wave, NGW = gridDim.x * NWAVES;
    constexpr int I1 = (DM / 64) * (NQKVU / 64), IG = (DM / 64) * (2048 / 64), I2 = (DM / 64) * (2048 / 64), I3 = (DM / 64) * (DM / 64), I4 = (DM / 64) * (2 * DFF / 64), I5 = (DFF / 64) * (DM / 64);
    static_assert(T_SCR_BYTES <= 16896 && 8 * 16896 <= LDS_BYTES - 1024, "transpose scratch");
    constexpr int NITEMS = I1 + IG + I2 + I3 + I4 + I5;
    for (int it = gw; it < NITEMS; it += NGW) {
        int r = it;
        if (r < I1) { transpose_item(a.in[3], INC, a.in[2], DM, NQKVU, (bf16*)(ws + WS_W1), false, scr, r, lane); continue; } r -= I1;
        if (r < IG) { transpose_item(a.in[3] + NQKVU, INC, a.in[2], DM, 2048, (bf16*)(ws + WS_WG), true, scr, r, lane); continue; } r -= IG;
        if (r < I2) { transpose_item(a.in[15], 2048, nullptr, DM, 2048, (bf16*)(ws + WS_W2), true, scr, r, lane); continue; } r -= I2;
        if (r < I3) { transpose_item(a.in[18], DM, nullptr, DM, DM, (bf16*)(ws + WS_W3), false, scr, r, lane); continue; } r -= I3;
        if (r < I4) { transpose_item(a.in[20], 2 * DFF, a.in[19], DM, 2 * DFF, (bf16*)(ws + WS_W4), true, scr, r, lane, true); continue; } r -= I4;
        transpose_item(a.in[21], DM, nullptr, DFF, DM, (bf16*)(ws + WS_W5), false, scr, r, lane);
    }
    bf16* XB = (bf16*)(ws + WS_XB); float* rstdx = (float*)(ws + WS_RSTDX);
    for (int m0 = gw; m0 < NTOK + 16; m0 += 2 * NGW) {
        const int m1 = m0 + NGW; const bool has1 = m1 < NTOK + 16; const int m1c = has1 ? m1 : m0;
        const float* src0 = m0 < NTOK ? a.in[0] + (size_t)m0 * DM : a.in[1] + (size_t)(m0 - NTOK) * DM;
        const float* src1 = m1c < NTOK ? a.in[0] + (size_t)m1c * DM : a.in[1] + (size_t)(m1c - NTOK) * DM;
        f32x4 v0[4], v1[4]; float s0 = 0.f, s1 = 0.f;
#pragma unroll
        for (int j = 0; j < 4; ++j) { v0[j] = __builtin_nontemporal_load((const f32x4*)src0 + lane + 64 * j); v1[j] = __builtin_nontemporal_load((const f32x4*)src1 + lane + 64 * j); }
#pragma unroll
        for (int j = 0; j < 4; ++j) { s0 += (v0[j].x * v0[j].x + v0[j].y * v0[j].y) + (v0[j].z * v0[j].z + v0[j].w * v0[j].w); s1 += (v1[j].x * v1[j].x + v1[j].y * v1[j].y) + (v1[j].z * v1[j].z + v1[j].w * v1[j].w); }
        u32x2* o0 = (u32x2*)(XB + (size_t)m0 * DM) + lane; u32x2* o1 = (u32x2*)(XB + (size_t)m1c * DM) + lane;
#pragma unroll
        for (int j = 0; j < 4; ++j) { u32x2 w; w.x = cvt_pk(v0[j].x, v0[j].y); w.y = cvt_pk(v0[j].z, v0[j].w); o0[64 * j] = w; }
        if (has1) {
#pragma unroll
            for (int j = 0; j < 4; ++j) { u32x2 w; w.x = cvt_pk(v1[j].x, v1[j].y); w.y = cvt_pk(v1[j].z, v1[j].w); o1[64 * j] = w; } }
        s0 = wave_sum(s0); s1 = wave_sum(s1);
        if (lane == 0) { rstdx[m0] = __builtin_amdgcn_rsqf(s0 * (1.0f / DM) + EPS); if (has1) rstdx[m1] = __builtin_amdgcn_rsqf(s1 * (1.0f / DM) + EPS); }
    }
    const int gt = blockIdx.x * NTHREADS + threadIdx.x, NGT = gridDim.x * NTHREADS;
    float* rowss = (float*)(ws + WS_ROWSS);
    float* rowsa = (float*)(ws + WS_ROWSA); float* rowsb = (float*)(ws + WS_ROWSB);
    for (int i = gt; i < NTOK; i += NGT) { rowss[i] = 0.f; rowsa[i] = 0.f; rowsb[i] = 0.f; }
    if (gt < NGRP * NST) {
        const int g = gt >> 6, p = gt & 63;
        const float dt = expf(a.in[9][g]), lr = a.in[7][gt], li = a.in[8][gt];
        const float mag = expf(lr * dt); float sn, cs; sincos_small(li * dt, sn, cs);
        const float ar = mag * cs, ai = mag * sn, den = lr * lr + li * li, nr = ar - 1.0f, ni = ai;
        const float fr = (nr * lr + ni * li) / den, fi = (ni * lr - nr * li) / den;
        ((f32x2*)(ws + WS_ATAB))[gt] = (f32x2){ar, ai};
        float pr = ar, pi = ai;
#pragma unroll
        for (int i = 0; i < 8; ++i) { const float tr = pr * pr - pi * pi, ti = 2.0f * pr * pi; pr = tr; pi = ti; }
        ((f32x2*)(ws + WS_ATAB2))[gt] = (f32x2){pr, pi};
        bf16* BB = (bf16*)(ws + WS_BB); bf16* CM = (bf16*)(ws + WS_CM);
        const int rre = g * 128 + (p >> 5) * 64 + (p & 31), rim = rre + 32;
        const float* bre = a.in[10] + (size_t)gt * 16; const float* bim = a.in[11] + (size_t)gt * 16;
#pragma unroll
        for (int c = 0; c < 16; c += 2) {
            const float br0 = bre[c], bi0 = bim[c], br1 = bre[c + 1], bi1 = bim[c + 1];
            *(unsigned*)(BB + (size_t)rre * 16 + c) = cvt_pk(fr * br0 - fi * bi0, fr * br1 - fi * bi1);
            *(unsigned*)(BB + (size_t)rim * 16 + c) = cvt_pk(fr * bi0 + fi * br0, fr * bi1 + fi * br1);
        }
#pragma unroll
        for (int c = 0; c < 16; ++c) {
            const float cr = a.in[12][((size_t)g * 16 + c) * 64 + p], ci = a.in[13][((size_t)g * 16 + c) * 64 + p];
            *(unsigned*)(CM + ((size_t)g * 16 + c) * 128 + 2 * p) = cvt_pk(cr, -ci);
        }
    }
}

constexpr int KP = 144, VP = 840, NKEY = 416;
constexpr int ATT_K_OFF = 0, ATT_V_OFF = NKEY * KP;
static_assert(ATT_V_OFF + 64 * VP <= 131072, "attention LDS");
__device__ __forceinline__ int crow(int r, int hi) { return (r & 3) + 8 * (r >> 2) + 4 * hi; }

__device__ __forceinline__ void attn_item(const Args& a, LAS unsigned char* lds, int item, int wave, int lane) {
    unsigned char* ws = a.ws;
    const bf16* QB = (const bf16*)(ws + WS_Q); const bf16* KB = (const bf16*)(ws + WS_K); const bf16* VB = (const bf16*)(ws + WS_V); bf16* ATT = (bf16*)(ws + WS_ATT);
    const int blk0 = (item & 31) * 2, kvh = (item >> 5) & 3, b = item >> 7;
    const int tid = threadIdx.x;
    const float* knw = a.in[5];
    for (int idx = tid; idx < NKEY * 8; idx += NTHREADS) {
        const int key = idx >> 3, ck = idx & 7; int row = -1;
        if (key < 16) row = META_ROW + key;
        else if (key < 32) row = -1;
        else if (key < 160) row = blk0 > 0 ? b * SEQ + (blk0 - 1) * 128 + (key - 32) : -1;
        else row = b * SEQ + blk0 * 128 + (key - 160);
        u32x4 kw = (u32x4){0u, 0u, 0u, 0u}, vw = (u32x4){0u, 0u, 0u, 0u};
        if (row >= 0) { kw = *(const u32x4*)(KB + (size_t)row * KVW + kvh * 64 + ck * 8); vw = *(const u32x4*)(VB + (size_t)row * KVW + kvh * 64 + ck * 8); }
        float kf[8] = {bf_lo(kw.x), bf_hi(kw.x), bf_lo(kw.y), bf_hi(kw.y), bf_lo(kw.z), bf_hi(kw.z), bf_lo(kw.w), bf_hi(kw.w)};
        float ss = 0.f;
#pragma unroll
        for (int e = 0; e < 8; ++e) ss += kf[e] * kf[e];
        ss += __shfl_xor(ss, 1); ss += __shfl_xor(ss, 2); ss += __shfl_xor(ss, 4);
        const float rs = __builtin_amdgcn_rsqf(ss * (1.0f / 64.0f) + EPS);
        const f32x4 g0 = *(const f32x4*)(knw + ck * 8), g1 = *(const f32x4*)(knw + ck * 8 + 4);
        u32x4 o; o.x = cvt_pk(kf[0] * rs * g0.x, kf[1] * rs * g0.y); o.y = cvt_pk(kf[2] * rs * g0.z, kf[3] * rs * g0.w);
        o.z = cvt_pk(kf[4] * rs * g1.x, kf[5] * rs * g1.y); o.w = cvt_pk(kf[6] * rs * g1.z, kf[7] * rs * g1.w);
        *(LAS u32x4*)(lds + ATT_K_OFF + key * KP + ck * 16) = o;
        LAS unsigned short* vt = (LAS unsigned short*)(lds + ATT_V_OFF + (ck * 8) * VP + key * 2);
        const unsigned vv[4] = {vw.x, vw.y, vw.z, vw.w};
#pragma unroll
        for (int e = 0; e < 4; ++e) { vt[(2 * e) * (VP / 2)] = (unsigned short)(vv[e] & 0xffffu); vt[(2 * e + 1) * (VP / 2)] = (unsigned short)(vv[e] >> 16); }
    }
    __syncthreads();
    const int r = wave >> 1, qh = wave & 1, hq = kvh * 4 + r, ql = lane & 31, hi = lane >> 5;
    const float sink = a.in[6][hq];
    const float* qnw = a.in[4];
    const float L2E = 1.4426950408889634f;
    for (int q4 = 0; q4 < 4; ++q4) {
        const int bl = q4 >> 1, qb = q4 & 1, blk = blk0 + bl;
        const int qblk = 2 * qh + qb;
        const size_t qrow = (size_t)b * SEQ + blk * 128 + qblk * 32 + ql;
        bf16x8 qf[4];
        {
            u32x4 qw[4]; float ss = 0.f;
#pragma unroll
            for (int ks = 0; ks < 4; ++ks) { qw[ks] = __builtin_nontemporal_load((const u32x4*)(QB + qrow * DM + hq * 64 + 16 * ks + 8 * hi));
                const unsigned ww[4] = {qw[ks].x, qw[ks].y, qw[ks].z, qw[ks].w};
#pragma unroll
                for (int e = 0; e < 4; ++e) { const float lo = bf_lo(ww[e]), h2 = bf_hi(ww[e]); ss += lo * lo + h2 * h2; } }
            ss += __shfl_xor(ss, 32);
            const float rs = __builtin_amdgcn_rsqf(ss * (1.0f / 64.0f) + EPS) * 0.125f;
#pragma unroll
            for (int ks = 0; ks < 4; ++ks) { const f32x4 g0 = *(const f32x4*)(qnw + 16 * ks + 8 * hi), g1 = *(const f32x4*)(qnw + 16 * ks + 8 * hi + 4);
                u32x4 o; o.x = cvt_pk(bf_lo(qw[ks].x) * rs * g0.x, bf_hi(qw[ks].x) * rs * g0.y); o.y = cvt_pk(bf_lo(qw[ks].y) * rs * g0.z, bf_hi(qw[ks].y) * rs * g0.w);
                o.z = cvt_pk(bf_lo(qw[ks].z) * rs * g1.x, bf_hi(qw[ks].z) * rs * g1.y); o.w = cvt_pk(bf_lo(qw[ks].w) * rs * g1.z, bf_hi(qw[ks].w) * rs * g1.w);
                qf[ks] = __builtin_bit_cast(bf16x8, o); }
        }
        f32x16 S[6];
#pragma unroll
        for (int i = 0; i < 6; ++i) {
            const int kb = (i == 0) ? 0 : 4 * bl + qblk + i;
            f32x16 acc;
#pragma unroll
            for (int e = 0; e < 16; ++e) acc[e] = 0.f;
#pragma unroll
            for (int ks = 0; ks < 4; ++ks) { const bf16x8 kf = *(const LAS bf16x8*)(lds + ATT_K_OFF + (kb * 32 + ql) * KP + (16 * ks + 8 * hi) * 2);
                acc = __builtin_amdgcn_mfma_f32_32x32x16_bf16(kf, qf[ks], acc, 0, 0, 0); }
            S[i] = acc;
        }
        const float NEG = -INFINITY;
#pragma unroll
        for (int e = 0; e < 16; ++e) { const int kr = crow(e, hi);
            if (kr >= 16) S[0][e] = NEG;
            if (!(kr > ql)) S[1][e] = NEG;
            if (!(kr <= ql)) S[5][e] = NEG; }
        if (blk == 0) {
#pragma unroll
            for (int i = 1; i < 6; ++i) if (qblk + i <= 4) {
#pragma unroll
                for (int e = 0; e < 16; ++e) S[i][e] = NEG; }
        }
        float mx = sink;
#pragma unroll
        for (int i = 0; i < 6; ++i)
#pragma unroll
            for (int e = 0; e < 16; ++e) mx = fmaxf(mx, S[i][e]);
        mx = fmaxf(mx, __shfl_xor(mx, 32));
        float den = 0.f; const float mb = mx * L2E;
        bf16x8 pf[6][2];
#pragma unroll
        for (int i = 0; i < 6; ++i) {
            float ev[16];
#pragma unroll
            for (int e = 0; e < 16; ++e) { ev[e] = __builtin_amdgcn_exp2f(S[i][e] * L2E - mb); den += ev[e]; }
#pragma unroll
            for (int h = 0; h < 2; ++h) { u32x4 o; o.x = cvt_pk(ev[8 * h + 0], ev[8 * h + 1]); o.y = cvt_pk(ev[8 * h + 2], ev[8 * h + 3]); o.z = cvt_pk(ev[8 * h + 4], ev[8 * h + 5]); o.w = cvt_pk(ev[8 * h + 6], ev[8 * h + 7]);
                pf[i][h] = __builtin_bit_cast(bf16x8, o); }
        }
        den += __shfl_xor(den, 32);
        den += __builtin_amdgcn_exp2f(sink * L2E - mb);
        const float inv = 1.0f / den; float ssq = 0.f;
#pragma unroll
        for (int db = 0; db < 2; ++db) {
            f32x16 O;
#pragma unroll
            for (int e = 0; e < 16; ++e) O[e] = 0.f;
#pragma unroll
            for (int i = 0; i < 6; ++i) { const int kb = (i == 0) ? 0 : 4 * bl + qblk + i;
#pragma unroll
                for (int h = 0; h < 2; ++h) {
                    const LAS unsigned char* vp = lds + ATT_V_OFF + (db * 32 + ql) * VP + (kb * 32 + 16 * h + 4 * hi) * 2;
                    const u32x2 v0 = *(const LAS u32x2*)vp, v1 = *(const LAS u32x2*)(vp + 16);
                    const u32x4 vv = (u32x4){v0.x, v0.y, v1.x, v1.y};
                    O = __builtin_amdgcn_mfma_f32_32x32x16_bf16(__builtin_bit_cast(bf16x8, vv), pf[i][h], O, 0, 0, 0); } }
#pragma unroll
            for (int g = 0; g < 4; ++g) { const float o0 = O[4 * g] * inv, o1 = O[4 * g + 1] * inv, o2 = O[4 * g + 2] * inv, o3 = O[4 * g + 3] * inv; ssq += (o0 * o0 + o1 * o1) + (o2 * o2 + o3 * o3);
                u32x2 w; w.x = cvt_pk(o0, o1); w.y = cvt_pk(o2, o3);
                *(u32x2*)(ATT + qrow * DM + hq * 64 + db * 32 + 8 * g + 4 * hi) = w; }
        }
        ssq += __shfl_xor(ssq, 32);
        if (hi == 0) atomicAdd((float*)(ws + WS_ROWSA) + qrow, ssq);
    }
    __syncthreads();
}

constexpr int SP = 272;
__device__ __forceinline__ float gelu_tanh(float y) { const float t = y + 0.044715f * y * y * y; return y * __builtin_amdgcn_rcpf(1.0f + __builtin_amdgcn_exp2f(-2.302208198f * t)); }
__device__ __forceinline__ f32x2 pk_fma(f32x2 a, f32x2 b, f32x2 c) { return __builtin_elementwise_fma(a, b, c); }

template <bool FINAL>
__device__ __forceinline__ void ssm_item(const Args& a, LAS unsigned char* lds, int item, int wave, int lane) {
    static_assert(NCHUNK == 32 && CHUNK == 256, "item decode");
    unsigned char* ws = a.ws;
    const bf16* U = (const bf16*)(ws + WS_U); bf16* Z = (bf16*)(ws + WS_Q);
    float* E = (float*)(ws + WS_E);
    const bool meta = (!FINAL) && item >= 256;
    const int oct = item & 7, cp = (item >> 3) & 15, bp = (item >> 7) & 1;
    const int g = oct * 8 + wave, j = lane & 31, hi = lane >> 5;
    const int b0 = bp * 2, c0 = 2 * cp;
    bf16x8 bbf[4];
#pragma unroll
    for (int k = 0; k < 4; ++k) bbf[k] = *(const bf16x8*)((const bf16*)(ws + WS_BB) + ((size_t)g * 128 + k * 32 + j) * 16 + 8 * hi);
    const f32x2 a0 = ((const f32x2*)(ws + WS_ATAB))[g * 64 + j], a1 = ((const f32x2*)(ws + WS_ATAB))[g * 64 + 32 + j];
    const f32x2 a0x = (f32x2){a0.x, a0.x}, a0y = (f32x2){a0.y, a0.y}, na0y = (f32x2){-a0.y, -a0.y}, a1x = (f32x2){a1.x, a1.x}, a1y = (f32x2){a1.y, a1.y}, na1y = (f32x2){-a1.y, -a1.y};
    f32x2 s0r = (f32x2){0.f, 0.f}, s0i = s0r, s1r = s0r, s1i = s0r;
    bf16x8 cmf[4]; f32x4 dsk;
    if (FINAL) {
#pragma unroll
        for (int k = 0; k < 4; ++k) cmf[k] = *(const bf16x8*)((const bf16*)(ws + WS_CM) + ((size_t)g * 16 + (lane & 15)) * 128 + 32 * k + 8 * (lane >> 4));
        dsk = *(const f32x4*)(a.in[14] + g * 16 + 4 * (lane >> 4));
        const f32x2 t0 = ((const f32x2*)(ws + WS_ATAB2))[g * 64 + j], t1 = ((const f32x2*)(ws + WS_ATAB2))[g * 64 + 32 + j];
        const f32x2 m0 = ((const f32x2*)(ws + WS_SMETA))[g * 64 + j], m1 = ((const f32x2*)(ws + WS_SMETA))[g * 64 + 32 + j];
        float c0r = m0.x, c0i = m0.y, c1r = m1.x, c1i = m1.y;
        const f32x2* Eb = (const f32x2*)E + ((size_t)((b0 + hi) * 64 + g) * NCHUNK) * 64;
#pragma unroll
        for (int half = 0; half < 2; ++half) {
            if (half * 16 < c0) {
                f32x2 e0[16], e1[16];
#pragma unroll
                for (int c = 0; c < 16; ++c) { const int cc = half * 16 + c < NCHUNK - 1 ? half * 16 + c : NCHUNK - 2; e0[c] = Eb[cc * 64 + j]; e1[c] = Eb[cc * 64 + 32 + j]; }
#pragma unroll
                for (int c = 0; c < 16; ++c) if (half * 16 + c < c0) {
                    const float n0r = fmaf(t0.x, c0r, fmaf(-t0.y, c0i, e0[c].x)), n0i = fmaf(t0.x, c0i, fmaf(t0.y, c0r, e0[c].y));
                    const float n1r = fmaf(t1.x, c1r, fmaf(-t1.y, c1i, e1[c].x)), n1i = fmaf(t1.x, c1i, fmaf(t1.y, c1r, e1[c].y));
                    c0r = n0r; c0i = n0i; c1r = n1r; c1i = n1i; }
            }
        }
        const f32x2 ec0 = Eb[c0 * 64 + j], ec1 = Eb[c0 * 64 + 32 + j];
        s0r = (f32x2){c0r, fmaf(t0.x, c0r, fmaf(-t0.y, c0i, ec0.x))}; s0i = (f32x2){c0i, fmaf(t0.x, c0i, fmaf(t0.y, c0r, ec0.y))};
        s1r = (f32x2){c1r, fmaf(t1.x, c1r, fmaf(-t1.y, c1i, ec1.x))}; s1i = (f32x2){c1i, fmaf(t1.x, c1i, fmaf(t1.y, c1r, ec1.y))};
    }
    const int bsel = (j >> 2) & 1, csel = j & 1, tt = ((j & 3) >> 1) + 2 * (j >> 3);
    const size_t urow0 = meta ? (size_t)META_ROW + tt : (size_t)(b0 + bsel) * SEQ + (size_t)(c0 + csel) * CHUNK + tt;
    const bf16* up = U + urow0 * DM + g * 16 + 8 * hi;
    LAS unsigned char* sl = lds + wave * (32 * SP);
    const int nsteps = meta ? 2 : CHUNK / 8;
    const size_t erow = (size_t)b0 * SEQ + (size_t)(c0 + ((lane & 15) >> 3)) * CHUNK + (lane & 7);
    const bf16* ue = U + erow * DM + g * 16 + 4 * (lane >> 4);
    bf16* ze = Z + erow * DM + g * 16 + 4 * (lane >> 4);
    bf16x8 uf = *(const bf16x8*)up;
    u32x2 uu0 = (u32x2){0u, 0u}, uu1 = (u32x2){0u, 0u};
    if (FINAL) { uu0 = *(const u32x2*)ue; uu1 = *(const u32x2*)(ue + (size_t)SEQ * DM); }
    for (int st = 0; st < nsteps; ++st) {
        bf16x8 ufn = uf; u32x2 un0 = uu0, un1 = uu1;
        if (st + 1 < nsteps) { ufn = *(const bf16x8*)(up + (size_t)(st + 1) * 8 * DM);
            if (FINAL) { un0 = *(const u32x2*)(ue + (size_t)(st + 1) * 8 * DM); un1 = *(const u32x2*)(ue + (size_t)(st + 1) * 8 * DM + (size_t)SEQ * DM); } }
        f32x16 X[4];
#pragma unroll
        for (int k = 0; k < 4; ++k) { f32x16 z;
#pragma unroll
            for (int e = 0; e < 16; ++e) z[e] = 0.f;
            X[k] = __builtin_amdgcn_mfma_f32_32x32x16_bf16(uf, bbf[k], z, 0, 0, 0); }
#pragma unroll
        for (int t = 0; t < 8; ++t) {
            const f32x2 x0r = (f32x2){X[0][2 * t], X[0][2 * t + 1]}, x0i = (f32x2){X[1][2 * t], X[1][2 * t + 1]}, x1r = (f32x2){X[2][2 * t], X[2][2 * t + 1]}, x1i = (f32x2){X[3][2 * t], X[3][2 * t + 1]};
            const f32x2 n0r = pk_fma(a0x, s0r, pk_fma(na0y, s0i, x0r)), n0i = pk_fma(a0x, s0i, pk_fma(a0y, s0r, x0i));
            const f32x2 n1r = pk_fma(a1x, s1r, pk_fma(na1y, s1i, x1r)), n1i = pk_fma(a1x, s1i, pk_fma(a1y, s1r, x1i));
            s0r = n0r; s0i = n0i; s1r = n1r; s1i = n1i;
            if (FINAL) {
                LAS unsigned char* r0 = sl + ((hi * 2 + 0) * 8 + t) * SP; LAS unsigned char* r1 = sl + ((hi * 2 + 1) * 8 + t) * SP;
                *(LAS unsigned*)(r0 + j * 4) = cvt_pk(n0r.x, n0i.x); *(LAS unsigned*)(r0 + (32 + j) * 4) = cvt_pk(n1r.x, n1i.x);
                *(LAS unsigned*)(r1 + j * 4) = cvt_pk(n0r.y, n0i.y); *(LAS unsigned*)(r1 + (32 + j) * 4) = cvt_pk(n1r.y, n1i.y); }
        }
        if (FINAL) {
            LDS_WAIT(); asm volatile("" ::: "memory");
#pragma unroll
            for (int bh = 0; bh < 2; ++bh) {
                f32x4 Y = (f32x4){0.f, 0.f, 0.f, 0.f};
#pragma unroll
                for (int k = 0; k < 4; ++k) { const bf16x8 sf = *(const LAS bf16x8*)(sl + (bh * 16 + (lane & 15)) * SP + (32 * k + 8 * (lane >> 4)) * 2);
                    Y = __builtin_amdgcn_mfma_f32_16x16x32_bf16(cmf[k], sf, Y, 0, 0, 0); }
                const u32x2 uu = bh ? uu1 : uu0;
                const float y0 = Y[0] + dsk.x * bf_lo(uu.x), y1 = Y[1] + dsk.y * bf_hi(uu.x), y2 = Y[2] + dsk.z * bf_lo(uu.y), y3 = Y[3] + dsk.w * bf_hi(uu.y);
                u32x2 w; w.x = cvt_pk(gelu_tanh(y0), gelu_tanh(y1)); w.y = cvt_pk(gelu_tanh(y2), gelu_tanh(y3));
                *(u32x2*)(ze + (size_t)st * 8 * DM + (size_t)bh * SEQ * DM) = w;
            }
            LDS_WAIT(); asm volatile("" ::: "memory");
        }
        uf = ufn; uu0 = un0; uu1 = un1;
    }
    if (!FINAL) {
        if (meta) { if (hi == 0) { ((f32x2*)(ws + WS_SMETA))[g * 64 + j] = (f32x2){s0r.x, s0i.x}; ((f32x2*)(ws + WS_SMETA))[g * 64 + 32 + j] = (f32x2){s1r.x, s1i.x}; } }
        else { f32x2* Eb = (f32x2*)E + ((size_t)((b0 + hi) * 64 + g) * NCHUNK + c0) * 64;
            Eb[j] = (f32x2){s0r.x, s0i.x}; Eb[32 + j] = (f32x2){s1r.x, s1i.x}; Eb[64 + j] = (f32x2){s0r.y, s0i.y}; Eb[64 + 32 + j] = (f32x2){s1r.y, s1i.y}; }
    }
}

#define XB_TMO      128
#define XB_XCNT(j)  (256  + 64 * (j))
#define XB_XSUB(j)  (1280 + 64 * (j))
#define XB_XGEN(j)  (2304 + 64 * (j))
#define XB_TOP      3328
#define XB_TOPGEN   3392
#define XCD_BAR_WORDS 3456
#define XB_SPIN_CAP (1u << 18)

__device__ __forceinline__ unsigned xb_ld(unsigned* p)              { return __hip_atomic_load(p, __ATOMIC_RELAXED, __HIP_MEMORY_SCOPE_AGENT); }
__device__ __forceinline__ unsigned xb_add(unsigned* p, unsigned v) { return __hip_atomic_fetch_add(p, v, __ATOMIC_RELAXED, __HIP_MEMORY_SCOPE_AGENT); }
__device__ __forceinline__ unsigned xb_xcc_id() { return (unsigned)__builtin_amdgcn_s_getreg((3 << 11) | 20) & 0xFu; }
#define XB_SPIN(cond, bar) do { unsigned _sp = 0; while (cond) { __builtin_amdgcn_s_sleep(1); \
    if ((++_sp & 255u) == 0u) { if (xb_ld(&(bar)[XB_TMO])) break; if (_sp > XB_SPIN_CAP) { atomicAdd(&(bar)[XB_TMO], 1u); break; } } } } while (0)

struct XcdBarrier {
    unsigned* bar; unsigned x;
    volatile LAS unsigned* st;
};

__device__ __forceinline__ XcdBarrier xcd_barrier_post(unsigned* bar, volatile LAS unsigned* st) {
    XcdBarrier b; b.bar = bar; b.x = xb_xcc_id(); b.st = st;
    if (threadIdx.x == 0) (void)xb_add(&bar[XB_XCNT(b.x)], 1u);
    return b;
}
__device__ __forceinline__ void xcd_barrier_complete(unsigned* bar, unsigned x, unsigned& nloc, unsigned& nx) {
    const unsigned G = gridDim.x * gridDim.y * gridDim.z;
    unsigned sum, cnt, mine, sp = 0u;
    for (;;) {
        sum = 0u; cnt = 0u; mine = 0u;
#pragma unroll
        for (unsigned j = 0; j < 16; ++j) { const unsigned c = xb_ld(&bar[XB_XCNT(j)]); sum += c; cnt += (c > 0u) ? 1u : 0u; mine = (j == x) ? c : mine; }
        if (sum == G) break;
        __builtin_amdgcn_s_sleep(1);
        if ((++sp & 255u) == 0u) { if (xb_ld(&bar[XB_TMO])) break; if (sp > XB_SPIN_CAP) { atomicAdd(&bar[XB_TMO], 1u); break; } }
    }
    nloc = mine > 0u ? mine : 1u; nx = cnt > 0u ? cnt : 1u;
}

__device__ __forceinline__ void xcd_barrier(const XcdBarrier& b) {
    asm volatile("s_waitcnt vmcnt(0)" ::: "memory");
    __syncthreads();
    if (threadIdx.x == 0) {
        unsigned* bar = b.bar;
        __builtin_amdgcn_s_waitcnt(0);
        unsigned nloc = b.st[0], nx = b.st[1];
        if (nloc == 0u) { xcd_barrier_complete(bar, b.x, nloc, nx); b.st[0] = nloc; b.st[1] = nx; }
        const unsigned old = xb_add(&bar[XB_XSUB(b.x)], 1u);
        const unsigned gen = old / nloc;
        if (old + 1u == (gen + 1u) * nloc) {
            __builtin_amdgcn_fence(__ATOMIC_RELEASE, "agent");
            asm volatile("s_waitcnt vmcnt(0)" ::: "memory");
            const unsigned og = xb_add(&bar[XB_TOP], 1u);
            const unsigned tg = og / nx;
            if (og + 1u == (tg + 1u) * nx) xb_add(&bar[XB_TOPGEN], 1u);
            else XB_SPIN(xb_ld(&bar[XB_TOPGEN]) == tg, bar);
            __builtin_amdgcn_fence(__ATOMIC_ACQUIRE, "agent");
            xb_add(&bar[XB_XGEN(b.x)], 1u);
            asm volatile("s_waitcnt vmcnt(0)" ::: "memory");
        } else {
            XB_SPIN(xb_ld(&bar[XB_XGEN(b.x)]) == gen, bar);
            __builtin_amdgcn_fence(__ATOMIC_ACQUIRE, "agent");
            asm volatile("s_waitcnt vmcnt(0)" ::: "memory");
        }
    }
    __syncthreads();
}

__device__ __forceinline__ void meta_proj(const Args& a, int wave, int lane) {
    unsigned char* ws = a.ws;
    const bf16* XB = (const bf16*)(ws + WS_XB); const bf16* W1t = (const bf16*)(ws + WS_W1); const float* rstdx = (const float*)(ws + WS_RSTDX);
    for (int gw = blockIdx.x * NWAVES + wave; gw < 1536; gw += gridDim.x * NWAVES) {
    const int n = 1024 + gw;
    float wf[16];
    { const u32x4 w0 = *(const u32x4*)(W1t + (size_t)n * DM + lane * 8), w1 = *(const u32x4*)(W1t + (size_t)n * DM + 512 + lane * 8);
      const unsigned ww[8] = {w0.x, w0.y, w0.z, w0.w, w1.x, w1.y, w1.z, w1.w};
#pragma unroll
      for (int e = 0; e < 8; ++e) { wf[2 * e] = bf_lo(ww[e]); wf[2 * e + 1] = bf_hi(ww[e]); } }
    float mine = 0.f;
#pragma unroll
    for (int r = 0; r < 16; ++r) {
        const u32x4 x0 = *(const u32x4*)(XB + (size_t)(META_ROW + r) * DM + lane * 8), x1 = *(const u32x4*)(XB + (size_t)(META_ROW + r) * DM + 512 + lane * 8);
        const unsigned xx[8] = {x0.x, x0.y, x0.z, x0.w, x1.x, x1.y, x1.z, x1.w};
        float s = 0.f;
#pragma unroll
        for (int e = 0; e < 8; ++e) s += bf_lo(xx[e]) * wf[2 * e] + bf_hi(xx[e]) * wf[2 * e + 1];
        s = wave_sum(s);
        if (lane == r) mine = s;
    }
    if (lane < 16) {
        const unsigned short o = (unsigned short)(cvt_pk(mine * rstdx[META_ROW + lane], 0.f) & 0xffffu);
        const size_t row = META_ROW + lane;
        if (n < 1280) ((bf16*)(ws + WS_K))[row * KVW + (n - 1024)] = o;
        else if (n < 1536) ((bf16*)(ws + WS_V))[row * KVW + (n - 1280)] = o;
        else ((bf16*)(ws + WS_U))[row * DM + (n - 1536)] = o;
    }
    }
}

constexpr int MISC_OFF = LDS_BYTES - 256;
constexpr size_t WS_BAR = 768 * 1024;
__global__ void __launch_bounds__(NTHREADS, 2) mk_fwd(Args a) {
    extern __shared__ __attribute__((aligned(16))) unsigned char lds_raw[];
    cg::grid_group grid = cg::this_grid();
    LAS unsigned char* lds = (LAS unsigned char*)lds_raw;
    const int tid = threadIdx.x, lane = tid & 63, wave = __builtin_amdgcn_readfirstlane(tid >> 6);
    unsigned char* ws = a.ws;
    const int G = gridDim.x, c = blockIdx.x;
    volatile LAS unsigned* MISC = (volatile LAS unsigned*)(lds + MISC_OFF);
    if (tid < 32) MISC[tid] = 0u;
    __syncthreads();
    unsigned* barw = (unsigned*)(ws + WS_BAR);
    XcdBarrier bar = xcd_barrier_post(barw, MISC + 8);
    if (a.never) grid.sync();

    p0_prologue(a, lds, wave, lane);
    xcd_barrier(bar);
    meta_proj(a, wave, lane);
    { pg8::Gemm g{(const pg8::bf16_t*)(ws + WS_XB), (const pg8::bf16_t*)(ws + WS_W1), NTOK, NQKVU, DM}; pg8::StaticOrder S; S.init(NTOK, NQKVU, G, c);
      EpiProj E{(bf16*)(ws + WS_Q), (bf16*)(ws + WS_K), (bf16*)(ws + WS_V), (bf16*)(ws + WS_U), (const float*)(ws + WS_RSTDX)};
      pg8::gemm_phase<EpiProj, pg8::StaticOrder, true, true>(lds, g, S, E); }
    xcd_barrier(bar);
    for (int it = c; it < 512; it += G) attn_item(a, lds, it, wave, lane);
    for (int it = c; it < 256 + 8; it += G) ssm_item<false>(a, lds, it, wave, lane);
    xcd_barrier(bar);
    for (int it = c; it < 256; it += G) ssm_item<true>(a, lds, it, wave, lane);
    xcd_barrier(bar);
    { pg8::Gemm g{(const pg8::bf16_t*)(ws + WS_Q), (const pg8::bf16_t*)(ws + WS_W2), NTOK, 2048, DM}; pg8::StaticOrder S; S.init(NTOK, 2048, G, c);
      EpiGlu E{(bf16*)(ws + WS_U), DM, (float*)(ws + WS_ROWSB)};
      pg8::gemm_phase<EpiGlu, pg8::StaticOrder, true, true>(lds, g, S, E); }
    xcd_barrier(bar);
    { pg8::Gemm g{(const pg8::bf16_t*)(ws + WS_XB), (const pg8::bf16_t*)(ws + WS_WG), NTOK, 2048, DM}; pg8::StaticOrder S; S.init(NTOK, 2048, G, c);
      EpiMerge E{(const bf16*)(ws + WS_ATT), (const bf16*)(ws + WS_U), (bf16*)(ws + WS_Q), (const float*)(ws + WS_RSTDX), (const float*)(ws + WS_ROWSA), (const float*)(ws + WS_ROWSB), a.in[16], a.in[17]};
      pg8::gemm_phase<EpiMerge, pg8::StaticOrder, true, true>(lds, g, S, E); }
    xcd_barrier(bar);
    { pg8::Gemm g{(const pg8::bf16_t*)(ws + WS_Q), (const pg8::bf16_t*)(ws + WS_W3), NTOK, DM, DM}; pg8::StaticOrder S; S.init(NTOK, DM, G, c);
      EpiResid1 E{(const bf16*)(ws + WS_XB), (bf16*)(ws + WS_ATT), (float*)(ws + WS_ROWSS)};
      pg8::gemm_phase<EpiResid1, pg8::StaticOrder, true, true>(lds, g, S, E); }
    xcd_barrier(bar);
    { pg8::Gemm g{(const pg8::bf16_t*)(ws + WS_ATT), (const pg8::bf16_t*)(ws + WS_W4), NTOK, 2 * DFF, DM}; pg8::StaticOrder S; S.init(NTOK, 2 * DFF, G, c);
      EpiSwiglu E{(bf16*)(ws + WS_ACT), DFF, (const float*)(ws + WS_ROWSS)};
      pg8::gemm_phase<EpiSwiglu, pg8::StaticOrder, true, true, true>(lds, g, S, E); }
    xcd_barrier(bar);
    { pg8::Gemm g{(const pg8::bf16_t*)(ws + WS_ACT), (const pg8::bf16_t*)(ws + WS_W5), NTOK, DM, DFF}; pg8::StaticOrder S; S.init(NTOK, DM, G, c);
      EpiResid2 E{(const bf16*)(ws + WS_ATT), a.out};
      pg8::gemm_phase<EpiResid2, pg8::StaticOrder, true, true>(lds, g, S, E); }
}

extern "C" void kernel_launch(void* const* d_in, const int* in_sizes, int n_in, void* d_out, int out_size, void* d_ws, size_t ws_size, hipStream_t stream) {
    static int grid = 0;
    if (grid == 0) {
        if (n_in != 22 || in_sizes[0] != NTOK * DM || out_size != NTOK * DM || ws_size < WS_END) { fprintf(stderr, "kernel_launch: unexpected shapes (n_in %d, in0 %d, out %d, ws %zu)\n", n_in, n_in > 0 ? in_sizes[0] : -1, out_size, ws_size); grid = -1; return; }
        int dev = 0, cus = 0, per_cu = 0;
        (void)hipGetDevice(&dev); (void)hipDeviceGetAttribute(&cus, hipDeviceAttributeMultiprocessorCount, dev);
        if (hipFuncSetAttribute((const void*)mk_fwd, hipFuncAttributeMaxDynamicSharedMemorySize, LDS_BYTES) != hipSuccess) { fprintf(stderr, "kernel_launch: hipFuncSetAttribute failed\n"); grid = -1; return; }
        if (hipOccupancyMaxActiveBlocksPerMultiprocessor(&per_cu, (const void*)mk_fwd, NTHREADS, LDS_BYTES) != hipSuccess || per_cu < 1) { fprintf(stderr, "kernel_launch: occupancy query says %d; nothing launched\n", per_cu); grid = -1; return; }
        (void)hipGetLastError();
        grid = cus;
    }
    if (grid < 0) return;
    Args a{};
    for (int i = 0; i < 22; ++i) a.in[i] = (const float*)d_in[i];
    a.out = (float*)d_out; a.ws = (unsigned char*)d_ws;
    if (hipMemsetAsync((unsigned char*)d_ws + WS_BAR, 0, XCD_BAR_WORDS * 4, stream) != hipSuccess) { fprintf(stderr, "kernel_launch: memset of the barrier words failed\n"); return; }
    void* args[] = {&a};
    hipError_t e = hipLaunchCooperativeKernel((const void*)mk_fwd, dim3(grid), dim3(NTHREADS), args, LDS_BYTES, stream);
    if (e != hipSuccess) fprintf(stderr, "cooperative launch failed: %s (grid %d)\n", hipGetErrorString(e), grid);
}
```

```cpp
#include <hip/hip_runtime.h>
#include <hip/hip_cooperative_groups.h>
#include <cstdio>
#include <cstdint>
namespace cg = cooperative_groups;
namespace pg8 {
#define PG8_LAS __attribute__((address_space(3)))
typedef unsigned short bf16_t;
typedef short bf16x8 __attribute__((ext_vector_type(8)));
typedef float f32x4 __attribute__((ext_vector_type(4)));
typedef unsigned u32x4 __attribute__((ext_vector_type(4)));
constexpr int BM = 256, BK = 64, HALF = 128, HTB = HALF * BK * 2  , STAGE_BYTES = 8 * HTB, NXCD = 8, WGM = 8;

__host__ __device__ __forceinline__ int lds_byte(int r, int c) { const int st = (r >> 4) * 2 + (c >> 5), rr = r & 15, cc = c & 31, ob = rr * 64 + cc * 2; return st * 1024 + (ob ^ (((ob >> 9) & 1) << 5)); }
__host__ __device__ __forceinline__ void stage_rc(int b, int& R, int& C) { const int st = b / 1024, sb = b % 1024, swz = sb ^ (((sb >> 9) & 1) << 5); R = (st >> 1) * 16 + swz / 64; C = (st & 1) * 32 + (swz % 64) / 2; }
__host__ __device__ __forceinline__ int perm32(int rho) { const int n = rho >> 4, i = rho & 15; return 8 * (i >> 2) + 4 * n + (i & 3); }

struct Unit { int pm, pn; };
struct Gemm { const bf16_t* A; const bf16_t* Bt; int M, N, K; };

struct StaticOrder {
    int nM, nN, nwg, G, c;
    __host__ __device__ void init(int M, int N, int G_, int c_) { nM = M / BM; nN = N / BM; nwg = nM * nN; G = G_; c = c_; }
    __host__ __device__ bool next(int i, Unit& u) const {
        const long L = (long)i * G + c; if (L >= nwg) return false;
        int wgid = (int)L; { const int q = nwg / NXCD, r = nwg % NXCD, xcd = wgid % NXCD, off = wgid / NXCD; wgid = (xcd < r ? xcd * (q + 1) : r * (q + 1) + (xcd - r) * q) + off; }
        const int nig = WGM * nN, gid = wgid / nig, fm = gid * WGM, gsz = (nM - fm) < WGM ? (nM - fm) : WGM;
        u.pm = fm + ((wgid % nig) % gsz); u.pn = (wgid % nig) / gsz; return true;
    }
    __device__ __forceinline__ void a_ready(const Unit&) const {}
    __device__ __forceinline__ void done(const Unit&) const {}
};

__device__ __forceinline__ unsigned cvt_pk_bf16(float lo, float hi) { unsigned r; asm volatile("v_cvt_pk_bf16_f32 %0, %1, %2" : "=v"(r) : "v"(lo), "v"(hi)); return r; }
typedef float f32x2 __attribute__((ext_vector_type(2)));
__device__ __forceinline__ f32x2 gelu_pk(f32x2 v) {
    const f32x2 av = __builtin_elementwise_abs(v), d = av * 0.2316418882f + 1.0f;
    f32x2 t; t.x = __builtin_amdgcn_rcpf(d.x); t.y = __builtin_amdgcn_rcpf(d.y);
    f32x2 q = t * 0.5307027145f + (-0.7265760135f); q = q * t + 0.7107068705f; q = q * t + (-0.142248368f); q = q * t + 0.127414796f; q = q * t;
    const f32x2 s = (v * v) * (-0.72134752044f);
    f32x2 e; e.x = __builtin_amdgcn_exp2f(s.x); e.y = __builtin_amdgcn_exp2f(s.y);
    const f32x2 m = v * (q * e), r = v - m;
    f32x2 o; o.x = v.x < 0.f ? m.x : r.x; o.y = v.y < 0.f ? m.y : r.y; return o;
}

template <int ACT  > struct EpiBf16 {
    static constexpr bool PERM = true, AFTER_DRAIN = false; static_assert(ACT == 0 || ACT == 1, "EpiBf16: ACT is 0 (none) or 1 (gelu_pk)");
    bf16_t* O; int ldc; const float* bias; int split_cols; size_t split_stride; float scale0;
    __device__ __forceinline__ void operator()(const f32x4 (&acc)[2][2][4][2], const Unit& u, int wr, int wc, int fr, int fq) const {
        const int row0 = u.pm * BM + wr * 64 + fr; int colt = u.pn * BM; bf16_t* base = O;
        float sc = 1.f; if (split_cols) { const int t = colt / split_cols; base += (size_t)t * split_stride; colt -= t * split_cols; if (t == 0) sc = scale0; }
        const int col0 = colt + wc * 32 + 8 * fq, bcol0 = u.pn * BM + wc * 32 + 8 * fq;
        f32x4 bv[2][2];
#pragma unroll
        for (int bj = 0; bj < 2; ++bj)
#pragma unroll
            for (int n = 0; n < 2; ++n) bv[bj][n] = bias ? *(const f32x4*)(bias + bcol0 + bj * HALF + 4 * n) : (f32x4){0.f, 0.f, 0.f, 0.f};
#pragma unroll
        for (int ai = 0; ai < 2; ++ai)
#pragma unroll
            for (int m = 0; m < 4; ++m) { bf16_t* rowp = base + (size_t)(row0 + ai * HALF + m * 16) * ldc + col0;
#pragma unroll
                for (int bj = 0; bj < 2; ++bj) { f32x4 v0 = acc[ai][bj][m][0] + bv[bj][0], v1 = acc[ai][bj][m][1] + bv[bj][1];
                    if (ACT == 1) { f32x2 a = gelu_pk((f32x2){v0[0], v0[1]}), b = gelu_pk((f32x2){v0[2], v0[3]}), c = gelu_pk((f32x2){v1[0], v1[1]}), d = gelu_pk((f32x2){v1[2], v1[3]});
                        v0 = (f32x4){a.x, a.y, b.x, b.y}; v1 = (f32x4){c.x, c.y, d.x, d.y}; }
                    v0 = v0 * sc; v1 = v1 * sc; u32x4 w; w.x = cvt_pk_bf16(v0[0], v0[1]); w.y = cvt_pk_bf16(v0[2], v0[3]); w.z = cvt_pk_bf16(v1[0], v1[1]); w.w = cvt_pk_bf16(v1[2], v1[3]);
                    *(u32x4*)(rowp + bj * HALF) = w; } }
    }
};
template <bool F16> __device__ __forceinline__ f32x4 mma16(bf16x8 b, bf16x8 a, f32x4 c) {
    if constexpr (F16) { typedef _Float16 h16x8 __attribute__((ext_vector_type(8))); return __builtin_amdgcn_mfma_f32_16x16x32_f16(__builtin_bit_cast(h16x8, b), __builtin_bit_cast(h16x8, a), c, 0, 0, 0); }
    else return __builtin_amdgcn_mfma_f32_16x16x32_bf16(b, a, c, 0, 0, 0);
}
template <class Epi, class Sched, bool ALIGN_EPI = false, bool SP2 = false, bool F16 = false>
__device__ __forceinline__ void gemm_phase(PG8_LAS unsigned char* lds, const Gemm g, const Sched& S, const Epi& E) {
    const int tid = threadIdx.x, wid = __builtin_amdgcn_readfirstlane(tid >> 6), lane = tid & 63, wr = wid >> 2, wc = wid & 3, fr = lane & 15, fq = lane >> 4;
    const int K = g.K, nt = K / BK;
    unsigned voffA[2], voffB[2];
#pragma unroll
    for (int i = 0; i < 2; ++i) { int R, C; stage_rc(tid * 16 + i * 8192, R, C); const int Rb = Epi::PERM ? ((R & ~31) + perm32(R & 31)) : R;
        voffA[i] = (unsigned)(R * K + C) * 2u; voffB[i] = (unsigned)(Rb * K + C) * 2u; }
    const size_t kstep = (size_t)(BK * 2);
    const size_t hstep = (size_t)HALF * K * 2;
    const size_t tstep = 2 * hstep;
    const unsigned ldsw = (unsigned)wid * 1024u;
    const int aoff = lds_byte(wr * 64 + fr, fq * 8), boff = lds_byte(wc * 32 + fr, fq * 8);
#define PG8_SA(b, h) (((b) * 2 + (h)) * HTB)
#define PG8_SB(b, h) ((4 + (b) * 2 + (h)) * HTB)
#define PG8_STAGE(bufoff, gbase, voff) do { _Pragma("unroll") for (int _i = 0; _i < 2; ++_i) \
        __builtin_amdgcn_global_load_lds((const unsigned*)((const char*)(gbase) + (voff)[_i]), (PG8_LAS unsigned*)(lds + (bufoff) + ldsw + _i * 8192), 16, 0, 0); } while (0)
#define PG8_LDA(dst, b, h) do { _Pragma("unroll") for (int m = 0; m < 4; ++m) _Pragma("unroll") for (int k = 0; k < 2; ++k) dst[m][k] = *(const PG8_LAS bf16x8*)(lds + PG8_SA(b, h) + aoff + m * 2048 + k * 1024); } while (0)
#define PG8_LDB(dst, b, h) do { _Pragma("unroll") for (int n = 0; n < 2; ++n) _Pragma("unroll") for (int k = 0; k < 2; ++k) dst[n][k] = *(const PG8_LAS bf16x8*)(lds + PG8_SB(b, h) + boff + n * 2048 + k * 1024); } while (0)
#define PG8_MMA(ai, bj, At, Bt) do { __builtin_amdgcn_s_setprio(1); _Pragma("unroll") for (int m = 0; m < 4; ++m) _Pragma("unroll") for (int n = 0; n < 2; ++n) _Pragma("unroll") for (int k = 0; k < 2; ++k) \
        acc[ai][bj][m][n] = mma16<F16>(Bt[n][k], At[m][k], acc[ai][bj][m][n]); __builtin_amdgcn_s_setprio(0); } while (0)
#define PG8_WAIT_V(n) asm volatile("s_waitcnt vmcnt(" #n ")" ::: "memory")
#define PG8_WAIT_L(n) asm volatile("s_waitcnt lgkmcnt(" #n ")" ::: "memory")
#define PG8_BAR __builtin_amdgcn_s_barrier()
#define PG8_SCHED __builtin_amdgcn_sched_barrier(0)
    Unit cur, nxt; int ui = 0;
    if (!S.next(0, cur)) return;
    f32x4 acc[2][2][4][2];
#pragma unroll
    for (int a = 0; a < 2; ++a)
#pragma unroll
        for (int b = 0; b < 2; ++b)
#pragma unroll
            for (int m = 0; m < 4; ++m)
#pragma unroll
                for (int n = 0; n < 2; ++n) acc[a][b][m][n] = (f32x4){0.f, 0.f, 0.f, 0.f};
    bf16x8 At[4][2], B0[2][2], B1[2][2];
    const char* cA = (const char*)g.A + (size_t)cur.pm * tstep; const char* cB = (const char*)g.Bt + (size_t)cur.pn * tstep;
    S.a_ready(cur);
    if constexpr (SP2) {
        PG8_STAGE(PG8_SB(0, 0), cB, voffB); PG8_STAGE(PG8_SB(0, 1), cB + hstep, voffB); PG8_STAGE(PG8_SA(0, 0), cA, voffA); PG8_STAGE(PG8_SA(0, 1), cA + hstep, voffA);
        if (wr == 1) PG8_BAR;
        PG8_WAIT_V(2); PG8_BAR;
        PG8_STAGE(PG8_SB(1, 0), cB + kstep, voffB); PG8_STAGE(PG8_SA(1, 0), cA + kstep, voffA); PG8_STAGE(PG8_SB(1, 1), cB + hstep + kstep, voffB);
        PG8_WAIT_V(6); PG8_BAR;
    } else {
        PG8_STAGE(PG8_SB(0, 0), cB, voffB); PG8_STAGE(PG8_SA(0, 0), cA, voffA); PG8_STAGE(PG8_SB(0, 1), cB + hstep, voffB); PG8_STAGE(PG8_SA(0, 1), cA + hstep, voffA);
        if (wr == 1) PG8_BAR;
        PG8_WAIT_V(4); PG8_BAR;
        PG8_STAGE(PG8_SB(1, 0), cB + kstep, voffB); PG8_STAGE(PG8_SA(1, 0), cA + kstep, voffA); PG8_STAGE(PG8_SB(1, 1), cB + hstep + kstep, voffB);
        PG8_WAIT_V(6); PG8_BAR;
    }
    for (;;) {
        const bool has_next = S.next(ui + 1, nxt);
        const char* nA = has_next ? (const char*)g.A + (size_t)nxt.pm * tstep : cA; const char* nB = has_next ? (const char*)g.Bt + (size_t)nxt.pn * tstep : cB;
        for (int t = 0; t < nt; t += 2) {
            const bool last = (t == nt - 2);
            const char* a1 = cA + (size_t)(t + 1) * kstep;
            const char* a2 = last ? nA : cA + (size_t)(t + 2) * kstep; const char* b2 = last ? nB : cB + (size_t)(t + 2) * kstep;
            const char* a3 = a2 + kstep; const char* b3 = b2 + kstep;
            if (last && has_next) S.a_ready(nxt);
            if constexpr (SP2) {
            PG8_LDB(B0, 0, 0); PG8_LDB(B1, 0, 1); PG8_SCHED; PG8_LDA(At, 0, 0); PG8_STAGE(PG8_SA(1, 1), a1 + hstep, voffA);
            PG8_WAIT_V(8); PG8_WAIT_L(0); PG8_BAR; PG8_MMA(0, 0, At, B0); PG8_MMA(0, 1, At, B1); PG8_BAR; PG8_SCHED;
            PG8_LDA(At, 0, 1); PG8_STAGE(PG8_SB(0, 0), b2, voffB); PG8_STAGE(PG8_SB(0, 1), b2 + hstep, voffB); PG8_STAGE(PG8_SA(0, 0), a2, voffA);
            PG8_WAIT_V(8); PG8_WAIT_L(0); PG8_BAR; PG8_MMA(1, 0, At, B0); PG8_MMA(1, 1, At, B1); PG8_BAR; PG8_SCHED;
            PG8_LDB(B0, 1, 0); PG8_LDB(B1, 1, 1); PG8_SCHED; PG8_LDA(At, 1, 0); PG8_STAGE(PG8_SA(0, 1), a2 + hstep, voffA);
            PG8_WAIT_V(8); PG8_WAIT_L(0); PG8_BAR; PG8_MMA(0, 0, At, B0); PG8_MMA(0, 1, At, B1); PG8_BAR; PG8_SCHED;
            PG8_LDA(At, 1, 1); PG8_STAGE(PG8_SB(1, 0), b3, voffB); PG8_STAGE(PG8_SB(1, 1), b3 + hstep, voffB); PG8_STAGE(PG8_SA(1, 0), a3, voffA);
            PG8_WAIT_V(8); PG8_WAIT_L(0); PG8_BAR; PG8_MMA(1, 0, At, B0); PG8_MMA(1, 1, At, B1); PG8_BAR; PG8_SCHED;
            } else {
            PG8_LDB(B0, 0, 0); PG8_SCHED; PG8_LDA(At, 0, 0); PG8_STAGE(PG8_SA(1, 1), a1 + hstep, voffA);
            PG8_WAIT_L(8); PG8_BAR; PG8_WAIT_L(0); PG8_MMA(0, 0, At, B0); PG8_BAR; PG8_SCHED;
            PG8_LDB(B1, 0, 1); PG8_STAGE(PG8_SB(0, 0), b2, voffB);
            PG8_BAR; PG8_WAIT_L(0); PG8_MMA(0, 1, At, B1); PG8_BAR;
            PG8_LDA(At, 0, 1); PG8_STAGE(PG8_SA(0, 0), a2, voffA);
            PG8_BAR; PG8_WAIT_L(0); PG8_MMA(1, 0, At, B0); PG8_BAR; PG8_SCHED;
            PG8_STAGE(PG8_SB(0, 1), b2 + hstep, voffB);
            PG8_WAIT_V(6); PG8_BAR; PG8_MMA(1, 1, At, B1); PG8_BAR;
            PG8_LDB(B0, 1, 0); PG8_SCHED; PG8_LDA(At, 1, 0); PG8_STAGE(PG8_SA(0, 1), a2 + hstep, voffA);
            PG8_WAIT_L(8); PG8_BAR; PG8_WAIT_L(0); PG8_MMA(0, 0, At, B0); PG8_BAR; PG8_SCHED;
            PG8_LDB(B1, 1, 1); PG8_STAGE(PG8_SB(1, 0), b3, voffB);
            PG8_BAR; PG8_WAIT_L(0); PG8_MMA(0, 1, At, B1); PG8_BAR;
            PG8_LDA(At, 1, 1); PG8_STAGE(PG8_SA(1, 0), a3, voffA);
            PG8_BAR; PG8_WAIT_L(0); PG8_MMA(1, 0, At, B0); PG8_BAR; PG8_SCHED;
            PG8_STAGE(PG8_SB(1, 1), b3 + hstep, voffB);
            PG8_WAIT_V(6); PG8_BAR; PG8_MMA(1, 1, At, B1); PG8_BAR;
            }
        }
        if constexpr (ALIGN_EPI) { if (wr == 0) PG8_BAR; }
        if constexpr (!Epi::AFTER_DRAIN) { E(acc, cur, wr, wc, fr, fq); S.done(cur); }
        if (!has_next) break;
#pragma unroll
        for (int a = 0; a < 2; ++a)
#pragma unroll
            for (int b = 0; b < 2; ++b)
#pragma unroll
                for (int m = 0; m < 4; ++m)
#pragma unroll
                    for (int n = 0; n < 2; ++n) acc[a][b][m][n] = (f32x4){0.f, 0.f, 0.f, 0.f};
        cur = nxt; cA = nA; cB = nB; ++ui;
        if constexpr (ALIGN_EPI) { if (wr == 1) PG8_BAR; }
    }
    PG8_WAIT_V(0);
    if constexpr (!ALIGN_EPI) { if (wr == 0) PG8_BAR; }
    PG8_BAR;
    if constexpr (Epi::AFTER_DRAIN) { E.fused(acc, cur, wr, wc, fr, fq, lds, wid, lane); S.done(cur); }
#undef PG8_SA
#undef PG8_SB
#undef PG8_STAGE
#undef PG8_LDA
#undef PG8_LDB
#undef PG8_MMA
#undef PG8_WAIT_V
#undef PG8_WAIT_L
#undef PG8_BAR
#undef PG8_SCHED
}
}

#define LAS __attribute__((address_space(3)))
typedef unsigned short bf16;
typedef float f32x4 __attribute__((ext_vector_type(4)));
typedef float f32x2 __attribute__((ext_vector_type(2)));
typedef float f32x16 __attribute__((ext_vector_type(16)));
typedef short bf16x8 __attribute__((ext_vector_type(8)));
typedef short s16x4 __attribute__((ext_vector_type(4)));
typedef unsigned u32x4 __attribute__((ext_vector_type(4)));
typedef unsigned u32x2 __attribute__((ext_vector_type(2)));

constexpr int NB = 4, SEQ = 8192, DM = 1024, NTOK = NB * SEQ, MROWS = NTOK + 256, META_ROW = NTOK;
constexpr int INC = 4608, DFF = 2816, KVW = 256;
constexpr int NGRP = 64, NST = 64, CHUNK = 256, NCHUNK = SEQ / CHUNK;
constexpr float EPS = 1e-6f;
constexpr int NTHREADS = 512, NWAVES = 8;
constexpr int LDS_BYTES = 147456;

constexpr size_t MiB = 1u << 20;
constexpr size_t WS_RSTDX = 0;
constexpr size_t WS_ROWSS = 256 * 1024;
constexpr size_t WS_ROWSA = 384 * 1024;
constexpr size_t WS_ROWSB = 800 * 1024;
constexpr size_t WS_ATAB = 512 * 1024;
constexpr size_t WS_ATAB2 = 512 * 1024 + 32768;
constexpr size_t WS_SMETA = 512 * 1024 + 65536;
constexpr size_t WS_BB = 1 * MiB;
constexpr size_t WS_CM = 1 * MiB + 262144;
constexpr size_t WS_WG = 7 * MiB;
constexpr int NQKVU = 2560;
constexpr size_t WS_W1 = 2 * MiB, WS_W2 = 11 * MiB, WS_W3 = 15 * MiB, WS_W4 = 17 * MiB, WS_W5 = 28 * MiB;
constexpr size_t WS_E = 34 * MiB;
constexpr size_t ROWBUF = (size_t)MROWS * DM * 2;
constexpr size_t WS_XB = 44 * MiB;
constexpr size_t WS_Q = 110 * MiB;
constexpr size_t WS_K = 175 * MiB, WS_V = 192 * MiB;
constexpr size_t WS_U = 209 * MiB;
constexpr size_t WS_GA = 274 * MiB, WS_GS = 339 * MiB;
constexpr size_t WS_ATT = 404 * MiB;
constexpr size_t WS_ACT = 110 * MiB;
constexpr size_t WS_END = 470 * MiB;
static_assert(WS_XB + ROWBUF <= WS_Q && WS_Q + ROWBUF <= WS_K && WS_U + ROWBUF <= WS_GA && WS_GA + ROWBUF <= WS_GS && WS_GS + ROWBUF <= WS_ATT && WS_ATT + ROWBUF <= WS_END, "ws map");
static_assert(WS_K + (size_t)MROWS * KVW * 2 <= WS_V && WS_V + (size_t)MROWS * KVW * 2 <= WS_U, "ws map kv");
static_assert(WS_ACT + (size_t)NTOK * DFF * 2 <= WS_GS, "act overlay");

__device__ __forceinline__ unsigned cvt_pk(float lo, float hi) { unsigned r; asm volatile("v_cvt_pk_bf16_f32 %0, %1, %2" : "=v"(r) : "v"(lo), "v"(hi)); return r; }
__device__ __forceinline__ float bf_lo(unsigned w) { return __uint_as_float(w << 16); }
__device__ __forceinline__ float bf_hi(unsigned w) { return __uint_as_float(w & 0xffff0000u); }
__device__ __forceinline__ unsigned pk_f16(float lo, float hi) { const _Float16 a = (_Float16)lo, b = (_Float16)hi; return (unsigned)__builtin_bit_cast(unsigned short, a) | ((unsigned)__builtin_bit_cast(unsigned short, b) << 16); }
__device__ __forceinline__ float f16_lo(unsigned w) { return (float)__builtin_bit_cast(_Float16, (unsigned short)(w & 0xffffu)); }
__device__ __forceinline__ float f16_hi(unsigned w) { return (float)__builtin_bit_cast(_Float16, (unsigned short)(w >> 16)); }
__device__ __forceinline__ float fast_sigmoid(float v) { return __builtin_amdgcn_rcpf(1.0f + __builtin_amdgcn_exp2f(-1.4426950408889634f * v)); }
__device__ __forceinline__ float wave_sum(float v) {
#pragma unroll
    for (int o = 1; o < 64; o <<= 1) v += __shfl_xor(v, o);
    return v;
}
#define LDS_WAIT() asm volatile("s_waitcnt lgkmcnt(0)" ::: "memory")

struct EpiProj {
    static constexpr bool PERM = true, AFTER_DRAIN = false;
    bf16 *Q, *K, *V, *U; const float* rstd;
    __device__ __forceinline__ void operator()(const pg8::f32x4 (&acc)[2][2][4][2], const pg8::Unit& u, int wr, int wc, int fr, int fq) const {
        const int pn = u.pn; bf16* base; int ld, ct;
        if (pn < 4) { base = Q; ld = DM; ct = pn; } else if (pn == 4) { base = K; ld = KVW; ct = 0; } else if (pn == 5) { base = V; ld = KVW; ct = 0; } else { base = U; ld = DM; ct = pn - 6; }
        const int row0 = u.pm * 256 + wr * 64 + fr, col0 = ct * 256 + wc * 32 + 8 * fq;
        float rsv[8];
#pragma unroll
        for (int q = 0; q < 8; ++q) rsv[q] = rstd[row0 + (q >> 2) * 128 + (q & 3) * 16];
        asm volatile("" : "+v"(rsv[0]), "+v"(rsv[1]), "+v"(rsv[2]), "+v"(rsv[3]), "+v"(rsv[4]), "+v"(rsv[5]), "+v"(rsv[6]), "+v"(rsv[7]));
#pragma unroll
        for (int ai = 0; ai < 2; ++ai)
#pragma unroll
            for (int m = 0; m < 4; ++m) { const int row = row0 + ai * 128 + m * 16; const float rs = rsv[ai * 4 + m]; bf16* rowp = base + (size_t)row * ld + col0;
#pragma unroll
                for (int bj = 0; bj < 2; ++bj) { pg8::f32x4 v0 = acc[ai][bj][m][0] * rs, v1 = acc[ai][bj][m][1] * rs;
                    u32x4 w; w.x = cvt_pk(v0[0], v0[1]); w.y = cvt_pk(v0[2], v0[3]); w.z = cvt_pk(v1[0], v1[1]); w.w = cvt_pk(v1[2], v1[3]);
                    *(u32x4*)(rowp + bj * 128) = w; } }
    }
};
struct EpiMerge {
    static constexpr bool PERM = true, AFTER_DRAIN = false;
    const bf16* ATT; const bf16* SSM; bf16* MG; const float* rstd; const float* rowsa; const float* rowsb; const float* wa; const float* wsn;
    __device__ __forceinline__ void operator()(const pg8::f32x4 (&acc)[2][2][4][2], const pg8::Unit& u, int wr, int wc, int fr, int fq) const {
        const int row0 = u.pm * 256 + wr * 64 + fr, col0 = u.pn * 128 + wc * 32 + 8 * fq;
        const pg8::f32x4 wa0 = *(const pg8::f32x4*)(wa + col0), wa1 = *(const pg8::f32x4*)(wa + col0 + 4), ws0 = *(const pg8::f32x4*)(wsn + col0), ws1 = *(const pg8::f32x4*)(wsn + col0 + 4);
        float rsv[8], rav[8], rbv[8];
#pragma unroll
        for (int q = 0; q < 8; ++q) { const int row = row0 + (q >> 2) * 128 + (q & 3) * 16; rsv[q] = rstd[row]; rav[q] = rowsa[row]; rbv[q] = rowsb[row]; }
#pragma unroll
        for (int p = 0; p < 4; ++p) {
            u32x4 awv[2], swv[2];
#pragma unroll
            for (int m2 = 0; m2 < 2; ++m2) { const int q = p * 2 + m2; const size_t off = (size_t)(row0 + (q >> 2) * 128 + (q & 3) * 16) * DM + col0; awv[m2] = *(const u32x4*)(ATT + off); swv[m2] = *(const u32x4*)(SSM + off); }
            asm volatile("" : "+v"(awv[0]), "+v"(awv[1]), "+v"(swv[0]), "+v"(swv[1]));
#pragma unroll
            for (int m2 = 0; m2 < 2; ++m2) { const int q = p * 2 + m2, ai = q >> 2, m = q & 3; const int row = row0 + ai * 128 + m * 16; const size_t off = (size_t)row * DM + col0;
                const u32x4 aw = awv[m2], sw = swv[m2];
                const float rs = rsv[q], ra = __builtin_amdgcn_rsqf(rav[q] * (1.0f / DM) + EPS), rb = __builtin_amdgcn_rsqf(rbv[q] * (1.0f / DM) + EPS);
                const float av[8] = {bf_lo(aw.x), bf_hi(aw.x), bf_lo(aw.y), bf_hi(aw.y), bf_lo(aw.z), bf_hi(aw.z), bf_lo(aw.w), bf_hi(aw.w)};
                const float sv[8] = {bf_lo(sw.x), bf_hi(sw.x), bf_lo(sw.y), bf_hi(sw.y), bf_lo(sw.z), bf_hi(sw.z), bf_lo(sw.w), bf_hi(sw.w)};
                float o[8];
#pragma unroll
                for (int n = 0; n < 2; ++n)
#pragma unroll
                    for (int e = 0; e < 4; ++e) { const float wl = n ? wa1[e] : wa0[e], vl = n ? ws1[e] : ws0[e];
                        o[n * 4 + e] = fast_sigmoid(acc[ai][0][m][n][e] * rs) * av[n * 4 + e] * (ra * wl) + fast_sigmoid(acc[ai][1][m][n][e] * rs) * sv[n * 4 + e] * (rb * vl); }
                u32x4 w; w.x = cvt_pk(o[0], o[1]); w.y = cvt_pk(o[2], o[3]); w.z = cvt_pk(o[4], o[5]); w.w = cvt_pk(o[6], o[7]);
                *(u32x4*)(MG + off) = w; }
        }
    }
};
struct EpiGlu {
    static constexpr bool PERM = true, AFTER_DRAIN = false;
    bf16* O; int ldc; float* rowsb;
    __device__ __forceinline__ void operator()(const pg8::f32x4 (&acc)[2][2][4][2], const pg8::Unit& u, int wr, int wc, int fr, int fq) const {
        const int row0 = u.pm * 256 + wr * 64 + fr, col0 = u.pn * 128 + wc * 32 + 8 * fq;
#pragma unroll
        for (int ai = 0; ai < 2; ++ai)
#pragma unroll
            for (int m = 0; m < 4; ++m) { const int row = row0 + ai * 128 + m * 16; float o[8]; float ss = 0.f;
#pragma unroll
                for (int n = 0; n < 2; ++n)
#pragma unroll
                    for (int e = 0; e < 4; ++e) { const float v = acc[ai][0][m][n][e] * fast_sigmoid(acc[ai][1][m][n][e]); o[n * 4 + e] = v; ss += v * v; }
                u32x4 w; w.x = cvt_pk(o[0], o[1]); w.y = cvt_pk(o[2], o[3]); w.z = cvt_pk(o[4], o[5]); w.w = cvt_pk(o[6], o[7]);
                *(u32x4*)(O + (size_t)row * ldc + col0) = w;
                ss += __shfl_xor(ss, 16); ss += __shfl_xor(ss, 32);
                if (fq == 0) atomicAdd(rowsb + row, ss); }
    }
};
struct EpiSwiglu {
    static constexpr bool PERM = true, AFTER_DRAIN = false;
    bf16* O; int ldc; const float* rowss;
    __device__ __forceinline__ void operator()(const pg8::f32x4 (&acc)[2][2][4][2], const pg8::Unit& u, int wr, int wc, int fr, int fq) const {
        const int row0 = u.pm * 256 + wr * 64 + fr, col0 = u.pn * 128 + wc * 32 + 8 * fq;
        float rsv[8];
#pragma unroll
        for (int q = 0; q < 8; ++q) rsv[q] = rowss[row0 + (q >> 2) * 128 + (q & 3) * 16];
        asm volatile("" : "+v"(rsv[0]), "+v"(rsv[1]), "+v"(rsv[2]), "+v"(rsv[3]), "+v"(rsv[4]), "+v"(rsv[5]), "+v"(rsv[6]), "+v"(rsv[7]));
#pragma unroll
        for (int ai = 0; ai < 2; ++ai)
#pragma unroll
            for (int m = 0; m < 4; ++m) { const int row = row0 + ai * 128 + m * 16; const float rs = __builtin_amdgcn_rsqf(rsv[ai * 4 + m] * (1.0f / DM) + EPS); float o[8];
#pragma unroll
                for (int n = 0; n < 2; ++n)
#pragma unroll
                    for (int e = 0; e < 4; ++e) { const float g = acc[ai][0][m][n][e] * rs, up = acc[ai][1][m][n][e] * rs; o[n * 4 + e] = g * fast_sigmoid(g) * up; }
                u32x4 w; w.x = cvt_pk(o[0], o[1]); w.y = cvt_pk(o[2], o[3]); w.z = cvt_pk(o[4], o[5]); w.w = cvt_pk(o[6], o[7]);
                *(u32x4*)(O + (size_t)row * ldc + col0) = w; }
    }
};
struct EpiResid1 {
    static constexpr bool PERM = true, AFTER_DRAIN = false;
    const bf16* XBp; bf16* HF; float* rowss;
    __device__ __forceinline__ void operator()(const pg8::f32x4 (&acc)[2][2][4][2], const pg8::Unit& u, int wr, int wc, int fr, int fq) const {
        const int row0 = u.pm * 256 + wr * 64 + fr, col0 = u.pn * 256 + wc * 32 + 8 * fq;
#pragma unroll
        for (int ai = 0; ai < 2; ++ai) {
            u32x4 xwv[4][2];
#pragma unroll
            for (int m = 0; m < 4; ++m)
#pragma unroll
                for (int bj = 0; bj < 2; ++bj) xwv[m][bj] = *(const u32x4*)(XBp + (size_t)(row0 + ai * 128 + m * 16) * DM + col0 + bj * 128);
            asm volatile("" : "+v"(xwv[0][0]), "+v"(xwv[0][1]), "+v"(xwv[1][0]), "+v"(xwv[1][1]), "+v"(xwv[2][0]), "+v"(xwv[2][1]), "+v"(xwv[3][0]), "+v"(xwv[3][1]));
#pragma unroll
            for (int m = 0; m < 4; ++m) { const int row = row0 + ai * 128 + m * 16; float ss = 0.f;
#pragma unroll
                for (int bj = 0; bj < 2; ++bj) { const size_t off = (size_t)row * DM + col0 + bj * 128;
                    const u32x4 xw = xwv[m][bj];
                    const pg8::f32x4 h0 = (pg8::f32x4){bf_lo(xw.x), bf_hi(xw.x), bf_lo(xw.y), bf_hi(xw.y)} + acc[ai][bj][m][0], h1 = (pg8::f32x4){bf_lo(xw.z), bf_hi(xw.z), bf_lo(xw.w), bf_hi(xw.w)} + acc[ai][bj][m][1];
                    ss += (h0[0] * h0[0] + h0[1] * h0[1]) + (h0[2] * h0[2] + h0[3] * h0[3]) + (h1[0] * h1[0] + h1[1] * h1[1]) + (h1[2] * h1[2] + h1[3] * h1[3]);
                    u32x4 l; l.x = pk_f16(h0[0], h0[1]); l.y = pk_f16(h0[2], h0[3]); l.z = pk_f16(h1[0], h1[1]); l.w = pk_f16(h1[2], h1[3]);
                    *(u32x4*)(HF + off) = l; }
                ss += __shfl_xor(ss, 16); ss += __shfl_xor(ss, 32);
                if (fq == 0) atomicAdd(rowss + row, ss); }
        }
    }
};
struct EpiResid2 {
    static constexpr bool PERM = true, AFTER_DRAIN = false;
    const bf16* HF; float* out;
    __device__ __forceinline__ void operator()(const pg8::f32x4 (&acc)[2][2][4][2], const pg8::Unit& u, int wr, int wc, int fr, int fq) const {
        const int row0 = u.pm * 256 + wr * 64 + fr, col0 = u.pn * 256 + wc * 32 + 8 * fq;
#pragma unroll
        for (int ai = 0; ai < 2; ++ai) {
            u32x4 hv[4][2];
#pragma unroll
            for (int m = 0; m < 4; ++m)
#pragma unroll
                for (int bj = 0; bj < 2; ++bj) hv[m][bj] = *(const u32x4*)(HF + (size_t)(row0 + ai * 128 + m * 16) * DM + col0 + bj * 128);
            asm volatile("" : "+v"(hv[0][0]), "+v"(hv[0][1]), "+v"(hv[1][0]), "+v"(hv[1][1]), "+v"(hv[2][0]), "+v"(hv[2][1]), "+v"(hv[3][0]), "+v"(hv[3][1]));
#pragma unroll
            for (int m = 0; m < 4; ++m) { const int row = row0 + ai * 128 + m * 16;
#pragma unroll
                for (int bj = 0; bj < 2; ++bj) { const size_t off = (size_t)row * DM + col0 + bj * 128; const u32x4 h = hv[m][bj];
                    *(pg8::f32x4*)(out + off) = (pg8::f32x4){f16_lo(h.x), f16_hi(h.x), f16_lo(h.y), f16_hi(h.y)} + acc[ai][bj][m][0];
                    *(pg8::f32x4*)(out + off + 4) = (pg8::f32x4){f16_lo(h.z), f16_hi(h.z), f16_lo(h.w), f16_hi(h.w)} + acc[ai][bj][m][1]; } }
        }
    }
};

constexpr int TP = 65, T_SCR_BYTES = 64 * TP * 4;
__device__ __forceinline__ void transpose_item(const float* W, int ldw, const float* gk, int K, int N, bf16* WT, bool glu, LAS float* scr, int item, int lane, bool f16 = false) {
    const int nblk = N / 64, kb = item / nblk, nb = item % nblk, k0 = 64 * kb, n0 = 64 * nb;
    const int kq = lane >> 4, n4 = (lane & 15) * 4;
    f32x4 v[16];
#pragma unroll
    for (int i = 0; i < 16; ++i) v[i] = __builtin_nontemporal_load((const f32x4*)(W + (size_t)(k0 + 4 * i + kq) * ldw + n0 + n4));
#pragma unroll
    for (int i = 0; i < 16; ++i) { LAS float* d = scr + (4 * i + kq) * TP + n4; d[0] = v[i].x; d[1] = v[i].y; d[2] = v[i].z; d[3] = v[i].w; }
    LDS_WAIT(); asm volatile("" ::: "memory");
    int d0 = n0; if (glu) { const int half = N / 2, bj = n0 / half, j = n0 % half; d0 = 256 * (j / 128) + 128 * bj + (j % 128); }
    const int c = lane & 7;
    float g[8];
#pragma unroll
    for (int e2 = 0; e2 < 8; ++e2) g[e2] = gk ? gk[k0 + 8 * c + e2] : 1.0f;
#pragma unroll
    for (int j = 0; j < 8; ++j) { const int n = (lane >> 3) + 8 * j; const LAS float* s = scr + (8 * c) * TP + n;
        u32x4 o;
        if (f16) { o.x = pk_f16(s[0 * TP] * g[0], s[1 * TP] * g[1]); o.y = pk_f16(s[2 * TP] * g[2], s[3 * TP] * g[3]); o.z = pk_f16(s[4 * TP] * g[4], s[5 * TP] * g[5]); o.w = pk_f16(s[6 * TP] * g[6], s[7 * TP] * g[7]); }
        else { o.x = cvt_pk(s[0 * TP] * g[0], s[1 * TP] * g[1]); o.y = cvt_pk(s[2 * TP] * g[2], s[3 * TP] * g[3]); o.z = cvt_pk(s[4 * TP] * g[4], s[5 * TP] * g[5]); o.w = cvt_pk(s[6 * TP] * g[6], s[7 * TP] * g[7]); }
        *(u32x4*)(WT + (size_t)(d0 + n) * K + k0 + 8 * c) = o; }
    LDS_WAIT(); asm volatile("" ::: "memory");
}

__device__ __forceinline__ void sincos_small(float x, float& s, float& c) {
    const float n = rintf(x * 0.6366197723675814f);
    float r = fmaf(-n, 1.5703125f, x); r = fmaf(-n, 4.837512969970703125e-4f, r); r = fmaf(-n, 7.54978995489188216e-8f, r);
    const float z = r * r;
    const float sp = r + r * z * (-1.6666654611e-1f + z * (8.3321608736e-3f + z * -1.9515295891e-4f));
    const float cp = 1.0f - 0.5f * z + z * z * (4.166664568298827e-2f + z * (-1.388731625493765e-3f + z * 2.443315711809948e-5f));
    const int q = ((int)n) & 3;
    const float ss = (q & 1) ? cp : sp, cc = (q & 1) ? sp : cp;
    s = (q & 2) ? -ss : ss; c = ((q + 1) & 2) ? -cc : cc;
}

struct Args { const float* in[22]; float* out; unsigned char* ws; long long never; };

__device__ __forceinline__ void p0_prologue(const Args& a, LAS unsigned char* lds, int wave, int lane) {
    unsigned char* ws = a.ws;
    LAS float* scr = (LAS float*)(lds + wave * 16896);
    const int gw = blockIdx.x * NWAVES + wave, NGW = gridDim.x * NWAVES;
    constexpr int I1 = (DM / 64) * (NQKVU / 64), IG = (DM / 64) * (2048 / 64), I2 = (DM / 64) * (2048 / 64), I3 = (DM / 64) * (DM / 64), I4 = (DM / 64) * (2 * DFF / 64), I5 = (DFF / 64) * (DM / 64);
    static_assert(T_SCR_BYTES <= 16896 && 8 * 16896 <= LDS_BYTES - 1024, "transpose scratch");
    constexpr int NITEMS = I1 + IG + I2 + I3 + I4 + I5;
    for (int it = gw; it < NITEMS; it += NGW) {
        int r = it;
        if (r < I1) { transpose_item(a.in[3], INC, a.in[2], DM, NQKVU, (bf16*)(ws + WS_W1), false, scr, r, lane); continue; } r -= I1;
        if (r < IG) { transpose_item(a.in[3] + NQKVU, INC, a.in[2], DM, 2048, (bf16*)(ws + WS_WG), true, scr, r, lane); continue; } r -= IG;
        if (r < I2) { transpose_item(a.in[15], 2048, nullptr, DM, 2048, (bf16*)(ws + WS_W2), true, scr, r, lane); continue; } r -= I2;
        if (r < I3) { transpose_item(a.in[18], DM, nullptr, DM, DM, (bf16*)(ws + WS_W3), false, scr, r, lane); continue; } r -= I3;
        if (r < I4) { transpose_item(a.in[20], 2 * DFF, a.in[19], DM, 2 * DFF, (bf16*)(ws + WS_W4), true, scr, r, lane, true); continue; } r -= I4;
        transpose_item(a.in[21], DM, nullptr, DFF, DM, (bf16*)(ws + WS_W5), false, scr, r, lane);
    }
    bf16* XB = (bf16*)(ws + WS_XB); float* rstdx = (float*)(ws + WS_RSTDX);
    for (int m0 = gw; m0 < NTOK + 16; m0 += 2 * NGW) {
        const int m1 = m0 + NGW; const bool has1 = m1 < NTOK + 16; const int m1c = has1 ? m1 : m0;
        const float* src0 = m0 < NTOK ? a.in[0] + (size_t)m0 * DM : a.in[1] + (size_t)(m0 - NTOK) * DM;
        const float* src1 = m1c < NTOK ? a.in[0] + (size_t)m1c * DM : a.in[1] + (size_t)(m1c - NTOK) * DM;
        f32x4 v0[4], v1[4]; float s0 = 0.f, s1 = 0.f;
#pragma unroll
        for (int j = 0; j < 4; ++j) { v0[j] = __builtin_nontemporal_load((const f32x4*)src0 + lane + 64 * j); v1[j] = __builtin_nontemporal_load((const f32x4*)src1 + lane + 64 * j); }
#pragma unroll
        for (int j = 0; j < 4; ++j) { s0 += (v0[j].x * v0[j].x + v0[j].y * v0[j].y) + (v0[j].z * v0[j].z + v0[j].w * v0[j].w); s1 += (v1[j].x * v1[j].x + v1[j].y * v1[j].y) + (v1[j].z * v1[j].z + v1[j].w * v1[j].w); }
        u32x2* o0 = (u32x2*)(XB + (size_t)m0 * DM) + lane; u32x2* o1 = (u32x2*)(XB + (size_t)m1c * DM) + lane;
#pragma unroll
        for (int j = 0; j < 4; ++j) { u32x2 w; w.x = cvt_pk(v0[j].x, v0[j].y); w.y = cvt_pk(v0[j].z, v0[j].w); o0[64 * j] = w; }
        if (has1) {
#pragma unroll
            for (int j = 0; j < 4; ++j) { u32x2 w; w.x = cvt_pk(v1[j].x, v1[j].y); w.y = cvt_pk(v1[j].z, v1[j].w); o1[64 * j] = w; } }
        s0 = wave_sum(s0); s1 = wave_sum(s1);
        if (lane == 0) { rstdx[m0] = __builtin_amdgcn_rsqf(s0 * (1.0f / DM) + EPS); if (has1) rstdx[m1] = __builtin_amdgcn_rsqf(s1 * (1.0f / DM) + EPS); }
    }
    const int gt = blockIdx.x * NTHREADS + threadIdx.x, NGT = gridDim.x * NTHREADS;
    float* rowss = (float*)(ws + WS_ROWSS);
    float* rowsa = (float*)(ws + WS_ROWSA); float* rowsb = (float*)(ws + WS_ROWSB);
    for (int i = gt; i < NTOK; i += NGT) { rowss[i] = 0.f; rowsa[i] = 0.f; rowsb[i] = 0.f; }
    if (gt < NGRP * NST) {
        const int g = gt >> 6, p = gt & 63;
        const float dt = expf(a.in[9][g]), lr = a.in[7][gt], li = a.in[8][gt];
        const float mag = expf(lr * dt); float sn, cs; sincos_small(li * dt, sn, cs);
        const float ar = mag * cs, ai = mag * sn, den = lr * lr + li * li, nr = ar - 1.0f, ni = ai;
        const float fr = (nr * lr + ni * li) / den, fi = (ni * lr - nr * li) / den;
        ((f32x2*)(ws + WS_ATAB))[gt] = (f32x2){ar, ai};
        float pr = ar, pi = ai;
#pragma unroll
        for (int i = 0; i < 8; ++i) { const float tr = pr * pr - pi * pi, ti = 2.0f * pr * pi; pr = tr; pi = ti; }
        ((f32x2*)(ws + WS_ATAB2))[gt] = (f32x2){pr, pi};
        bf16* BB = (bf16*)(ws + WS_BB); bf16* CM = (bf16*)(ws + WS_CM);
        const int rre = g * 128 + (p >> 5) * 64 + (p & 31), rim = rre + 32;
        const float* bre = a.in[10] + (size_t)gt * 16; const float* bim = a.in[11] + (size_t)gt * 16;
#pragma unroll
        for (int c = 0; c < 16; c += 2) {
            const float br0 = bre[c], bi0 = bim[c], br1 = bre[c + 1], bi1 = bim[c + 1];
            *(unsigned*)(BB + (size_t)rre * 16 + c) = cvt_pk(fr * br0 - fi * bi0, fr * br1 - fi * bi1);
            *(unsigned*)(BB + (size_t)rim * 16 + c) = cvt_pk(fr * bi0 + fi * br0, fr * bi1 + fi * br1);
        }
#pragma unroll
        for (int c = 0; c < 16; ++c) {
            const float cr = a.in[12][((size_t)g * 16 + c) * 64 + p], ci = a.in[13][((size_t)g * 16 + c) * 64 + p];
            *(unsigned*)(CM + ((size_t)g * 16 + c) * 128 + 2 * p) = cvt_pk(cr, -ci);
        }
    }
}

constexpr int KP = 144, VP = 840, NKEY = 416;
constexpr int ATT_K_OFF = 0, ATT_V_OFF = NKEY * KP;
static_assert(ATT_V_OFF + 64 * VP <= 131072, "attention LDS");
__device__ __forceinline__ int crow(int r, int hi) { return (r & 3) + 8 * (r >> 2) + 4 * hi; }

__device__ __forceinline__ void attn_item(const Args& a, LAS unsigned char* lds, int item, int wave, int lane) {
    unsigned char* ws = a.ws;
    const bf16* QB = (const bf16*)(ws + WS_Q); const bf16* KB = (const bf16*)(ws + WS_K); const bf16* VB = (const bf16*)(ws + WS_V); bf16* ATT = (bf16*)(ws + WS_ATT);
    const int blk0 = (item & 31) * 2, kvh = (item >> 5) & 3, b = item >> 7;
    const int tid = threadIdx.x;
    const float* knw = a.in[5];
    for (int idx = tid; idx < NKEY * 8; idx += NTHREADS) {
        const int key = idx >> 3, ck = idx & 7; int row = -1;
        if (key < 16) row = META_ROW + key;
        else if (key < 32) row = -1;
        else if (key < 160) row = blk0 > 0 ? b * SEQ + (blk0 - 1) * 128 + (key - 32) : -1;
        else row = b * SEQ + blk0 * 128 + (key - 160);
        u32x4 kw = (u32x4){0u, 0u, 0u, 0u}, vw = (u32x4){0u, 0u, 0u, 0u};
        if (row >= 0) { kw = *(const u32x4*)(KB + (size_t)row * KVW + kvh * 64 + ck * 8); vw = *(const u32x4*)(VB + (size_t)row * KVW + kvh * 64 + ck * 8); }
        float kf[8] = {bf_lo(kw.x), bf_hi(kw.x), bf_lo(kw.y), bf_hi(kw.y), bf_lo(kw.z), bf_hi(kw.z), bf_lo(kw.w), bf_hi(kw.w)};
        float ss = 0.f;
#pragma unroll
        for (int e = 0; e < 8; ++e) ss += kf[e] * kf[e];
        ss += __shfl_xor(ss, 1); ss += __shfl_xor(ss, 2); ss += __shfl_xor(ss, 4);
        const float rs = __builtin_amdgcn_rsqf(ss * (1.0f / 64.0f) + EPS);
        const f32x4 g0 = *(const f32x4*)(knw + ck * 8), g1 = *(const f32x4*)(knw + ck * 8 + 4);
        u32x4 o; o.x = cvt_pk(kf[0] * rs * g0.x, kf[1] * rs * g0.y); o.y = cvt_pk(kf[2] * rs * g0.z, kf[3] * rs * g0.w);
        o.z = cvt_pk(kf[4] * rs * g1.x, kf[5] * rs * g1.y); o.w = cvt_pk(kf[6] * rs * g1.z, kf[7] * rs * g1.w);
        *(LAS u32x4*)(lds + ATT_K_OFF + key * KP + ck * 16) = o;
        LAS unsigned short* vt = (LAS unsigned short*)(lds + ATT_V_OFF + (ck * 8) * VP + key * 2);
        const unsigned vv[4] = {vw.x, vw.y, vw.z, vw.w};
#pragma unroll
        for (int e = 0; e < 4; ++e) { vt[(2 * e) * (VP / 2)] = (unsigned short)(vv[e] & 0xffffu); vt[(2 * e + 1) * (VP / 2)] = (unsigned short)(vv[e] >> 16); }
    }
    __syncthreads();
    const int r = wave >> 1, qh = wave & 1, hq = kvh * 4 + r, ql = lane & 31, hi = lane >> 5;
    const float sink = a.in[6][hq];
    const float* qnw = a.in[4];
    const float L2E = 1.4426950408889634f;
    for (int q4 = 0; q4 < 4; ++q4) {
        const int bl = q4 >> 1, qb = q4 & 1, blk = blk0 + bl;
        const int qblk = 2 * qh + qb;
        const size_t qrow = (size_t)b * SEQ + blk * 128 + qblk * 32 + ql;
        bf16x8 qf[4];
        {
            u32x4 qw[4]; float ss = 0.f;
#pragma unroll
            for (int ks = 0; ks < 4; ++ks) { qw[ks] = __builtin_nontemporal_load((const u32x4*)(QB + qrow * DM + hq * 64 + 16 * ks + 8 * hi));
                const unsigned ww[4] = {qw[ks].x, qw[ks].y, qw[ks].z, qw[ks].w};
#pragma unroll
                for (int e = 0; e < 4; ++e) { const float lo = bf_lo(ww[e]), h2 = bf_hi(ww[e]); ss += lo * lo + h2 * h2; } }
            ss += __shfl_xor(ss, 32);
            const float rs = __builtin_amdgcn_rsqf(ss * (1.0f / 64.0f) + EPS) * 0.125f;
#pragma unroll
            for (int ks = 0; ks < 4; ++ks) { const f32x4 g0 = *(const f32x4*)(qnw + 16 * ks + 8 * hi), g1 = *(const f32x4*)(qnw + 16 * ks + 8 * hi + 4);
                u32x4 o; o.x = cvt_pk(bf_lo(qw[ks].x) * rs * g0.x, bf_hi(qw[ks].x) * rs * g0.y); o.y = cvt_pk(bf_lo(qw[ks].y) * rs * g0.z, bf_hi(qw[ks].y) * rs * g0.w);
                o.z = cvt_pk(bf_lo(qw[ks].z) * rs * g1.x, bf_hi(qw[ks].z) * rs * g1.y); o.w = cvt_pk(bf_lo(qw[ks].w) * rs * g1.z, bf_hi(qw[ks].w) * rs * g1.w);
                qf[ks] = __builtin_bit_cast(bf16x8, o); }
        }
        f32x16 S[6];
#pragma unroll
        for (int i = 0; i < 6; ++i) {
            const int kb = (i == 0) ? 0 : 4 * bl + qblk + i;
            f32x16 acc;
#pragma unroll
            for (int e = 0; e < 16; ++e) acc[e] = 0.f;
#pragma unroll
            for (int ks = 0; ks < 4; ++ks) { const bf16x8 kf = *(const LAS bf16x8*)(lds + ATT_K_OFF + (kb * 32 + ql) * KP + (16 * ks + 8 * hi) * 2);
                acc = __builtin_amdgcn_mfma_f32_32x32x16_bf16(kf, qf[ks], acc, 0, 0, 0); }
            S[i] = acc;
        }
        const float NEG = -INFINITY;
#pragma unroll
        for (int e = 0; e < 16; ++e) { const int kr = crow(e, hi);
            if (kr >= 16) S[0][e] = NEG;
            if (!(kr > ql)) S[1][e] = NEG;
            if (!(kr <= ql)) S[5][e] = NEG; }
        if (blk == 0) {
#pragma unroll
            for (int i = 1; i < 6; ++i) if (qblk + i <= 4) {
#pragma unroll
                for (int e = 0; e < 16; ++e) S[i][e] = NEG; }
        }
        float mx = sink;
#pragma unroll
        for (int i = 0; i < 6; ++i)
#pragma unroll
            for (int e = 0; e < 16; ++e) mx = fmaxf(mx, S[i][e]);
        mx = fmaxf(mx, __shfl_xor(mx, 32));
        float den = 0.f; const float mb = mx * L2E;
        bf16x8 pf[6][2];
#pragma unroll
        for (int i = 0; i < 6; ++i) {
            float ev[16];
#pragma unroll
            for (int e = 0; e < 16; ++e) { ev[e] = __builtin_amdgcn_exp2f(S[i][e] * L2E - mb); den += ev[e]; }
#pragma unroll
            for (int h = 0; h < 2; ++h) { u32x4 o; o.x = cvt_pk(ev[8 * h + 0], ev[8 * h + 1]); o.y = cvt_pk(ev[8 * h + 2], ev[8 * h + 3]); o.z = cvt_pk(ev[8 * h + 4], ev[8 * h + 5]); o.w = cvt_pk(ev[8 * h + 6], ev[8 * h + 7]);
                pf[i][h] = __builtin_bit_cast(bf16x8, o); }
        }
        den += __shfl_xor(den, 32);
        den += __builtin_amdgcn_exp2f(sink * L2E - mb);
        const float inv = 1.0f / den; float ssq = 0.f;
#pragma unroll
        for (int db = 0; db < 2; ++db) {
            f32x16 O;
#pragma unroll
            for (int e = 0; e < 16; ++e) O[e] = 0.f;
#pragma unroll
            for (int i = 0; i < 6; ++i) { const int kb = (i == 0) ? 0 : 4 * bl + qblk + i;
#pragma unroll
                for (int h = 0; h < 2; ++h) {
                    const LAS unsigned char* vp = lds + ATT_V_OFF + (db * 32 + ql) * VP + (kb * 32 + 16 * h + 4 * hi) * 2;
                    const u32x2 v0 = *(const LAS u32x2*)vp, v1 = *(const LAS u32x2*)(vp + 16);
                    const u32x4 vv = (u32x4){v0.x, v0.y, v1.x, v1.y};
                    O = __builtin_amdgcn_mfma_f32_32x32x16_bf16(__builtin_bit_cast(bf16x8, vv), pf[i][h], O, 0, 0, 0); } }
#pragma unroll
            for (int g = 0; g < 4; ++g) { const float o0 = O[4 * g] * inv, o1 = O[4 * g + 1] * inv, o2 = O[4 * g + 2] * inv, o3 = O[4 * g + 3] * inv; ssq += (o0 * o0 + o1 * o1) + (o2 * o2 + o3 * o3);
                u32x2 w; w.x = cvt_pk(o0, o1); w.y = cvt_pk(o2, o3);
                *(u32x2*)(ATT + qrow * DM + hq * 64 + db * 32 + 8 * g + 4 * hi) = w; }
        }
        ssq += __shfl_xor(ssq, 32);
        if (hi == 0) atomicAdd((float*)(ws + WS_ROWSA) + qrow, ssq);
    }
    __syncthreads();
}

constexpr int SP = 272;
__device__ __forceinline__ float gelu_tanh(float y) { const float t = y + 0.044715f * y * y * y; return y * __builtin_amdgcn_rcpf(1.0f + __builtin_amdgcn_exp2f(-2.302208198f * t)); }
__device__ __forceinline__ f32x2 pk_fma(f32x2 a, f32x2 b, f32x2 c) { return __builtin_elementwise_fma(a, b, c); }

template <bool FINAL>
__device__ __forceinline__ void ssm_item(const Args& a, LAS unsigned char* lds, int item, int wave, int lane) {
    static_assert(NCHUNK == 32 && CHUNK == 256, "item decode");
    unsigned char* ws = a.ws;
    const bf16* U = (const bf16*)(ws + WS_U); bf16* Z = (bf16*)(ws + WS_Q);
    float* E = (float*)(ws + WS_E);
    const bool meta = (!FINAL) && item >= 256;
    const int oct = item & 7, cp = (item >> 3) & 15, bp = (item >> 7) & 1;
    const int g = oct * 8 + wave, j = lane & 31, hi = lane >> 5;
    const int b0 = bp * 2, c0 = 2 * cp;
    bf16x8 bbf[4];
#pragma unroll
    for (int k = 0; k < 4; ++k) bbf[k] = *(const bf16x8*)((const bf16*)(ws + WS_BB) + ((size_t)g * 128 + k * 32 + j) * 16 + 8 * hi);
    const f32x2 a0 = ((const f32x2*)(ws + WS_ATAB))[g * 64 + j], a1 = ((const f32x2*)(ws + WS_ATAB))[g * 64 + 32 + j];
    const f32x2 a0x = (f32x2){a0.x, a0.x}, a0y = (f32x2){a0.y, a0.y}, na0y = (f32x2){-a0.y, -a0.y}, a1x = (f32x2){a1.x, a1.x}, a1y = (f32x2){a1.y, a1.y}, na1y = (f32x2){-a1.y, -a1.y};
    f32x2 s0r = (f32x2){0.f, 0.f}, s0i = s0r, s1r = s0r, s1i = s0r;
    bf16x8 cmf[4]; f32x4 dsk;
    if (FINAL) {
#pragma unroll
        for (int k = 0; k < 4; ++k) cmf[k] = *(const bf16x8*)((const bf16*)(ws + WS_CM) + ((size_t)g * 16 + (lane & 15)) * 128 + 32 * k + 8 * (lane >> 4));
        dsk = *(const f32x4*)(a.in[14] + g * 16 + 4 * (lane >> 4));
        const f32x2 t0 = ((const f32x2*)(ws + WS_ATAB2))[g * 64 + j], t1 = ((const f32x2*)(ws + WS_ATAB2))[g * 64 + 32 + j];
        const f32x2 m0 = ((const f32x2*)(ws + WS_SMETA))[g * 64 + j], m1 = ((const f32x2*)(ws + WS_SMETA))[g * 64 + 32 + j];
        float c0r = m0.x, c0i = m0.y, c1r = m1.x, c1i = m1.y;
        const f32x2* Eb = (const f32x2*)E + ((size_t)((b0 + hi) * 64 + g) * NCHUNK) * 64;
#pragma unroll
        for (int half = 0; half < 2; ++half) {
            if (half * 16 < c0) {
                f32x2 e0[16], e1[16];
#pragma unroll
                for (int c = 0; c < 16; ++c) { const int cc = half * 16 + c < NCHUNK - 1 ? half * 16 + c : NCHUNK - 2; e0[c] = Eb[cc * 64 + j]; e1[c] = Eb[cc * 64 + 32 + j]; }
#pragma unroll
                for (int c = 0; c < 16; ++c) if (half * 16 + c < c0) {
                    const float n0r = fmaf(t0.x, c0r, fmaf(-t0.y, c0i, e0[c].x)), n0i = fmaf(t0.x, c0i, fmaf(t0.y, c0r, e0[c].y));
                    const float n1r = fmaf(t1.x, c1r, fmaf(-t1.y, c1i, e1[c].x)), n1i = fmaf(t1.x, c1i, fmaf(t1.y, c1r, e1[c].y));
                    c0r = n0r; c0i = n0i; c1r = n1r; c1i = n1i; }
            }
        }
        const f32x2 ec0 = Eb[c0 * 64 + j], ec1 = Eb[c0 * 64 + 32 + j];
        s0r = (f32x2){c0r, fmaf(t0.x, c0r, fmaf(-t0.y, c0i, ec0.x))}; s0i = (f32x2){c0i, fmaf(t0.x, c0i, fmaf(t0.y, c0r, ec0.y))};
        s1r = (f32x2){c1r, fmaf(t1.x, c1r, fmaf(-t1.y, c1i, ec1.x))}; s1i = (f32x2){c1i, fmaf(t1.x, c1i, fmaf(t1.y, c1r, ec1.y))};
    }
    const int bsel = (j >> 2) & 1, csel = j & 1, tt = ((j & 3) >> 1) + 2 * (j >> 3);
    const size_t urow0 = meta ? (size_t)META_ROW + tt : (size_t)(b0 + bsel) * SEQ + (size_t)(c0 + csel) * CHUNK + tt;
    const bf16* up = U + urow0 * DM + g * 16 + 8 * hi;
    LAS unsigned char* sl = lds + wave * (32 * SP);
    const int nsteps = meta ? 2 : CHUNK / 8;
    const size_t erow = (size_t)b0 * SEQ + (size_t)(c0 + ((lane & 15) >> 3)) * CHUNK + (lane & 7);
    const bf16* ue = U + erow * DM + g * 16 + 4 * (lane >> 4);
    bf16* ze = Z + erow * DM + g * 16 + 4 * (lane >> 4);
    bf16x8 uf = *(const bf16x8*)up;
    u32x2 uu0 = (u32x2){0u, 0u}, uu1 = (u32x2){0u, 0u};
    if (FINAL) { uu0 = *(const u32x2*)ue; uu1 = *(const u32x2*)(ue + (size_t)SEQ * DM); }
    for (int st = 0; st < nsteps; ++st) {
        bf16x8 ufn = uf; u32x2 un0 = uu0, un1 = uu1;
        if (st + 1 < nsteps) { ufn = *(const bf16x8*)(up + (size_t)(st + 1) * 8 * DM);
            if (FINAL) { un0 = *(const u32x2*)(ue + (size_t)(st + 1) * 8 * DM); un1 = *(const u32x2*)(ue + (size_t)(st + 1) * 8 * DM + (size_t)SEQ * DM); } }
        f32x16 X[4];
#pragma unroll
        for (int k = 0; k < 4; ++k) { f32x16 z;
#pragma unroll
            for (int e = 0; e < 16; ++e) z[e] = 0.f;
            X[k] = __builtin_amdgcn_mfma_f32_32x32x16_bf16(uf, bbf[k], z, 0, 0, 0); }
#pragma unroll
        for (int t = 0; t < 8; ++t) {
            const f32x2 x0r = (f32x2){X[0][2 * t], X[0][2 * t + 1]}, x0i = (f32x2){X[1][2 * t], X[1][2 * t + 1]}, x1r = (f32x2){X[2][2 * t], X[2][2 * t + 1]}, x1i = (f32x2){X[3][2 * t], X[3][2 * t + 1]};
            const f32x2 n0r = pk_fma(a0x, s0r, pk_fma(na0y, s0i, x0r)), n0i = pk_fma(a0x, s0i, pk_fma(a0y, s0r, x0i));
            const f32x2 n1r = pk_fma(a1x, s1r, pk_fma(na1y, s1i, x1r)), n1i = pk_fma(a1x, s1i, pk_fma(a1y, s1r, x1i));
            s0r = n0r; s0i = n0i; s1r = n1r; s1i = n1i;
            if (FINAL) {
                LAS unsigned char* r0 = sl + ((hi * 2 + 0) * 8 + t) * SP; LAS unsigned char* r1 = sl + ((hi * 2 + 1) * 8 + t) * SP;
                *(LAS unsigned*)(r0 + j * 4) = cvt_pk(n0r.x, n0i.x); *(LAS unsigned*)(r0 + (32 + j) * 4) = cvt_pk(n1r.x, n1i.x);
                *(LAS unsigned*)(r1 + j * 4) = cvt_pk(n0r.y, n0i.y); *(LAS unsigned*)(r1 + (32 + j) * 4) = cvt_pk(n1r.y, n1i.y); }
        }
        if (FINAL) {
            LDS_WAIT(); asm volatile("" ::: "memory");
#pragma unroll
            for (int bh = 0; bh < 2; ++bh) {
                f32x4 Y = (f32x4){0.f, 0.f, 0.f, 0.f};
#pragma unroll
                for (int k = 0; k < 4; ++k) { const bf16x8 sf = *(const LAS bf16x8*)(sl + (bh * 16 + (lane & 15)) * SP + (32 * k + 8 * (lane >> 4)) * 2);
                    Y = __builtin_amdgcn_mfma_f32_16x16x32_bf16(cmf[k], sf, Y, 0, 0, 0); }
                const u32x2 uu = bh ? uu1 : uu0;
                const float y0 = Y[0] + dsk.x * bf_lo(uu.x), y1 = Y[1] + dsk.y * bf_hi(uu.x), y2 = Y[2] + dsk.z * bf_lo(uu.y), y3 = Y[3] + dsk.w * bf_hi(uu.y);
                u32x2 w; w.x = cvt_pk(gelu_tanh(y0), gelu_tanh(y1)); w.y = cvt_pk(gelu_tanh(y2), gelu_tanh(y3));
                *(u32x2*)(ze + (size_t)st * 8 * DM + (size_t)bh * SEQ * DM) = w;
            }
            LDS_WAIT(); asm volatile("" ::: "memory");
        }
        uf = ufn; uu0 = un0; uu1 = un1;
    }
    if (!FINAL) {
        if (meta) { if (hi == 0) { ((f32x2*)(ws + WS_SMETA))[g * 64 + j] = (f32x2){s0r.x, s0i.x}; ((f32x2*)(ws + WS_SMETA))[g * 64 + 32 + j] = (f32x2){s1r.x, s1i.x}; } }
        else { f32x2* Eb = (f32x2*)E + ((size_t)((b0 + hi) * 64 + g) * NCHUNK + c0) * 64;
            Eb[j] = (f32x2){s0r.x, s0i.x}; Eb[32 + j] = (f32x2){s1r.x, s1i.x}; Eb[64 + j] = (f32x2){s0r.y, s0i.y}; Eb[64 + 32 + j] = (f32x2){s1r.y, s1i.y}; }
    }
}

#define XB_TMO      128
#define XB_XCNT(j)  (256  + 64 * (j))
#define XB_XSUB(j)  (1280 + 64 * (j))
#define XB_XGEN(j)  (2304 + 64 * (j))
#define XB_TOP      3328
#define XB_TOPGEN   3392
#define XCD_BAR_WORDS 3456
#define XB_SPIN_CAP (1u << 18)

__device__ __forceinline__ unsigned xb_ld(unsigned* p)              { return __hip_atomic_load(p, __ATOMIC_RELAXED, __HIP_MEMORY_SCOPE_AGENT); }
__device__ __forceinline__ unsigned xb_add(unsigned* p, unsigned v) { return __hip_atomic_fetch_add(p, v, __ATOMIC_RELAXED, __HIP_MEMORY_SCOPE_AGENT); }
__device__ __forceinline__ unsigned xb_xcc_id() { return (unsigned)__builtin_amdgcn_s_getreg((3 << 11) | 20) & 0xFu; }
#define XB_SPIN(cond, bar) do { unsigned _sp = 0; while (cond) { __builtin_amdgcn_s_sleep(1); \
    if ((++_sp & 255u) == 0u) { if (xb_ld(&(bar)[XB_TMO])) break; if (_sp > XB_SPIN_CAP) { atomicAdd(&(bar)[XB_TMO], 1u); break; } } } } while (0)

struct XcdBarrier {
    unsigned* bar; unsigned x;
    volatile LAS unsigned* st;
};

__device__ __forceinline__ XcdBarrier xcd_barrier_post(unsigned* bar, volatile LAS unsigned* st) {
    XcdBarrier b; b.bar = bar; b.x = xb_xcc_id(); b.st = st;
    if (threadIdx.x == 0) (void)xb_add(&bar[XB_XCNT(b.x)], 1u);
    return b;
}
__device__ __forceinline__ void xcd_barrier_complete(unsigned* bar, unsigned x, unsigned& nloc, unsigned& nx) {
    const unsigned G = gridDim.x * gridDim.y * gridDim.z;
    unsigned sum, cnt, mine, sp = 0u;
    for (;;) {
        sum = 0u; cnt = 0u; mine = 0u;
#pragma unroll
        for (unsigned j = 0; j < 16; ++j) { const unsigned c = xb_ld(&bar[XB_XCNT(j)]); sum += c; cnt += (c > 0u) ? 1u : 0u; mine = (j == x) ? c : mine; }
        if (sum == G) break;
        __builtin_amdgcn_s_sleep(1);
        if ((++sp & 255u) == 0u) { if (xb_ld(&bar[XB_TMO])) break; if (sp > XB_SPIN_CAP) { atomicAdd(&bar[XB_TMO], 1u); break; } }
    }
    nloc = mine > 0u ? mine : 1u; nx = cnt > 0u ? cnt : 1u;
}

__device__ __forceinline__ void xcd_barrier(const XcdBarrier& b) {
    asm volatile("s_waitcnt vmcnt(0)" ::: "memory");
    __syncthreads();
    if (threadIdx.x == 0) {
        unsigned* bar = b.bar;
        __builtin_amdgcn_s_waitcnt(0);
        unsigned nloc = b.st[0], nx = b.st[1];
        if (nloc == 0u) { xcd_barrier_complete(bar, b.x, nloc, nx); b.st[0] = nloc; b.st[1] = nx; }
        const unsigned old = xb_add(&bar[XB_XSUB(b.x)], 1u);
        const unsigned gen = old / nloc;
        if (old + 1u == (gen + 1u) * nloc) {
            __builtin_amdgcn_fence(__ATOMIC_RELEASE, "agent");
            asm volatile("s_waitcnt vmcnt(0)" ::: "memory");
            const unsigned og = xb_add(&bar[XB_TOP], 1u);
            const unsigned tg = og / nx;
            if (og + 1u == (tg + 1u) * nx) xb_add(&bar[XB_TOPGEN], 1u);
            else XB_SPIN(xb_ld(&bar[XB_TOPGEN]) == tg, bar);
            __builtin_amdgcn_fence(__ATOMIC_ACQUIRE, "agent");
            xb_add(&bar[XB_XGEN(b.x)], 1u);
            asm volatile("s_waitcnt vmcnt(0)" ::: "memory");
        } else {
            XB_SPIN(xb_ld(&bar[XB_XGEN(b.x)]) == gen, bar);
            __builtin_amdgcn_fence(__ATOMIC_ACQUIRE, "agent");
            asm volatile("s_waitcnt vmcnt(0)" ::: "memory");
        }
    }
    __syncthreads();
}

__device__ __forceinline__ void meta_proj(const Args& a, int wave, int lane) {
    unsigned char* ws = a.ws;
    const bf16* XB = (const bf16*)(ws + WS_XB); const bf16* W1t = (const bf16*)(ws + WS_W1); const float* rstdx = (const float*)(ws + WS_RSTDX);
    for (int gw = blockIdx.x * NWAVES + wave; gw < 1536; gw += gridDim.x * NWAVES) {
    const int n = 1024 + gw;
    float wf[16];
    { const u32x4 w0 = *(const u32x4*)(W1t + (size_t)n * DM + lane * 8), w1 = *(const u32x4*)(W1t + (size_t)n * DM + 512 + lane * 8);
      const unsigned ww[8] = {w0.x, w0.y, w0.z, w0.w, w1.x, w1.y, w1.z, w1.w};
#pragma unroll
      for (int e = 0; e < 8; ++e) { wf[2 * e] = bf_lo(ww[e]); wf[2 * e + 1] = bf_hi(ww[e]); } }
    float mine = 0.f;
#pragma unroll
    for (int r = 0; r < 16; ++r) {
        const u32x4 x0 = *(const u32x4*)(XB + (size_t)(META_ROW + r) * DM + lane * 8), x1 = *(const u32x4*)(XB + (size_t)(META_ROW + r) * DM + 512 + lane * 8);
        const unsigned xx[8] = {x0.x, x0.y, x0.z, x0.w, x1.x, x1.y, x1.z, x1.w};
        float s = 0.f;
#pragma unroll
        for (int e = 0; e < 8; ++e) s += bf_lo(xx[e]) * wf[2 * e] + bf_hi(xx[e]) * wf[2 * e + 1];
        s = wave_sum(s);
        if (lane == r) mine = s;
    }
    if (lane < 16) {
        const unsigned short o = (unsigned short)(cvt_pk(mine * rstdx[META_ROW + lane], 0.f) & 0xffffu);
        const size_t row = META_ROW + lane;
        if (n < 1280) ((bf16*)(ws + WS_K))[row * KVW + (n - 1024)] = o;
        else if (n < 1536) ((bf16*)(ws + WS_V))[row * KVW + (n - 1280)] = o;
        else ((bf16*)(ws + WS_U))[row * DM + (n - 1536)] = o;
    }
    }
}

constexpr int MISC_OFF = LDS_BYTES - 256;
constexpr size_t WS_BAR = 768 * 1024;
__global__ void __launch_bounds__(NTHREADS, 2) mk_fwd(Args a) {
    extern __shared__ __attribute__((aligned(16))) unsigned char lds_raw[];
    cg::grid_group grid = cg::this_grid();
    LAS unsigned char* lds = (LAS unsigned char*)lds_raw;
    const int tid = threadIdx.x, lane = tid & 63, wave = __builtin_amdgcn_readfirstlane(tid >> 6);
    unsigned char* ws = a.ws;
    const int G = gridDim.x, c = blockIdx.x;
    volatile LAS unsigned* MISC = (volatile LAS unsigned*)(lds + MISC_OFF);
    if (tid < 32) MISC[tid] = 0u;
    __syncthreads();
    unsigned* barw = (unsigned*)(ws + WS_BAR);
    XcdBarrier bar = xcd_barrier_post(barw, MISC + 8);
    if (a.never) grid.sync();

    p0_prologue(a, lds, wave, lane);
    xcd_barrier(bar);
    meta_proj(a, wave, lane);
    { pg8::Gemm g{(const pg8::bf16_t*)(ws + WS_XB), (const pg8::bf16_t*)(ws + WS_W1), NTOK, NQKVU, DM}; pg8::StaticOrder S; S.init(NTOK, NQKVU, G, c);
      EpiProj E{(bf16*)(ws + WS_Q), (bf16*)(ws + WS_K), (bf16*)(ws + WS_V), (bf16*)(ws + WS_U), (const float*)(ws + WS_RSTDX)};
      pg8::gemm_phase<EpiProj, pg8::StaticOrder, true, true>(lds, g, S, E); }
    xcd_barrier(bar);
    { const int vcu = (G % 8 == 0) ? (c % 8) * (G / 8) + c / 8 : c;
      for (int it = vcu; it < 512; it += G) attn_item(a, lds, it, wave, lane); }
    for (int it = c; it < 256 + 8; it += G) ssm_item<false>(a, lds, it, wave, lane);
    xcd_barrier(bar);
    for (int it = c; it < 256; it += G) ssm_item<true>(a, lds, it, wave, lane);
    xcd_barrier(bar);
    { pg8::Gemm g{(const pg8::bf16_t*)(ws + WS_Q), (const pg8::bf16_t*)(ws + WS_W2), NTOK, 2048, DM}; pg8::StaticOrder S; S.init(NTOK, 2048, G, c);
      EpiGlu E{(bf16*)(ws + WS_U), DM, (float*)(ws + WS_ROWSB)};
      pg8::gemm_phase<EpiGlu, pg8::StaticOrder, true, true>(lds, g, S, E); }
    xcd_barrier(bar);
    { pg8::Gemm g{(const pg8::bf16_t*)(ws + WS_XB), (const pg8::bf16_t*)(ws + WS_WG), NTOK, 2048, DM}; pg8::StaticOrder S; S.init(NTOK, 2048, G, c);
      EpiMerge E{(const bf16*)(ws + WS_ATT), (const bf16*)(ws + WS_U), (bf16*)(ws + WS_Q), (const float*)(ws + WS_RSTDX), (const float*)(ws + WS_ROWSA), (const float*)(ws + WS_ROWSB), a.in[16], a.in[17]};
      pg8::gemm_phase<EpiMerge, pg8::StaticOrder, true, true>(lds, g, S, E); }
    xcd_barrier(bar);
    { pg8::Gemm g{(const pg8::bf16_t*)(ws + WS_Q), (const pg8::bf16_t*)(ws + WS_W3), NTOK, DM, DM}; pg8::StaticOrder S; S.init(NTOK, DM, G, c);
      EpiResid1 E{(const bf16*)(ws + WS_XB), (bf16*)(ws + WS_ATT), (float*)(ws + WS_ROWSS)};
      pg8::gemm_phase<EpiResid1, pg8::StaticOrder, true, true>(lds, g, S, E); }
    xcd_barrier(bar);
    { pg8::Gemm g{(const pg8::bf16_t*)(ws + WS_ATT), (const pg8::bf16_t*)(ws + WS_W4), NTOK, 2 * DFF, DM}; pg8::StaticOrder S; S.init(NTOK, 2 * DFF, G, c);
      EpiSwiglu E{(bf16*)(ws + WS_ACT), DFF, (const float*)(ws + WS_ROWSS)};
      pg8::gemm_phase<EpiSwiglu, pg8::StaticOrder, true, true, true>(lds, g, S, E); }
    xcd_barrier(bar);
    { pg8::Gemm g{(const pg8::bf16_t*)(ws + WS_ACT), (const pg8::bf16_t*)(ws + WS_W5), NTOK, DM, DFF}; pg8::StaticOrder S; S.init(NTOK, DM, G, c);
      EpiResid2 E{(const bf16*)(ws + WS_ATT), a.out};
      pg8::gemm_phase<EpiResid2, pg8::StaticOrder, true, true>(lds, g, S, E); }
}

extern "C" void kernel_launch(void* const* d_in, const int* in_sizes, int n_in, void* d_out, int out_size, void* d_ws, size_t ws_size, hipStream_t stream) {
    static int grid = 0;
    if (grid == 0) {
        if (n_in != 22 || in_sizes[0] != NTOK * DM || out_size != NTOK * DM || ws_size < WS_END) { fprintf(stderr, "kernel_launch: unexpected shapes (n_in %d, in0 %d, out %d, ws %zu)\n", n_in, n_in > 0 ? in_sizes[0] : -1, out_size, ws_size); grid = -1; return; }
        int dev = 0, cus = 0, per_cu = 0;
        (void)hipGetDevice(&dev); (void)hipDeviceGetAttribute(&cus, hipDeviceAttributeMultiprocessorCount, dev);
        if (hipFuncSetAttribute((const void*)mk_fwd, hipFuncAttributeMaxDynamicSharedMemorySize, LDS_BYTES) != hipSuccess) { fprintf(stderr, "kernel_launch: hipFuncSetAttribute failed\n"); grid = -1; return; }
        if (hipOccupancyMaxActiveBlocksPerMultiprocessor(&per_cu, (const void*)mk_fwd, NTHREADS, LDS_BYTES) != hipSuccess || per_cu < 1) { fprintf(stderr, "kernel_launch: occupancy query says %d; nothing launched\n", per_cu); grid = -1; return; }
        (void)hipGetLastError();
        grid = cus;
    }
    if (grid < 0) return;
    Args a{};
    for (int i = 0; i < 22; ++i) a.in[i] = (const float*)d_in[i];
    a.out = (float*)d_out; a.ws = (unsigned char*)d_ws;
    if (hipMemsetAsync((unsigned char*)d_ws + WS_BAR, 0, XCD_BAR_WORDS * 4, stream) != hipSuccess) { fprintf(stderr, "kernel_launch: memset of the barrier words failed\n"); return; }
    void* args[] = {&a};
    hipError_t e = hipLaunchCooperativeKernel((const void*)mk_fwd, dim3(grid), dim3(NTHREADS), args, LDS_BYTES, stream);
    if (e != hipSuccess) fprintf(stderr, "cooperative launch failed: %s (grid %d)\n", hipGetErrorString(e), grid);
}
```
